# Optimizing an MI355X kernel written in HIP

```python
import jax, jax.numpy as jnp
from jax import lax
import numpy as np

D_MODEL = 1024
BATCH = 8
SEQ = 2048
DEPTH = 4

RET_HEADS = 4
RET_DK = 128
RET_DV = 256
RET_QK = RET_HEADS * RET_DK
RET_V = RET_HEADS * RET_DV
ROPE_BASE = 10000.0
MAX_POS_OFFSET = 1024
LRU_WIDTH = D_MODEL
LRU_BLOCKS = 16
LRU_BLOCK = LRU_WIDTH // LRU_BLOCKS
LRU_C = 8.0
CONV_W = 4
MLSTM_HEADS = 4
MLSTM_WIDTH = D_MODEL
MLSTM_DH = MLSTM_WIDTH // MLSTM_HEADS
QKV_BLOCK = 4
CHUNK = 64
D_FF = 4 * D_MODEL
N_BRANCH = 3
EPS = 1e-6

IN_SPLITS = (RET_QK, RET_QK, RET_V, RET_V,
             LRU_WIDTH, LRU_WIDTH,
             MLSTM_WIDTH, MLSTM_WIDTH,
             N_BRANCH * D_MODEL)
D_IN = int(sum(IN_SPLITS))
IN_OFFSETS = tuple(int(v) for v in np.cumsum(IN_SPLITS)[:-1])

kernel_name = "hybrid_retention_rglru_mlstm_trunk"


def rms_norm(x, gain):
    xf = x.astype(jnp.float32)
    xf = xf * lax.rsqrt(jnp.mean(xf * xf, axis=-1, keepdims=True) + EPS)
    return xf.astype(x.dtype) * gain


def head_rms_norm(xh):
    xf = xh.astype(jnp.float32)
    xf = xf * lax.rsqrt(jnp.mean(xf * xf, axis=-1, keepdims=True) + EPS)
    return xf.astype(xh.dtype)


def causal_depthwise_conv(x, w, b):
    S = x.shape[1]
    xp = jnp.pad(x, ((0, 0), (CONV_W - 1, 0), (0, 0)))
    y = b
    for k in range(CONV_W):
        y = y + w[k] * xp[:, k:k + S]
    return y


def block_diag_linear(x, w):
    B, S, _ = x.shape
    nb, bs, bo = w.shape
    return jnp.einsum('bsnd,nde->bsne', x.reshape(B, S, nb, bs), w).reshape(B, S, nb * bo)


def rotary(x, positions):
    half = x.shape[-1] // 2
    inv_freq = ROPE_BASE ** (-jnp.arange(half, dtype=jnp.float32) / half)
    ang = positions.astype(jnp.float32)[..., None] * inv_freq
    cos = jnp.cos(ang)[:, :, None, :].astype(x.dtype)
    sin = jnp.sin(ang)[:, :, None, :].astype(x.dtype)
    x1, x2 = x[..., :half], x[..., half:]
    return jnp.concatenate([x1 * cos - x2 * sin, x1 * sin + x2 * cos], axis=-1)


def to_chunks(x):
    B, S, H, d = x.shape
    return x.reshape(B, S // CHUNK, CHUNK, H, d).transpose(1, 0, 3, 2, 4)


def gate_to_chunks(g):
    B, S, H = g.shape
    return g.reshape(B, S // CHUNK, CHUNK, H).transpose(1,0, 3, 2)


def from_chunks(y):
    N, B, H, C, d = y.shape
    return y.transpose(1, 0, 3, 2, 4).reshape(B, N * C, H, d)


def chunked_retention(q, k, v):
    dtype = v.dtype
    q, k, v = q.astype(jnp.float32), k.astype(jnp.float32) * RET_DK ** -0.5, v.astype(jnp.float32)
    B = q.shape[0]
    log_gamma = jnp.log1p(-jnp.exp2(-5.0 - jnp.arange(RET_HEADS, dtype=jnp.float32)))
    pos = jnp.arange(CHUNK, dtype=jnp.float32)
    diff = pos[:, None] - pos[None, :]
    causal = diff >= 0
    decay_intra = jnp.where(causal, jnp.exp(log_gamma[:, None, None] * jnp.where(causal, diff, 0.0)), 0.0)
    decay_q = jnp.exp(log_gamma[:, None] * (pos + 1.0))[:, :, None]
    decay_k = jnp.exp(log_gamma[:, None] * (CHUNK - 1.0 - pos))[:, :, None]
    decay_chunk = jnp.exp(log_gamma * CHUNK)[:, None, None]

    def step(state, qkv):
        qc, kc, vc = qkv
        scores = jnp.einsum('bhid,bhjd->bhij', qc, kc) * decay_intra
        out = (jnp.einsum('bhij,bhje->bhie', scores, vc)
               + jnp.einsum('bhid,bhde->bhie', qc * decay_q, state))
        state = decay_chunk * state + jnp.einsum('bhjd,bhje->bhde', kc * decay_k, vc)
        return state, out

    state0 = jnp.zeros((B, RET_HEADS, RET_DK, RET_DV), jnp.float32)
    _, out = lax.scan(step, state0, (to_chunks(q), to_chunks(k), to_chunks(v)))
    return from_chunks(out).astype(dtype)


def rg_lru(x, w_r, b_r, w_i, b_i, lam):
    dtype = x.dtype
    xf = x.astype(jnp.float32)
    r = jax.nn.sigmoid(block_diag_linear(xf, w_r.astype(jnp.float32)) + b_r)
    i = jax.nn.sigmoid(block_diag_linear(xf, w_i.astype(jnp.float32)) + b_i)
    log_a = -LRU_C * r * jax.nn.softplus(-lam.astype(jnp.float32))
    a = jnp.exp(log_a)
    u = jnp.sqrt(-jnp.expm1(2.0 * log_a)) * (i * xf)

    def combine(left, right):
        a1, b1 = left
        a2, b2 = right
        return a1 * a2, a2 * b1 + b2

    _, h = lax.associative_scan(combine, (a, u), axis=1)
    return h.astype(dtype)


def chunked_mlstm(q, k, v, i_pre, f_pre):
    dtype = v.dtype
    q, k, v = q.astype(jnp.float32), k.astype(jnp.float32) * MLSTM_DH ** -0.5, v.astype(jnp.float32)
    i_pre = i_pre.astype(jnp.float32)
    log_f = jax.nn.log_sigmoid(f_pre.astype(jnp.float32))
    B = q.shape[0]
    causal = jnp.tril(jnp.ones((CHUNK, CHUNK), dtype=bool))

    def step(carry, inp):
        C_s, n_s, m_s = carry
        qc, kc, vc, ic, lfc = inp
        b = jnp.cumsum(lfc, axis=-1)
        D = jnp.where(causal, b[..., :, None] - b[..., None, :] + ic[..., None, :], -jnp.inf)
        inter = b + m_s[..., None]
        m_t = jnp.maximum(inter, jnp.max(D, axis=-1))
        w_inter = jnp.exp(inter - m_t)
        s = jnp.einsum('bhid,bhjd->bhij', qc, kc) * jnp.exp(D - m_t[..., None])
        num = (jnp.einsum('bhij,bhje->bhie', s, vc)
               + w_inter[..., None] * jnp.einsum('bhid,bhde->bhie', qc, C_s))
        den = jnp.sum(s, axis=-1) + w_inter * jnp.einsum('bhid,bhd->bhi', qc, n_s)
        h = num / jnp.maximum(jnp.abs(den), jnp.exp(-m_t))[..., None]
        b_last = b[..., -1]
        m_new = m_t[..., -1]
        w_k = jnp.exp(b_last[..., None] - b + ic - m_new[..., None])
        decay = jnp.exp(b_last + m_s - m_new)
        C_new = decay[..., None, None] * C_s + jnp.einsum('bhjd,bhje->bhde', kc * w_k[..., None], vc)
        n_new = decay[..., None] * n_s + jnp.einsum('bhjd,bhj->bhd', kc, w_k)
        return (C_new, n_new, m_new), h

    carry0 = (jnp.zeros((B, MLSTM_HEADS, MLSTM_DH, MLSTM_DH), jnp.float32),
              jnp.zeros((B, MLSTM_HEADS, MLSTM_DH), jnp.float32),
              jnp.zeros((B, MLSTM_HEADS), jnp.float32))
    _, h = lax.scan(step, carry0, (to_chunks(q), to_chunks(k), to_chunks(v),
                                   gate_to_chunks(i_pre), gate_to_chunks(log_f)))
    return from_chunks(h).astype(dtype)


def hybrid_mixer(h, positions, w_in, lru_conv_w, lru_conv_b, lru_w_r, lru_b_r, lru_w_i, lru_b_i,
                 lru_lambda, m_conv_w, m_conv_b, m_w_q, m_w_k, m_w_v, m_w_if, m_b_if, m_norm,
                 w_br_ret, w_br_lru, w_br_mlstm, w_out):
    B, S, _ = h.shape
    proj = h @ w_in
    rq, rk, rv, rg, lx, ly, mx, mo, gate_pre = jnp.split(proj, IN_OFFSETS, axis=-1)

    q = rotary(rq.reshape(B, S, RET_HEADS, RET_DK), positions)
    k = rotary(rk.reshape(B, S, RET_HEADS, RET_DK), positions)
    v = rv.reshape(B, S, RET_HEADS, RET_DV)
    ret = head_rms_norm(chunked_retention(q, k, v)).reshape(B, S, RET_V) * jax.nn.silu(rg)

    xl = causal_depthwise_conv(lx, lru_conv_w, lru_conv_b)
    lru = rg_lru(xl, lru_w_r, lru_b_r, lru_w_i, lru_b_i, lru_lambda) * jax.nn.gelu(ly)

    xc = jax.nn.silu(causal_depthwise_conv(mx, m_conv_w, m_conv_b))
    mq = block_diag_linear(xc, m_w_q)
    mk = block_diag_linear(xc, m_w_k)
    mv = block_diag_linear(mx, m_w_v)
    if_pre = jnp.concatenate([mq, mk, mv], axis=-1) @ m_w_if + m_b_if
    i_pre, f_pre = jnp.split(if_pre, 2, axis=-1)
    hm = chunked_mlstm(mq.reshape(B, S, MLSTM_HEADS, MLSTM_DH), mk.reshape(B, S, MLSTM_HEADS, MLSTM_DH),
                       mv.reshape(B, S, MLSTM_HEADS, MLSTM_DH), i_pre, f_pre)
    hm = jax.nn.sigmoid(mo) * hm.reshape(B, S, MLSTM_WIDTH)
    mls = head_rms_norm(hm.reshape(B, S, MLSTM_HEADS, MLSTM_DH)).reshape(B, S, MLSTM_WIDTH) * m_norm

    g_ret, g_lru, g_mls = jnp.split(jax.nn.sigmoid(gate_pre), N_BRANCH, axis=-1)
    merged = g_ret * (ret @ w_br_ret) + g_lru * (lru @ w_br_lru) + g_mls * (mls @ w_br_mlstm)
    return merged @ w_out


def squared_relu_mlp(h, w1, w2):
    return jnp.square(jax.nn.relu(h @ w1)) @ w2


def setup_inputs(seed: int = 0) -> dict:
    key = jax.random.key(seed)
    ks = iter(jax.random.split(key, 40))

    def nrm(shape, scale):
        return scale * jax.random.normal(next(ks), shape, jnp.float32)

    L, D, H = DEPTH, D_MODEL, MLSTM_HEADS
    x = nrm((BATCH, SEQ, D), 1.0)
    c = nrm((BATCH, D), 1.0)
    offset = jax.random.randint(next(ks), (BATCH, 1), 0, MAX_POS_OFFSET, dtype=jnp.int32)
    positions = offset + jnp.arange(SEQ, dtype=jnp.int32)[None, :]
    w_ada = nrm((L, D, 6 * D), 0.5 * D ** -0.5)
    b_ada = nrm((L, 6 * D), 0.02)
    norm_mix = 1.0 + nrm((L, D), 0.02)
    norm_mlp = 1.0 + nrm((L, D), 0.02)
    w_in = nrm((L, D, D_IN), D ** -0.5)
    lru_conv_w = nrm((L, CONV_W, LRU_WIDTH), CONV_W ** -0.5)
    lru_conv_b = nrm((L, LRU_WIDTH), 0.02)
    lru_w_r = nrm((L, LRU_BLOCKS, LRU_BLOCK, LRU_BLOCK), LRU_BLOCK ** -0.5)
    lru_b_r = nrm((L, LRU_WIDTH), 0.1)
    lru_w_i = nrm((L, LRU_BLOCKS, LRU_BLOCK, LRU_BLOCK), LRU_BLOCK ** -0.5)
    lru_b_i = nrm((L, LRU_WIDTH), 0.1)
    a_pow_c = jax.random.uniform(next(ks), (L, LRU_WIDTH), jnp.float32, 0.9, 0.999)
    a_base = a_pow_c ** (1.0 / LRU_C)
    lru_lambda = jnp.log(a_base) - jnp.log1p(-a_base)
    m_conv_w = nrm((L, CONV_W, MLSTM_WIDTH), CONV_W ** -0.5)
    m_conv_b = nrm((L, MLSTM_WIDTH), 0.02)
    nqb = MLSTM_WIDTH // QKV_BLOCK
    m_w_q = nrm((L, nqb, QKV_BLOCK, QKV_BLOCK), QKV_BLOCK ** -0.5)
    m_w_k = nrm((L, nqb, QKV_BLOCK, QKV_BLOCK), QKV_BLOCK ** -0.5)
    m_w_v = nrm((L, nqb, QKV_BLOCK, QKV_BLOCK), QKV_BLOCK ** -0.5)
    m_w_if = nrm((L, 3 * MLSTM_WIDTH, 2 * H), (3 * MLSTM_WIDTH) ** -0.5)
    m_b_if = jnp.concatenate([nrm((L, H), 0.1),
                              jnp.linspace(3.0, 6.0, H, dtype=jnp.float32)[None, :] + nrm((L, H), 0.1)], axis=-1)
    m_norm = 1.0 + nrm((L, MLSTM_WIDTH), 0.02)
    w_br_ret = nrm((L, RET_V, D), RET_V ** -0.5)
    w_br_lru = nrm((L, LRU_WIDTH, D), LRU_WIDTH ** -0.5)
    w_br_mlstm = nrm((L, MLSTM_WIDTH, D), MLSTM_WIDTH ** -0.5)
    w_out = nrm((L, D, D), D ** -0.5)
    w_ff1 = nrm((L, D, D_FF), D ** -0.5)
    w_ff2 = nrm((L, D_FF, D), D_FF ** -0.5)
    final_norm = 1.0 + nrm((D,), 0.02)
    return {"x": x, "c": c, "positions": positions, "w_ada": w_ada, "b_ada": b_ada,
            "norm_mix": norm_mix, "norm_mlp": norm_mlp, "w_in": w_in,
            "lru_conv_w": lru_conv_w, "lru_conv_b": lru_conv_b, "lru_w_r": lru_w_r, "lru_b_r": lru_b_r,
            "lru_w_i": lru_w_i, "lru_b_i": lru_b_i, "lru_lambda": lru_lambda,
            "m_conv_w": m_conv_w, "m_conv_b": m_conv_b, "m_w_q": m_w_q, "m_w_k": m_w_k, "m_w_v": m_w_v,
            "m_w_if": m_w_if, "m_b_if": m_b_if, "m_norm": m_norm,
            "w_br_ret": w_br_ret, "w_br_lru": w_br_lru, "w_br_mlstm": w_br_mlstm, "w_out": w_out,
            "w_ff1": w_ff1, "w_ff2": w_ff2, "final_norm": final_norm}


def reference(x, c, positions, w_ada, b_ada, norm_mix, norm_mlp, w_in,
              lru_conv_w, lru_conv_b, lru_w_r, lru_b_r, lru_w_i, lru_b_i, lru_lambda,
              m_conv_w, m_conv_b, m_w_q, m_w_k, m_w_v, m_w_if, m_b_if, m_norm,
              w_br_ret, w_br_lru, w_br_mlstm, w_out, w_ff1, w_ff2, final_norm):
    cond = jax.nn.silu(c)
    for l in range(DEPTH):
        mod = (cond @ w_ada[l] + b_ada[l])[:, None, :]
        sh1, sc1, g1, sh2, sc2, g2 = jnp.split(mod, 6, axis=-1)
        h = rms_norm(x, norm_mix[l]) * (1.0 + sc1) + sh1
        x = x + g1 * hybrid_mixer(h, positions, w_in[l], lru_conv_w[l], lru_conv_b[l], lru_w_r[l], lru_b_r[l],
                                  lru_w_i[l], lru_b_i[l], lru_lambda[l], m_conv_w[l], m_conv_b[l],
                                  m_w_q[l], m_w_k[l], m_w_v[l], m_w_if[l], m_b_if[l], m_norm[l],
                                  w_br_ret[l], w_br_lru[l], w_br_mlstm[l], w_out[l])
        h = rms_norm(x, norm_mlp[l]) * (1.0 + sc2) + sh2
        x = x + g2 * squared_relu_mlp(h, w_ff1[l], w_ff2[l])
    return rms_norm(x, final_norm)
```

```cpp
#include <hip/hip_runtime.h>
#include <cstdio>
#include <cstdint>
#include <cmath>
constexpr int NB = 8, SEQ = 2048, DM = 1024, DIN = 10240, DFF = 4096, NL = 4, M = NB * SEQ;
constexpr int OFF_RQ = 0, OFF_RK = 512, OFF_RV = 1024, OFF_RG = 2048, OFF_LX = 3072, OFF_LY = 4096, OFF_MX = 5120, OFF_MO = 6144, OFF_GATE = 7168;
constexpr float EPSF = 1e-6f;
#define MK_ONE_LAUNCH 0
namespace pg8 {
#define PG8_LAS __attribute__((address_space(3)))
typedef unsigned short bf16_t;
typedef short bf16x8 __attribute__((ext_vector_type(8)));
typedef float f32x4 __attribute__((ext_vector_type(4)));
typedef unsigned u32x4 __attribute__((ext_vector_type(4)));
constexpr int BM = 256, BK = 64, HALF = 128, HTB = HALF * BK * 2  , STAGE_BYTES = 8 * HTB, NXCD = 8, WGM = 8;

__host__ __device__ __forceinline__ int lds_byte(int r, int c) { const int st = (r >> 4) * 2 + (c >> 5), rr = r & 15, cc = c & 31, ob = rr * 64 + cc * 2; return st * 1024 + (ob ^ (((ob >> 9) & 1) << 5)); }
__host__ __device__ __forceinline__ void stage_rc(int b, int& R, int& C) { const int st = b / 1024, sb = b % 1024, swz = sb ^ (((sb >> 9) & 1) << 5); R = (st >> 1) * 16 + swz / 64; C = (st & 1) * 32 + (swz % 64) / 2; }
__host__ __device__ __forceinline__ int perm32(int rho) { const int n = rho >> 4, i = rho & 15; return 8 * (i >> 2) + 4 * n + (i & 3); }

struct Unit { int pm, pn; };
struct Gemm { const bf16_t* A; const bf16_t* Bt; int M, N, K; };

struct StaticOrder {
    int nM, nN, nwg, G, c;
    __host__ __device__ void init(int M, int N, int G_, int c_) { nM = M / BM; nN = N / BM; nwg = nM * nN; G = G_; c = c_; }
    __host__ __device__ bool next(int i, Unit& u) const {
        const long L = (long)i * G + c; if (L >= nwg) return false;
        int wgid = (int)L; { const int q = nwg / NXCD, r = nwg % NXCD, xcd = wgid % NXCD, off = wgid / NXCD; wgid = (xcd < r ? xcd * (q + 1) : r * (q + 1) + (xcd - r) * q) + off; }
        const int nig = WGM * nN, gid = wgid / nig, fm = gid * WGM, gsz = (nM - fm) < WGM ? (nM - fm) : WGM;
        u.pm = fm + ((wgid % nig) % gsz); u.pn = (wgid % nig) / gsz; return true;
    }
    __device__ __forceinline__ void a_ready(const Unit&) const {}
    __device__ __forceinline__ void done(const Unit&) const {}
};
__device__ __forceinline__ unsigned cvt_pk_bf16(float lo, float hi) { unsigned r; asm volatile("v_cvt_pk_bf16_f32 %0, %1, %2" : "=v"(r) : "v"(lo), "v"(hi)); return r; }
typedef float f32x2 __attribute__((ext_vector_type(2)));
__device__ __forceinline__ float bf_lo(unsigned w) { return __builtin_bit_cast(float, w << 16); }
__device__ __forceinline__ float bf_hi(unsigned w) { return __builtin_bit_cast(float, w & 0xffff0000u); }
__device__ __forceinline__ float sigmoid_f(float x) { return 1.0f / (1.0f + __expf(-x)); }
template <int ACT> struct EpiStore {
    static constexpr bool PERM = true, AFTER_DRAIN = false;
    bf16_t* O; int ldc;
    __device__ __forceinline__ void operator()(const f32x4 (&acc)[2][2][4][2], const Unit& u, int wr, int wc, int fr, int fq) const {
        const int row0 = u.pm * BM + wr * 64 + fr, col0 = u.pn * BM + wc * 32 + 8 * fq;
#pragma unroll
        for (int ai = 0; ai < 2; ++ai)
#pragma unroll
            for (int m = 0; m < 4; ++m) { bf16_t* rowp = O + (size_t)(row0 + ai * HALF + m * 16) * ldc + col0;
#pragma unroll
                for (int bj = 0; bj < 2; ++bj) { f32x4 v0 = acc[ai][bj][m][0], v1 = acc[ai][bj][m][1];
                    if (ACT == 2) {
#pragma unroll
                        for (int e = 0; e < 4; ++e) { const float a = fmaxf(v0[e], 0.f), b = fmaxf(v1[e], 0.f); v0[e] = a * a; v1[e] = b * b; } }
                    u32x4 w; w.x = cvt_pk_bf16(v0[0], v0[1]); w.y = cvt_pk_bf16(v0[2], v0[3]); w.z = cvt_pk_bf16(v1[0], v1[1]); w.w = cvt_pk_bf16(v1[2], v1[3]);
                    *(u32x4*)(rowp + bj * HALF) = w; } }
    }
};
template <int MODE> struct EpiGate {
    static constexpr bool PERM = true, AFTER_DRAIN = false;
    const bf16_t* G; int ldg; bf16_t* O; const bf16_t* Y1; const bf16_t* Y2; int ldc;
    __device__ __forceinline__ void operator()(const f32x4 (&acc)[2][2][4][2], const Unit& u, int wr, int wc, int fr, int fq) const {
        const int row0 = u.pm * BM + wr * 64 + fr, col0 = u.pn * BM + wc * 32 + 8 * fq;
#pragma unroll
        for (int ai = 0; ai < 2; ++ai)
#pragma unroll
            for (int m = 0; m < 4; ++m) { const size_t row = (size_t)(row0 + ai * HALF + m * 16);
#pragma unroll
                for (int bj = 0; bj < 2; ++bj) { f32x4 v0 = acc[ai][bj][m][0], v1 = acc[ai][bj][m][1];
                    const u32x4 gw = *(const u32x4*)(G + row * ldg + col0 + bj * HALF);
                    v0[0] *= sigmoid_f(bf_lo(gw.x)); v0[1] *= sigmoid_f(bf_hi(gw.x)); v0[2] *= sigmoid_f(bf_lo(gw.y)); v0[3] *= sigmoid_f(bf_hi(gw.y));
                    v1[0] *= sigmoid_f(bf_lo(gw.z)); v1[1] *= sigmoid_f(bf_hi(gw.z)); v1[2] *= sigmoid_f(bf_lo(gw.w)); v1[3] *= sigmoid_f(bf_hi(gw.w));
                    if (MODE == 1) {
                        const u32x4 a = *(const u32x4*)(Y1 + row * ldc + col0 + bj * HALF), b = *(const u32x4*)(Y2 + row * ldc + col0 + bj * HALF);
                        v0[0] += bf_lo(a.x) + bf_lo(b.x); v0[1] += bf_hi(a.x) + bf_hi(b.x); v0[2] += bf_lo(a.y) + bf_lo(b.y); v0[3] += bf_hi(a.y) + bf_hi(b.y);
                        v1[0] += bf_lo(a.z) + bf_lo(b.z); v1[1] += bf_hi(a.z) + bf_hi(b.z); v1[2] += bf_lo(a.w) + bf_lo(b.w); v1[3] += bf_hi(a.w) + bf_hi(b.w); }
                    u32x4 w; w.x = cvt_pk_bf16(v0[0], v0[1]); w.y = cvt_pk_bf16(v0[2], v0[3]); w.z = cvt_pk_bf16(v1[0], v1[1]); w.w = cvt_pk_bf16(v1[2], v1[3]);
                    *(u32x4*)(O + row * ldc + col0 + bj * HALF) = w; }
                asm volatile("" ::: "memory"); }
    }
};
struct EpiResid {
    static constexpr bool PERM = false, AFTER_DRAIN = false;
    float* X; const float* g; int gstride;
    __device__ __forceinline__ void operator()(const f32x4 (&acc)[2][2][4][2], const Unit& u, int wr, int wc, int fr, int fq) const {
        const float* gb = g + (size_t)(u.pm >> 3) * gstride;
        const int row0 = u.pm * BM + wr * 64 + fr, col0 = u.pn * BM + wc * 32 + 4 * fq;
#pragma unroll
        for (int bj = 0; bj < 2; ++bj)
#pragma unroll
            for (int n = 0; n < 2; ++n) { const f32x4 gv = *(const f32x4*)(gb + col0 + bj * HALF + n * 16);
#pragma unroll
                for (int ai = 0; ai < 2; ++ai)
#pragma unroll
                    for (int m = 0; m < 4; ++m) { float* p = X + (size_t)(row0 + ai * HALF + m * 16) * 1024 + col0 + bj * HALF + n * 16;
                        const f32x4 xv = *(const f32x4*)p; *(f32x4*)p = xv + gv * acc[ai][bj][m][n]; if (m & 1) asm volatile("" ::: "memory"); } }
    }
};
template <class Epi, class Sched, bool ALIGN_EPI = false, bool SP2 = false>
__device__ __forceinline__ void gemm_phase(PG8_LAS unsigned char* lds, const Gemm g, const Sched& S, const Epi& E) {
    const int tid = threadIdx.x, wid = __builtin_amdgcn_readfirstlane(tid >> 6), lane = tid & 63, wr = wid >> 2, wc = wid & 3, fr = lane & 15, fq = lane >> 4;
    const int K = g.K, nt = K / BK;
    unsigned voffA[2], voffB[2];
#pragma unroll
    for (int i = 0; i < 2; ++i) { int R, C; stage_rc(tid * 16 + i * 8192, R, C); const int Rb = Epi::PERM ? ((R & ~31) + perm32(R & 31)) : R;
        voffA[i] = (unsigned)(R * K + C) * 2u; voffB[i] = (unsigned)(Rb * K + C) * 2u; }
    const size_t kstep = (size_t)(BK * 2);
    const size_t hstep = (size_t)HALF * K * 2;
    const size_t tstep = 2 * hstep;
    const unsigned ldsw = (unsigned)wid * 1024u;
    const int aoff = lds_byte(wr * 64 + fr, fq * 8), boff = lds_byte(wc * 32 + fr, fq * 8);
#define PG8_SA(b, h) (((b) * 2 + (h)) * HTB)
#define PG8_SB(b, h) ((4 + (b) * 2 + (h)) * HTB)
#define PG8_STAGE(bufoff, gbase, voff) do { _Pragma("unroll") for (int _i = 0; _i < 2; ++_i) \
        __builtin_amdgcn_global_load_lds((const unsigned*)((const char*)(gbase) + (voff)[_i]), (PG8_LAS unsigned*)(lds + (bufoff) + ldsw + _i * 8192), 16, 0, 0); } while (0)
#define PG8_LDA(dst, b, h) do { _Pragma("unroll") for (int m = 0; m < 4; ++m) _Pragma("unroll") for (int k = 0; k < 2; ++k) dst[m][k] = *(const PG8_LAS bf16x8*)(lds + PG8_SA(b, h) + aoff + m * 2048 + k * 1024); } while (0)
#define PG8_LDB(dst, b, h) do { _Pragma("unroll") for (int n = 0; n < 2; ++n) _Pragma("unroll") for (int k = 0; k < 2; ++k) dst[n][k] = *(const PG8_LAS bf16x8*)(lds + PG8_SB(b, h) + boff + n * 2048 + k * 1024); } while (0)
#define PG8_MMA(ai, bj, At, Bt) do { __builtin_amdgcn_s_setprio(1); _Pragma("unroll") for (int m = 0; m < 4; ++m) _Pragma("unroll") for (int n = 0; n < 2; ++n) _Pragma("unroll") for (int k = 0; k < 2; ++k) \
        acc[ai][bj][m][n] = __builtin_amdgcn_mfma_f32_16x16x32_bf16(Bt[n][k], At[m][k], acc[ai][bj][m][n], 0, 0, 0); __builtin_amdgcn_s_setprio(0); } while (0)
#define PG8_WAIT_V(n) asm volatile("s_waitcnt vmcnt(" #n ")" ::: "memory")
#define PG8_WAIT_L(n) asm volatile("s_waitcnt lgkmcnt(" #n ")" ::: "memory")
#define PG8_BAR __builtin_amdgcn_s_barrier()
#define PG8_SCHED __builtin_amdgcn_sched_barrier(0)
    Unit cur, nxt; int ui = 0;
    if (!S.next(0, cur)) return;
    f32x4 acc[2][2][4][2];
#pragma unroll
    for (int a = 0; a < 2; ++a)
#pragma unroll
        for (int b = 0; b < 2; ++b)
#pragma unroll
            for (int m = 0; m < 4; ++m)
#pragma unroll
                for (int n = 0; n < 2; ++n) acc[a][b][m][n] = (f32x4){0.f, 0.f, 0.f, 0.f};
    bf16x8 At[4][2], B0[2][2], B1[2][2];
    const char* cA = (const char*)g.A + (size_t)cur.pm * tstep; const char* cB = (const char*)g.Bt + (size_t)cur.pn * tstep;
    S.a_ready(cur);
    if constexpr (SP2) {
        PG8_STAGE(PG8_SB(0, 0), cB, voffB); PG8_STAGE(PG8_SB(0, 1), cB + hstep, voffB); PG8_STAGE(PG8_SA(0, 0), cA, voffA); PG8_STAGE(PG8_SA(0, 1), cA + hstep, voffA);
        if (wr == 1) PG8_BAR;
        PG8_WAIT_V(2); PG8_BAR;
        PG8_STAGE(PG8_SB(1, 0), cB + kstep, voffB); PG8_STAGE(PG8_SA(1, 0), cA + kstep, voffA); PG8_STAGE(PG8_SB(1, 1), cB + hstep + kstep, voffB);
        PG8_WAIT_V(6); PG8_BAR;
    } else {
        PG8_STAGE(PG8_SB(0, 0), cB, voffB); PG8_STAGE(PG8_SA(0, 0), cA, voffA); PG8_STAGE(PG8_SB(0, 1), cB + hstep, voffB); PG8_STAGE(PG8_SA(0, 1), cA + hstep, voffA);
        if (wr == 1) PG8_BAR;
        PG8_WAIT_V(4); PG8_BAR;
        PG8_STAGE(PG8_SB(1, 0), cB + kstep, voffB); PG8_STAGE(PG8_SA(1, 0), cA + kstep, voffA); PG8_STAGE(PG8_SB(1, 1), cB + hstep + kstep, voffB);
        PG8_WAIT_V(6); PG8_BAR;
    }
    for (;;) {
        const bool has_next = S.next(ui + 1, nxt);
        const char* nA = has_next ? (const char*)g.A + (size_t)nxt.pm * tstep : cA; const char* nB = has_next ? (const char*)g.Bt + (size_t)nxt.pn * tstep : cB;
        for (int t = 0; t < nt; t += 2) {
            const bool last = (t == nt - 2);
            const char* a1 = cA + (size_t)(t + 1) * kstep;
            const char* a2 = last ? nA : cA + (size_t)(t + 2) * kstep; const char* b2 = last ? nB : cB + (size_t)(t + 2) * kstep;
            const char* a3 = a2 + kstep; const char* b3 = b2 + kstep;
            if (last && has_next) S.a_ready(nxt);
            if constexpr (SP2) {
            PG8_LDB(B0, 0, 0); PG8_LDB(B1, 0, 1); PG8_SCHED; PG8_LDA(At, 0, 0); PG8_STAGE(PG8_SA(1, 1), a1 + hstep, voffA);
            PG8_WAIT_V(8); PG8_WAIT_L(0); PG8_BAR; PG8_MMA(0, 0, At, B0); PG8_MMA(0, 1, At, B1); PG8_BAR; PG8_SCHED;
            PG8_LDA(At, 0, 1); PG8_STAGE(PG8_SB(0, 0), b2, voffB); PG8_STAGE(PG8_SB(0, 1), b2 + hstep, voffB); PG8_STAGE(PG8_SA(0, 0), a2, voffA);
            PG8_WAIT_V(8); PG8_WAIT_L(0); PG8_BAR; PG8_MMA(1, 0, At, B0); PG8_MMA(1, 1, At, B1); PG8_BAR; PG8_SCHED;
            PG8_LDB(B0, 1, 0); PG8_LDB(B1, 1, 1); PG8_SCHED; PG8_LDA(At, 1, 0); PG8_STAGE(PG8_SA(0, 1), a2 + hstep, voffA);
            PG8_WAIT_V(8); PG8_WAIT_L(0); PG8_BAR; PG8_MMA(0, 0, At, B0); PG8_MMA(0, 1, At, B1); PG8_BAR; PG8_SCHED;
            PG8_LDA(At, 1, 1); PG8_STAGE(PG8_SB(1, 0), b3, voffB); PG8_STAGE(PG8_SB(1, 1), b3 + hstep, voffB); PG8_STAGE(PG8_SA(1, 0), a3, voffA);
            PG8_WAIT_V(8); PG8_WAIT_L(0); PG8_BAR; PG8_MMA(1, 0, At, B0); PG8_MMA(1, 1, At, B1); PG8_BAR; PG8_SCHED;
            } else {
            PG8_LDB(B0, 0, 0); PG8_SCHED; PG8_LDA(At, 0, 0); PG8_STAGE(PG8_SA(1, 1), a1 + hstep, voffA);
            PG8_WAIT_L(8); PG8_BAR; PG8_WAIT_L(0); PG8_MMA(0, 0, At, B0); PG8_BAR; PG8_SCHED;
            PG8_LDB(B1, 0, 1); PG8_STAGE(PG8_SB(0, 0), b2, voffB);
            PG8_BAR; PG8_WAIT_L(0); PG8_MMA(0, 1, At, B1); PG8_BAR;
            PG8_LDA(At, 0, 1); PG8_STAGE(PG8_SA(0, 0), a2, voffA);
            PG8_BAR; PG8_WAIT_L(0); PG8_MMA(1, 0, At, B0); PG8_BAR; PG8_SCHED;
            PG8_STAGE(PG8_SB(0, 1), b2 + hstep, voffB);
            PG8_WAIT_V(6); PG8_BAR; PG8_MMA(1, 1, At, B1); PG8_BAR;
            PG8_LDB(B0, 1, 0); PG8_SCHED; PG8_LDA(At, 1, 0); PG8_STAGE(PG8_SA(0, 1), a2 + hstep, voffA);
            PG8_WAIT_L(8); PG8_BAR; PG8_WAIT_L(0); PG8_MMA(0, 0, At, B0); PG8_BAR; PG8_SCHED;
            PG8_LDB(B1, 1, 1); PG8_STAGE(PG8_SB(1, 0), b3, voffB);
            PG8_BAR; PG8_WAIT_L(0); PG8_MMA(0, 1, At, B1); PG8_BAR;
            PG8_LDA(At, 1, 1); PG8_STAGE(PG8_SA(1, 0), a3, voffA);
            PG8_BAR; PG8_WAIT_L(0); PG8_MMA(1, 0, At, B0); PG8_BAR; PG8_SCHED;
            PG8_STAGE(PG8_SB(1, 1), b3 + hstep, voffB);
            PG8_WAIT_V(6); PG8_BAR; PG8_MMA(1, 1, At, B1); PG8_BAR;
            }
        }
        if constexpr (ALIGN_EPI) { if (wr == 0) PG8_BAR; }
        if constexpr (!Epi::AFTER_DRAIN) { E(acc, cur, wr, wc, fr, fq); S.done(cur); }
        if (!has_next) break;
#pragma unroll
        for (int a = 0; a < 2; ++a)
#pragma unroll
            for (int b = 0; b < 2; ++b)
#pragma unroll
                for (int m = 0; m < 4; ++m)
#pragma unroll
                    for (int n = 0; n < 2; ++n) acc[a][b][m][n] = (f32x4){0.f, 0.f, 0.f, 0.f};
        cur = nxt; cA = nA; cB = nB; ++ui;
        if constexpr (ALIGN_EPI) { if (wr == 1) PG8_BAR; }
    }
    PG8_WAIT_V(0);
    if constexpr (!ALIGN_EPI) { if (wr == 0) PG8_BAR; }
    PG8_BAR;
    if constexpr (Epi::AFTER_DRAIN) { E.fused(acc, cur, wr, wc, fr, fq, lds, wid, lane); S.done(cur); }
#undef PG8_SA
#undef PG8_SB
#undef PG8_STAGE
#undef PG8_LDA
#undef PG8_LDB
#undef PG8_MMA
#undef PG8_WAIT_V
#undef PG8_WAIT_L
#undef PG8_BAR
#undef PG8_SCHED
}
}
#ifndef MK_ONE_LAUNCH
#define MK_ONE_LAUNCH 1
#endif
constexpr int NWAVES = 8;
constexpr size_t MiB = 1u << 20;
constexpr size_t WS_CTL = 0, CTL_ZERO_BYTES = 1 * MiB;
constexpr size_t WS_MODF = 1 * MiB;
constexpr size_t WS_ROPE = 2 * MiB;
constexpr size_t WS_IFG = 10 * MiB;
constexpr size_t WS_WIN = 12 * MiB;
constexpr size_t WS_WBR = 32 * MiB;
constexpr size_t WS_WOUT = 38 * MiB;
constexpr size_t WS_WFF1 = 40 * MiB;
constexpr size_t WS_WFF2 = 48 * MiB;
constexpr size_t WS_ACT = 56 * MiB;
constexpr size_t WS_RET = 88 * MiB, WS_LRU = 120 * MiB, WS_MLS = 152 * MiB;
constexpr size_t WS_MQ = 184 * MiB, WS_MK = 216 * MiB, WS_MV = 248 * MiB;
constexpr size_t WS_PROJ = 280 * MiB;
constexpr size_t WS_END = 600 * MiB;
constexpr int LDS_BYTES = 147456;
constexpr int RING_BYTES = 131072, MISC_OFF = RING_BYTES + 320;

#define GAS __attribute__((address_space(1)))
#define LAS __attribute__((address_space(3)))
typedef unsigned short bf16;
typedef unsigned v4u __attribute__((ext_vector_type(4)));
typedef unsigned v2u __attribute__((ext_vector_type(2)));
typedef float f32x4 __attribute__((ext_vector_type(4)));
typedef float f32x2v __attribute__((ext_vector_type(2)));
#define LDS_WAIT() asm volatile("s_waitcnt lgkmcnt(0)" ::: "memory")
#define VM_WAIT() asm volatile("s_waitcnt vmcnt(0)" ::: "memory")
__device__ __forceinline__ unsigned f2bf(float f) { unsigned u = __builtin_bit_cast(unsigned, f); return (u + 0x7fffu + ((u >> 16) & 1u)) >> 16; }
__device__ __forceinline__ unsigned pk2(float lo, float hi) { return f2bf(lo) | (f2bf(hi) << 16); }
__device__ __forceinline__ float bf2f(unsigned short h) { return __builtin_bit_cast(float, (unsigned)h << 16); }
__device__ __forceinline__ float bflo(unsigned w) { return __builtin_bit_cast(float, w << 16); }
__device__ __forceinline__ float bfhi(unsigned w) { return __builtin_bit_cast(float, w & 0xffff0000u); }
__device__ __forceinline__ float sigmoidf_(float x) { return 1.0f / (1.0f + __expf(-x)); }
__device__ __forceinline__ float wave_sum(float v) {
#pragma unroll
    for (int o = 1; o < 64; o <<= 1) v += __shfl_xor(v, o);
    return v;
}
#define XB_TMO      128
#define XB_XCNT(j)  (256  + 64 * (j))
#define XB_XSUB(j)  (1280 + 64 * (j))
#define XB_XGEN(j)  (2304 + 64 * (j))
#define XB_TOP      3328
#define XB_TOPGEN   3392
#define XCD_BAR_WORDS 3456
#define XB_SPIN_CAP (1u << 18)

__device__ __forceinline__ unsigned xb_ld(unsigned* p)              { return __hip_atomic_load(p, __ATOMIC_RELAXED, __HIP_MEMORY_SCOPE_AGENT); }
__device__ __forceinline__ unsigned xb_add(unsigned* p, unsigned v) { return __hip_atomic_fetch_add(p, v, __ATOMIC_RELAXED, __HIP_MEMORY_SCOPE_AGENT); }
__device__ __forceinline__ unsigned xb_xcc_id() { return (unsigned)__builtin_amdgcn_s_getreg((3 << 11) | 20) & 0xFu; }
#define XB_SPIN(cond, bar) do { unsigned _sp = 0; while (cond) { __builtin_amdgcn_s_sleep(1); \
    if ((++_sp & 255u) == 0u) { if (xb_ld(&(bar)[XB_TMO])) break; if (_sp > XB_SPIN_CAP) { atomicAdd(&(bar)[XB_TMO], 1u); break; } } } } while (0)

struct XcdBarrier {
    unsigned* bar; unsigned x;
    volatile LAS unsigned* st;
};

__device__ __forceinline__ XcdBarrier xcd_barrier_post(unsigned* bar, volatile LAS unsigned* st) {
    XcdBarrier b; b.bar = bar; b.x = xb_xcc_id(); b.st = st;
    if (threadIdx.x == 0) (void)xb_add(&bar[XB_XCNT(b.x)], 1u);
    return b;
}
__device__ __forceinline__ void xcd_barrier_complete(unsigned* bar, unsigned x, unsigned& nloc, unsigned& nx) {
    const unsigned G = gridDim.x * gridDim.y * gridDim.z;
    unsigned sum, cnt, mine, sp = 0u;
    for (;;) {
        sum = 0u; cnt = 0u; mine = 0u;
#pragma unroll
        for (unsigned j = 0; j < 16; ++j) { const unsigned c = xb_ld(&bar[XB_XCNT(j)]); sum += c; cnt += (c > 0u) ? 1u : 0u; mine = (j == x) ? c : mine; }
        if (sum == G) break;
        __builtin_amdgcn_s_sleep(1);
        if ((++sp & 255u) == 0u) { if (xb_ld(&bar[XB_TMO])) break; if (sp > XB_SPIN_CAP) { atomicAdd(&bar[XB_TMO], 1u); break; } }
    }
    nloc = mine > 0u ? mine : 1u; nx = cnt > 0u ? cnt : 1u;
}

__device__ __forceinline__ void xcd_barrier(const XcdBarrier& b) {
    asm volatile("s_waitcnt vmcnt(0)" ::: "memory");
    __syncthreads();
    if (threadIdx.x == 0) {
        unsigned* bar = b.bar;
        __builtin_amdgcn_s_waitcnt(0);
        unsigned nloc = b.st[0], nx = b.st[1];
        if (nloc == 0u) { xcd_barrier_complete(bar, b.x, nloc, nx); b.st[0] = nloc; b.st[1] = nx; }
        const unsigned old = xb_add(&bar[XB_XSUB(b.x)], 1u);
        const unsigned gen = old / nloc;
        if (old + 1u == (gen + 1u) * nloc) {
            __builtin_amdgcn_fence(__ATOMIC_RELEASE, "agent");
            asm volatile("s_waitcnt vmcnt(0)" ::: "memory");
            const unsigned og = xb_add(&bar[XB_TOP], 1u);
            const unsigned tg = og / nx;
            if (og + 1u == (tg + 1u) * nx) xb_add(&bar[XB_TOPGEN], 1u);
            else XB_SPIN(xb_ld(&bar[XB_TOPGEN]) == tg, bar);
            __builtin_amdgcn_fence(__ATOMIC_ACQUIRE, "agent");
            xb_add(&bar[XB_XGEN(b.x)], 1u);
            asm volatile("s_waitcnt vmcnt(0)" ::: "memory");
        } else {
            XB_SPIN(xb_ld(&bar[XB_XGEN(b.x)]) == gen, bar);
            __builtin_amdgcn_fence(__ATOMIC_ACQUIRE, "agent");
            asm volatile("s_waitcnt vmcnt(0)" ::: "memory");
        }
    }
    __syncthreads();
}
__device__ __forceinline__ void p0_transpose_item(const float* W, int K, int N, bf16* WT, int row_off, LAS float* scr, int item, int lane) {
    const int nblk = N / 32, kb = item / nblk, nb = item % nblk, k0 = 64 * kb, n0 = 32 * nb;
#pragma unroll 8
    for (int i = 0; i < 32; ++i) { const int kk = 2 * i + (lane >> 5); scr[kk * 33 + (lane & 31)] = W[(size_t)(k0 + kk) * N + n0 + (lane & 31)]; }
    LDS_WAIT(); asm volatile("" ::: "memory");
    const int c = lane & 7;
#pragma unroll
    for (int j = 0; j < 4; ++j) { const int n = (lane >> 3) + 8 * j; const LAS float* s = scr + (8 * c) * 33 + n;
        v4u o; o.x = pk2(s[0 * 33], s[1 * 33]); o.y = pk2(s[2 * 33], s[3 * 33]); o.z = pk2(s[4 * 33], s[5 * 33]); o.w = pk2(s[6 * 33], s[7 * 33]);
        *(GAS v4u*)(WT + (size_t)(row_off + n0 + n) * K + k0 + 8 * c) = o; }
    LDS_WAIT(); asm volatile("" ::: "memory");
}
struct Ctx {
    LAS unsigned char* lds;
    int tid, lane, wave, vcu, G, bx;
};

__device__ __forceinline__ void p0_prologue(const Ctx& F, const float* x, const float* c, const int* positions, const float* w_ada, const float* b_ada,
                                            float* modf, f32x2v* rope, float* xw) {
    LAS float* cond = (LAS float*)F.lds;
    LAS float* red = (LAS float*)(F.lds + 32768);
    for (int i = F.tid; i < NB * DM; i += 512) { const float v = c[i]; cond[i] = v / (1.f + __expf(-v)); }
    __syncthreads();
    const int col = F.tid & 63, ks = F.tid >> 6;
    for (int it = F.vcu; it < NL * 96; it += F.G) {
        const int l = it / 96, cg = it % 96, n = cg * 64 + col;
        const float* w = w_ada + ((size_t)l * DM + ks * 128) * (6 * DM) + n;
        float acc[8];
#pragma unroll
        for (int b = 0; b < 8; ++b) acc[b] = 0.f;
#pragma unroll 8
        for (int k = 0; k < 128; ++k) { const float wv = w[(size_t)k * (6 * DM)];
#pragma unroll
            for (int b = 0; b < 8; ++b) acc[b] += cond[b * DM + ks * 128 + k] * wv; }
#pragma unroll
        for (int b = 0; b < 8; ++b) red[(ks * 8 + b) * 64 + col] = acc[b];
        __syncthreads();
        { const int b = F.tid >> 6; float s = b_ada[l * 6 * DM + n];
#pragma unroll
          for (int k2 = 0; k2 < 8; ++k2) s += red[(k2 * 8 + b) * 64 + col];
          modf[((size_t)l * NB + b) * (6 * DM) + n] = s; }
        __syncthreads();
    }
    const int gt = F.vcu * 512 + F.tid, NT = F.G * 512;
    for (int idx = gt; idx < M * 64; idx += NT) { const int tok = idx >> 6, i = idx & 63;
        const float inv = powf(10000.0f, -(float)i * (1.0f / 64.0f)); const float ang = (float)positions[tok] * inv;
        float sn, cs; sincosf(ang, &sn, &cs); rope[idx] = (f32x2v){cs, sn}; }
    for (int idx = gt; idx < M * DM / 4; idx += NT) ((f32x4*)xw)[idx] = ((const f32x4*)x)[idx];
}

__device__ __forceinline__ void convert_weights(const Ctx& F, const float* w_in, const float* w_br0, const float* w_br1, const float* w_br2, const float* w_out,
                                                const float* w_ff1, const float* w_ff2, bf16* Win, bf16* Wbr, bf16* Wout, bf16* Wff1, bf16* Wff2) {
    LAS float* scr = (LAS float*)(F.lds + F.wave * 16384);
    const int gw = F.vcu * NWAVES + F.wave, NGW = F.G * NWAVES;
    constexpr int I_IN = (DM / 64) * (DIN / 32), I_SQ = (DM / 64) * (DM / 32), I_F1 = (DM / 64) * (DFF / 32), I_F2 = (DFF / 64) * (DM / 32);
    constexpr int NITEMS = I_IN + 4 * I_SQ + I_F1 + I_F2;
    for (int it = gw; it < NITEMS; it += NGW) {
        int r = it;
        if (r < I_IN) { p0_transpose_item(w_in, DM, DIN, Win, 0, scr, r, F.lane); continue; } r -= I_IN;
        if (r < I_SQ) { p0_transpose_item(w_br0, DM, DM, Wbr, 0, scr, r, F.lane); continue; } r -= I_SQ;
        if (r < I_SQ) { p0_transpose_item(w_br1, DM, DM, Wbr, DM, scr, r, F.lane); continue; } r -= I_SQ;
        if (r < I_SQ) { p0_transpose_item(w_br2, DM, DM, Wbr, 2 * DM, scr, r, F.lane); continue; } r -= I_SQ;
        if (r < I_SQ) { p0_transpose_item(w_out, DM, DM, Wout, 0, scr, r, F.lane); continue; } r -= I_SQ;
        if (r < I_F1) { p0_transpose_item(w_ff1, DM, DFF, Wff1, 0, scr, r, F.lane); continue; } r -= I_F1;
        p0_transpose_item(w_ff2, DFF, DM, Wff2, 0, scr, r, F.lane);
    }
}

__device__ __forceinline__ void norm_phase(const Ctx& F, const float* xw, const float* gain, const float* sc, const float* sh, bf16* out) {
    const int gw = F.vcu * NWAVES + F.wave, NGW = F.G * NWAVES;
    for (int ri = gw; ri < M / 8; ri += NGW) {
        const int b = ri / (SEQ / 8);
        f32x4 A[4], Bv[4];
#pragma unroll
        for (int j = 0; j < 4; ++j) { const int cidx = 4 * F.lane + 256 * j;
            const f32x4 g = *(const f32x4*)(gain + cidx), s1 = *(const f32x4*)(sc + (size_t)b * 6 * DM + cidx); A[j] = g * (s1 + 1.0f); Bv[j] = *(const f32x4*)(sh + (size_t)b * 6 * DM + cidx); }
        for (int r = 0; r < 8; ++r) { const size_t row = (size_t)ri * 8 + r;
            const f32x4* xr = (const f32x4*)(xw + row * DM) + F.lane;
            f32x4 v[4]; float ss = 0.f;
#pragma unroll
            for (int j = 0; j < 4; ++j) { v[j] = xr[64 * j]; ss += (v[j].x * v[j].x + v[j].y * v[j].y) + (v[j].z * v[j].z + v[j].w * v[j].w); }
            const float rs = rsqrtf(wave_sum(ss) * (1.0f / DM) + EPSF);
            unsigned long long* o8 = (unsigned long long*)(out + row * DM) + F.lane;
#pragma unroll
            for (int j = 0; j < 4; ++j) { const f32x4 o = v[j] * rs * A[j] + Bv[j];
                o8[64 * j] = (unsigned long long)pk2(o.x, o.y) | ((unsigned long long)pk2(o.z, o.w) << 32); } }
    }
}
__device__ __forceinline__ void final_norm_phase(const Ctx& F, float* xw, const float* gain) {
    const int gw = F.vcu * NWAVES + F.wave, NGW = F.G * NWAVES;
    f32x4 A[4];
#pragma unroll
    for (int j = 0; j < 4; ++j) A[j] = *(const f32x4*)(gain + 4 * F.lane + 256 * j);
    for (int row = gw; row < M; row += NGW) {
        f32x4* xr = (f32x4*)(xw + (size_t)row * DM) + F.lane;
        f32x4 v[4]; float ss = 0.f;
#pragma unroll
        for (int j = 0; j < 4; ++j) { v[j] = xr[64 * j]; ss += (v[j].x * v[j].x + v[j].y * v[j].y) + (v[j].z * v[j].z + v[j].w * v[j].w); }
        const float rs = rsqrtf(wave_sum(ss) * (1.0f / DM) + EPSF);
#pragma unroll
        for (int j = 0; j < 4; ++j) xr[64 * j] = v[j] * rs * A[j];
    }
}

__device__ __forceinline__ void mlstm_pre(const Ctx& F, const bf16* proj, const float* conv_w, const float* conv_b, const float* wq, const float* wk, const float* wv,
                                          const float* w_if, const float* b_if, bf16* MQ, bf16* MK, bf16* MV, float* IFG) {
    LAS f32x4* wif = (LAS f32x4*)F.lds;
    LAS float* part = (LAS float*)(F.lds + 98304);
    for (int e = F.tid; e < 3 * DM * 8; e += 512) { const int j = e >> 3, g = e & 7, src = j >> 10, ch = j & 1023, nb = ch >> 2, d = ch & 3, vi = (src * 4 + d) * 8 + g;
        ((LAS float*)wif)[((vi >> 2) * 256 + nb) * 4 + (vi & 3)] = w_if[e]; }
    const int u = F.tid & 255, rg = F.tid >> 8, c0 = 4 * u, wrun = F.wave & 3;
    f32x4 cw[4], Wq[4], Wk[4], Wv[4];
#pragma unroll
    for (int k = 0; k < 4; ++k) { cw[k] = *(const f32x4*)(conv_w + k * DM + c0); Wq[k] = *(const f32x4*)(wq + u * 16 + k * 4); Wk[k] = *(const f32x4*)(wk + u * 16 + k * 4); Wv[k] = *(const f32x4*)(wv + u * 16 + k * 4); }
    const f32x4 cb = *(const f32x4*)(conv_b + c0);
    __syncthreads();
    for (int rr = F.vcu; rr < M / 64; rr += F.G) {
        const int r = 2 * rr + rg, t0 = (r & 63) * 32;
        const bf16* mx = proj + (size_t)r * 32 * DIN + OFF_MX + c0;
        f32x4 x0 = {0.f, 0.f, 0.f, 0.f}, x1 = x0, x2 = x0;
        if (t0 != 0) { v2u a = *(const v2u*)(mx - 3 * (size_t)DIN), b = *(const v2u*)(mx - 2 * (size_t)DIN), cc = *(const v2u*)(mx - (size_t)DIN);
            x0 = (f32x4){bflo(a.x), bfhi(a.x), bflo(a.y), bfhi(a.y)}; x1 = (f32x4){bflo(b.x), bfhi(b.x), bflo(b.y), bfhi(b.y)}; x2 = (f32x4){bflo(cc.x), bfhi(cc.x), bflo(cc.y), bfhi(cc.y)}; }
#pragma unroll 1
        for (int tt = 0; tt < 32; ++tt) {
            const size_t row = (size_t)r * 32 + tt;
            const v2u xr = *(const v2u*)(mx + (size_t)tt * DIN);
            const f32x4 x3 = {bflo(xr.x), bfhi(xr.x), bflo(xr.y), bfhi(xr.y)};
            f32x4 cv = cb + cw[0] * x0 + cw[1] * x1 + cw[2] * x2 + cw[3] * x3;
            f32x4 xc; xc.x = cv.x * sigmoidf_(cv.x); xc.y = cv.y * sigmoidf_(cv.y); xc.z = cv.z * sigmoidf_(cv.z); xc.w = cv.w * sigmoidf_(cv.w);
            const f32x4 q = Wq[0] * xc.x + Wq[1] * xc.y + Wq[2] * xc.z + Wq[3] * xc.w;
            const f32x4 k = Wk[0] * xc.x + Wk[1] * xc.y + Wk[2] * xc.z + Wk[3] * xc.w;
            const f32x4 v = Wv[0] * x3.x + Wv[1] * x3.y + Wv[2] * x3.z + Wv[3] * x3.w;
            *(v2u*)(MQ + row * DM + c0) = (v2u){pk2(q.x, q.y), pk2(q.z, q.w)};
            *(v2u*)(MK + row * DM + c0) = (v2u){pk2(k.x, k.y), pk2(k.z, k.w)};
            *(v2u*)(MV + row * DM + c0) = (v2u){pk2(v.x, v.y), pk2(v.z, v.w)};
            f32x4 pa = {0.f, 0.f, 0.f, 0.f}, pb = pa;
            const float vals[12] = {q.x, q.y, q.z, q.w, k.x, k.y, k.z, k.w, v.x, v.y, v.z, v.w};
#pragma unroll
            for (int sd = 0; sd < 12; ++sd) { pa += wif[(sd * 2) * 256 + u] * vals[sd]; pb += wif[(sd * 2 + 1) * 256 + u] * vals[sd]; }
            const bool b0 = F.lane & 1, b1 = F.lane & 2, b2 = F.lane & 4;
            float a4[4];
#pragma unroll
            for (int i = 0; i < 4; ++i) { const float snd = b0 ? pa[i] : pb[i], kp = b0 ? pb[i] : pa[i]; a4[i] = kp + __shfl_xor(snd, 1); }
            float c2[2];
#pragma unroll
            for (int i = 0; i < 2; ++i) { const float snd = b1 ? a4[i] : a4[i + 2], kp = b1 ? a4[i + 2] : a4[i]; c2[i] = kp + __shfl_xor(snd, 2); }
            float d1; { const float snd = b2 ? c2[0] : c2[1], kp = b2 ? c2[1] : c2[0]; d1 = kp + __shfl_xor(snd, 4); }
            d1 += __shfl_xor(d1, 8); d1 += __shfl_xor(d1, 16); d1 += __shfl_xor(d1, 32);
            if (F.lane < 8) { const int gi = 4 * (F.lane & 1) + 2 * ((F.lane >> 1) & 1) + ((F.lane >> 2) & 1); part[((rg * 32 + tt) * 4 + wrun) * 8 + gi] = d1; }
            x0 = x1; x1 = x2; x2 = x3;
        }
        __syncthreads();
        { const int rg2 = F.tid >> 8, tt = (F.tid >> 3) & 31, g = F.tid & 7; const LAS float* p = part + ((rg2 * 32 + tt) * 4) * 8 + g;
          IFG[((size_t)(2 * rr + rg2) * 32 + tt) * 8 + g] = (p[0] + p[8]) + (p[16] + p[24]) + b_if[g]; }
        __syncthreads();
    }
}

__device__ __forceinline__ float log_sigmoid_f(float x) { return x >= 0.f ? -log1pf(expf(-x)) : x - log1pf(expf(x)); }
__device__ __forceinline__ float gelu_tanh_f(float x) { return 0.5f * x * (1.0f + tanhf(0.7978845608028654f * (x + 0.044715f * x * x * x))); }

__device__ __forceinline__ void mlstm_simple(const Ctx& F, int b, int h, const bf16* MQ, const bf16* MK, const bf16* MV, const float* IFG, const bf16* proj, const float* m_norm, bf16* MLS) {
    LAS float* qs = (LAS float*)F.lds;
    LAS float* ks = qs + 2048;
    LAS float* vs = ks + 2048;
    LAS float* nump = vs + 2048;
    LAS float* gi = nump + 4096;
    LAS float* gf = gi + 8;
    LAS float* ms = gf + 8;
    LAS float* denp = ms + 8;
    const int e = F.tid & 255, half = F.tid >> 8;
    float C[128];
#pragma unroll
    for (int d = 0; d < 128; ++d) C[d] = 0.f;
    float nown = 0.f, m = 0.f;
    __syncthreads();
    for (int tile = 0; tile < SEQ / 8; ++tile) {
        const size_t row0 = (size_t)b * SEQ + tile * 8;
        for (int i = F.tid; i < 2048; i += 512) { const int tk = i >> 8, ee = i & 255; const size_t o = (row0 + tk) * DM + h * 256 + ee;
            qs[i] = bf2f(MQ[o]); ks[i] = bf2f(MK[o]) * 0.0625f; vs[i] = bf2f(MV[o]); }
        if (F.tid < 8) { gi[F.tid] = IFG[(row0 + F.tid) * 8 + h]; gf[F.tid] = log_sigmoid_f(IFG[(row0 + F.tid) * 8 + 4 + h]); }
        __syncthreads();
#pragma unroll 1
        for (int tk = 0; tk < 8; ++tk) {
            const float it = gi[tk], lf = gf[tk], mn = fmaxf(lf + m, it), fs = __expf(lf + m - mn), is = __expf(it - mn); m = mn;
            const float isv = is * vs[tk * 256 + e];
            const LAS f32x4* k4 = (const LAS f32x4*)(ks + tk * 256 + half * 128);
            const LAS f32x4* q4 = (const LAS f32x4*)(qs + tk * 256 + half * 128);
            float num = 0.f;
#pragma unroll
            for (int d4 = 0; d4 < 32; ++d4) { const f32x4 kk = k4[d4], qq = q4[d4];
                C[4 * d4 + 0] = fs * C[4 * d4 + 0] + isv * kk.x; num += C[4 * d4 + 0] * qq.x;
                C[4 * d4 + 1] = fs * C[4 * d4 + 1] + isv * kk.y; num += C[4 * d4 + 1] * qq.y;
                C[4 * d4 + 2] = fs * C[4 * d4 + 2] + isv * kk.z; num += C[4 * d4 + 2] * qq.z;
                C[4 * d4 + 3] = fs * C[4 * d4 + 3] + isv * kk.w; num += C[4 * d4 + 3] * qq.w; }
            nump[(tk * 2 + half) * 256 + e] = num;
            if (half == 0) { nown = fs * nown + is * ks[tk * 256 + e]; const float dp = wave_sum(nown * qs[tk * 256 + e]); if (F.lane == 0) denp[tk * 4 + F.wave] = dp; }
            if (F.tid == 0) ms[tk] = mn;
        }
        __syncthreads();
        { const int tk = F.wave; const size_t row = row0 + tk;
          const float den = (denp[tk * 4 + 0] + denp[tk * 4 + 1]) + (denp[tk * 4 + 2] + denp[tk * 4 + 3]);
          const float dn = fmaxf(fabsf(den), __expf(-ms[tk])), rdn = 1.0f / dn;
          float hm[4], ss = 0.f;
#pragma unroll
          for (int j = 0; j < 4; ++j) { const int ee = F.lane + 64 * j; const float hh = (nump[(tk * 2) * 256 + ee] + nump[(tk * 2 + 1) * 256 + ee]) * rdn;
              hm[j] = hh * sigmoidf_(bf2f(proj[row * DIN + OFF_MO + h * 256 + ee])); ss += hm[j] * hm[j]; }
          const float rs = rsqrtf(wave_sum(ss) * (1.0f / 256.0f) + EPSF);
#pragma unroll
          for (int j = 0; j < 4; ++j) { const int ee = F.lane + 64 * j; MLS[row * DM + h * 256 + ee] = (bf16)f2bf(hm[j] * rs * m_norm[h * 256 + ee]); } }
        __syncthreads();
    }
}

__device__ __forceinline__ void ret_simple(const Ctx& F, int b, int h, const bf16* proj, const f32x2v* rope, bf16* RET) {
    LAS float* qs = (LAS float*)F.lds;
    LAS float* ks = qs + 1024;
    LAS float* vs = ks + 1024;
    LAS float* op = vs + 2048;
    const int e = F.tid & 255, half = F.tid >> 8;
    const float gamma = 1.0f - exp2f(-5.0f - (float)h);
    float S[64];
#pragma unroll
    for (int d = 0; d < 64; ++d) S[d] = 0.f;
    __syncthreads();
    for (int tile = 0; tile < SEQ / 8; ++tile) {
        const size_t row0 = (size_t)b * SEQ + tile * 8;
        for (int idx = F.tid; idx < 1024; idx += 512) { const int which = idx >> 9, tk = (idx >> 6) & 7, i = idx & 63; const size_t row = row0 + tk;
            const bf16* src = proj + row * DIN + (which ? OFF_RK : OFF_RQ) + h * 128;
            const float x1 = bf2f(src[i]), x2 = bf2f(src[64 + i]); const f32x2v cs = rope[row * 64 + i];
            const float sc = which ? 0.08838834764831845f : 1.0f;
            LAS float* dst = (which ? ks : qs) + tk * 128;
            dst[i] = (x1 * cs.x - x2 * cs.y) * sc; dst[64 + i] = (x1 * cs.y + x2 * cs.x) * sc; }
        for (int i = F.tid; i < 2048; i += 512) { const int tk = i >> 8, ee = i & 255; vs[i] = bf2f(proj[(row0 + tk) * DIN + OFF_RV + h * 256 + ee]); }
        __syncthreads();
#pragma unroll 1
        for (int tk = 0; tk < 8; ++tk) {
            const float ve = vs[tk * 256 + e];
            const LAS f32x4* k4 = (const LAS f32x4*)(ks + tk * 128 + half * 64);
            const LAS f32x4* q4 = (const LAS f32x4*)(qs + tk * 128 + half * 64);
            float o = 0.f;
#pragma unroll
            for (int d4 = 0; d4 < 16; ++d4) { const f32x4 kk = k4[d4], qq = q4[d4];
                S[4 * d4 + 0] = gamma * S[4 * d4 + 0] + ve * kk.x; o += S[4 * d4 + 0] * qq.x;
                S[4 * d4 + 1] = gamma * S[4 * d4 + 1] + ve * kk.y; o += S[4 * d4 + 1] * qq.y;
                S[4 * d4 + 2] = gamma * S[4 * d4 + 2] + ve * kk.z; o += S[4 * d4 + 2] * qq.z;
                S[4 * d4 + 3] = gamma * S[4 * d4 + 3] + ve * kk.w; o += S[4 * d4 + 3] * qq.w; }
            op[(tk * 2 + half) * 256 + e] = o;
        }
        __syncthreads();
        { const int tk = F.wave; const size_t row = row0 + tk;
          float ov[4], ss = 0.f;
#pragma unroll
          for (int j = 0; j < 4; ++j) { const int ee = F.lane + 64 * j; ov[j] = op[(tk * 2) * 256 + ee] + op[(tk * 2 + 1) * 256 + ee]; ss += ov[j] * ov[j]; }
          const float rs = rsqrtf(wave_sum(ss) * (1.0f / 256.0f) + EPSF);
#pragma unroll
          for (int j = 0; j < 4; ++j) { const int ee = F.lane + 64 * j; const float g = bf2f(proj[row * DIN + OFF_RG + h * 256 + ee]);
              RET[row * DM + h * 256 + ee] = (bf16)f2bf(ov[j] * rs * (g * sigmoidf_(g))); } }
        __syncthreads();
    }
}

__device__ __forceinline__ void lru_simple(const Ctx& F, int b, int cb, const bf16* proj, const float* conv_w, const float* conv_b, const float* w_r, const float* b_r,
                                           const float* w_i, const float* b_i, const float* lam, bf16* LRU) {
    LAS float* wr = (LAS float*)F.lds;
    LAS float* wi = wr + 4096;
    LAS float* xls = wi + 4096;
    LAS float* as_ = xls + 512;
    LAS float* us = as_ + 512;
    LAS float* hs = us + 512;
    __syncthreads();
    for (int i = F.tid; i < 4096; i += 512) { wr[i] = w_r[(size_t)cb * 4096 + i]; wi[i] = w_i[(size_t)cb * 4096 + i]; }
    const int ch = F.tid & 63, tt = F.tid >> 6, gch = cb * 64 + ch;
    float cw[4];
#pragma unroll
    for (int k = 0; k < 4; ++k) cw[k] = conv_w[k * DM + gch];
    const float cbias = conv_b[gch], br = b_r[gch], bi = b_i[gch];
    const float lm = lam[gch], sp = (-lm > 20.f) ? -lm : log1pf(expf(-lm));
    float hstate = 0.f;
    __syncthreads();
    for (int tile = 0; tile < SEQ / 8; ++tile) {
        const int t = tile * 8 + tt; const size_t row = (size_t)b * SEQ + t;
        float xl = cbias;
#pragma unroll
        for (int k = 0; k < 4; ++k) { const int ts = t - 3 + k; if (ts >= 0) xl += cw[k] * bf2f(proj[((size_t)b * SEQ + ts) * DIN + OFF_LX + gch]); }
        xls[tt * 64 + ch] = xl;
        __syncthreads();
        float rp = br, ip = bi;
#pragma unroll 16
        for (int d = 0; d < 64; ++d) { const float xv = xls[tt * 64 + d]; rp += xv * wr[d * 64 + ch]; ip += xv * wi[d * 64 + ch]; }
        const float r = sigmoidf_(rp), ig = sigmoidf_(ip), log_a = -8.0f * r * sp, a = expf(log_a);
        as_[tt * 64 + ch] = a; us[tt * 64 + ch] = sqrtf(-expm1f(2.0f * log_a)) * (ig * xl);
        __syncthreads();
        if (F.wave == 0) {
#pragma unroll
            for (int k = 0; k < 8; ++k) { hstate = as_[k * 64 + F.lane] * hstate + us[k * 64 + F.lane]; hs[k * 64 + F.lane] = hstate; } }
        __syncthreads();
        LRU[row * DM + gch] = (bf16)f2bf(hs[tt * 64 + ch] * gelu_tanh_f(bf2f(proj[row * DIN + OFF_LY + gch])));
    }
}
enum { I_X = 0, I_C, I_POS, I_WADA, I_BADA, I_NMIX, I_NMLP, I_WIN, I_LCW, I_LCB, I_LWR, I_LBR, I_LWI, I_LBI, I_LLAM, I_MCW, I_MCB, I_MWQ, I_MWK, I_MWV, I_MWIF, I_MBIF, I_MNORM,
       I_WBR0, I_WBR1, I_WBR2, I_WOUT, I_WFF1, I_WFF2, I_FNORM, N_INPUTS };
constexpr int PH_PER_LAYER = 9, N_PHASES = 2 + NL * PH_PER_LAYER;
struct Args { const float* in[N_INPUTS]; float* out; unsigned char* ws; int ph_lo, ph_hi; };
static_assert(sizeof(Args) == N_INPUTS * 8 + 8 + 8 + 8, "Args has no padding bytes");

__device__ __forceinline__ const float* inp(const Args& a, int i) { asm volatile("" : "+s"(i)); return a.in[i]; }
__device__ __forceinline__ unsigned char* wsbase(const Args& a) { int z = 0; asm volatile("" : "+s"(z)); return (&a.ws)[z]; }
__device__ __forceinline__ int phlo(const Args& a) { int z = 0; asm volatile("" : "+s"(z)); return (&a.ph_lo)[z]; }
__device__ __forceinline__ int phhi(const Args& a) { int z = 0; asm volatile("" : "+s"(z)); return (&a.ph_hi)[z]; }
__device__ __forceinline__ bool in_range(const Args& a, int k) { return phlo(a) <= k && k < phhi(a); }
__device__ __forceinline__ bool seam_here(const Args& a, int k) { return phlo(a) <= k && k + 1 < phhi(a); }
__device__ __forceinline__ float* outp(const Args& a) { int z = 0; asm volatile("" : "+s"(z)); return (&a.out)[z]; }
__device__ __forceinline__ Ctx make_ctx(LAS unsigned char* lds) {
    Ctx F; int g = (int)gridDim.x, bx = (int)blockIdx.x, t = (int)threadIdx.x;
    asm volatile("" : "+s"(g), "+s"(bx), "+v"(t));
    F.lds = lds; F.tid = t; F.lane = t & 63; F.wave = __builtin_amdgcn_readfirstlane(t >> 6); F.G = g; F.bx = bx; F.vcu = (g % 8 == 0) ? (bx % 8) * (g / 8) + bx / 8 : bx;
    return F;
}
__global__ void __launch_bounds__(NWAVES * 64, 2) fwd(Args args) {
    extern __shared__ __attribute__((aligned(16))) unsigned char lds_raw[];
    LAS unsigned char* const ldsb = (LAS unsigned char*)lds_raw;
    volatile LAS unsigned* MISC = (volatile LAS unsigned*)(ldsb + MISC_OFF);
    for (int u = threadIdx.x; u < (LDS_BYTES - RING_BYTES) / 4; u += NWAVES * 64) ((LAS unsigned*)(ldsb + RING_BYTES))[u] = 0u;
    __syncthreads();
    { const int span = phhi(args) - phlo(args);
      if (span > 1) (void)xcd_barrier_post((unsigned*)(wsbase(args) + WS_CTL) + 4096, MISC + 8); }
#ifndef PMASK
#define PMASK 0xFFFF
#endif
#define IN(k) in_range(args, (k))
#define PH(j) ((PMASK >> (j)) & 1)
#define SEAM(k) do { if (seam_here(args, (k))) { XcdBarrier b_; b_.bar = (unsigned*)(wsbase(args) + WS_CTL) + 4096; b_.x = xb_xcc_id(); b_.st = MISC + 8; xcd_barrier(b_); } } while (0)

#define INP(i) inp(args, (i))
#define WSP(T, off) ((T*)(wsbase(args) + (off)))
    if (PH(9) && IN(0)) { const Ctx F = make_ctx(ldsb); p0_prologue(F, INP(I_X), INP(I_C), (const int*)INP(I_POS), INP(I_WADA), INP(I_BADA), WSP(float, WS_MODF), WSP(f32x2v, WS_ROPE), outp(args)); }
    SEAM(0);

    for (int l = 0; l < NL; ++l) {
        const int kb = 1 + l * PH_PER_LAYER;
#define MOD_L(j) (WSP(float, WS_MODF) + ((size_t)l * NB * 6 + (j)) * DM)
        if (PH(0) && IN(kb + 0)) { const Ctx F = make_ctx(ldsb);
            convert_weights(F, INP(I_WIN) + (size_t)l * DM * DIN, INP(I_WBR0) + (size_t)l * DM * DM, INP(I_WBR1) + (size_t)l * DM * DM, INP(I_WBR2) + (size_t)l * DM * DM,
                            INP(I_WOUT) + (size_t)l * DM * DM, INP(I_WFF1) + (size_t)l * DM * DFF, INP(I_WFF2) + (size_t)l * DFF * DM,
                            WSP(bf16, WS_WIN), WSP(bf16, WS_WBR), WSP(bf16, WS_WOUT), WSP(bf16, WS_WFF1), WSP(bf16, WS_WFF2));
            norm_phase(F, outp(args), INP(I_NMIX) + l * DM, MOD_L(1), MOD_L(0), WSP(bf16, WS_ACT));
        }
        SEAM(kb + 0);
        if (PH(1) && IN(kb + 1)) { const Ctx F = make_ctx(ldsb); pg8::Gemm g{WSP(bf16, WS_ACT), WSP(bf16, WS_WIN), M, DIN, DM}; pg8::StaticOrder S; S.init(M, DIN, F.G, F.bx); pg8::EpiStore<0> E{WSP(bf16, WS_PROJ), DIN};
            pg8::gemm_phase<pg8::EpiStore<0>, pg8::StaticOrder, true, true>(F.lds, g, S, E); }
        SEAM(kb + 1);
        if (PH(2) && IN(kb + 2)) { const Ctx F = make_ctx(ldsb); mlstm_pre(F, WSP(bf16, WS_PROJ), INP(I_MCW) + l * 4 * DM, INP(I_MCB) + l * DM, INP(I_MWQ) + l * DM * 4, INP(I_MWK) + l * DM * 4, INP(I_MWV) + l * DM * 4,
                                  INP(I_MWIF) + (size_t)l * 3 * DM * 8, INP(I_MBIF) + l * 8, WSP(bf16, WS_MQ), WSP(bf16, WS_MK), WSP(bf16, WS_MV), WSP(float, WS_IFG)); }
        SEAM(kb + 2);
        if (PH(3) && IN(kb + 3)) { const Ctx F = make_ctx(ldsb);
            for (int it = F.vcu; it < 192; it += F.G) {
                if (it < 32) mlstm_simple(F, it >> 2, it & 3, WSP(bf16, WS_MQ), WSP(bf16, WS_MK), WSP(bf16, WS_MV), WSP(float, WS_IFG), WSP(bf16, WS_PROJ), INP(I_MNORM) + l * DM, WSP(bf16, WS_MLS));
                else if (it < 64) ret_simple(F, (it - 32) >> 2, (it - 32) & 3, WSP(bf16, WS_PROJ), WSP(f32x2v, WS_ROPE), WSP(bf16, WS_RET));
                else lru_simple(F, (it - 64) >> 4, (it - 64) & 15, WSP(bf16, WS_PROJ), INP(I_LCW) + l * 4 * DM, INP(I_LCB) + l * DM, INP(I_LWR) + (size_t)l * DM * 64, INP(I_LBR) + l * DM,
                                INP(I_LWI) + (size_t)l * DM * 64, INP(I_LBI) + l * DM, INP(I_LLAM) + l * DM, WSP(bf16, WS_LRU));
            }
        }
        SEAM(kb + 3);
        if (PH(4) && IN(kb + 4)) {
            { const Ctx F = make_ctx(ldsb); pg8::StaticOrder S; S.init(M, DM, F.G, F.bx); pg8::Gemm g{WSP(bf16, WS_RET), WSP(bf16, WS_WBR), M, DM, DM};
              pg8::EpiGate<0> E{WSP(bf16, WS_PROJ) + OFF_GATE, DIN, WSP(bf16, WS_MQ), nullptr, nullptr, DM}; pg8::gemm_phase<pg8::EpiGate<0>, pg8::StaticOrder, true, true>(F.lds, g, S, E); }
            { const Ctx F = make_ctx(ldsb); pg8::StaticOrder S; S.init(M, DM, F.G, F.bx); pg8::Gemm g{WSP(bf16, WS_LRU), WSP(bf16, WS_WBR) + (size_t)DM * DM, M, DM, DM};
              pg8::EpiGate<0> E{WSP(bf16, WS_PROJ) + OFF_GATE + DM, DIN, WSP(bf16, WS_MK), nullptr, nullptr, DM}; pg8::gemm_phase<pg8::EpiGate<0>, pg8::StaticOrder, true, true>(F.lds, g, S, E); }
            { const Ctx F = make_ctx(ldsb); pg8::StaticOrder S; S.init(M, DM, F.G, F.bx); pg8::Gemm g{WSP(bf16, WS_MLS), WSP(bf16, WS_WBR) + (size_t)2 * DM * DM, M, DM, DM};
              pg8::EpiGate<1> E{WSP(bf16, WS_PROJ) + OFF_GATE + 2 * DM, DIN, WSP(bf16, WS_ACT), WSP(bf16, WS_MQ), WSP(bf16, WS_MK), DM}; pg8::gemm_phase<pg8::EpiGate<1>, pg8::StaticOrder, true, true>(F.lds, g, S, E); }
        }
        SEAM(kb + 4);
        if (PH(5) && IN(kb + 5)) { const Ctx F = make_ctx(ldsb); pg8::Gemm g{WSP(bf16, WS_ACT), WSP(bf16, WS_WOUT), M, DM, DM}; pg8::StaticOrder S; S.init(M, DM, F.G, F.bx); pg8::EpiResid E{outp(args), MOD_L(2), 6 * DM};
            pg8::gemm_phase<pg8::EpiResid, pg8::StaticOrder, true, true>(F.lds, g, S, E); }
        SEAM(kb + 5);
        if (PH(6) && IN(kb + 6)) { const Ctx F = make_ctx(ldsb); norm_phase(F, outp(args), INP(I_NMLP) + l * DM, MOD_L(4), MOD_L(3), WSP(bf16, WS_ACT)); }
        SEAM(kb + 6);
        if (PH(7) && IN(kb + 7)) { const Ctx F = make_ctx(ldsb); pg8::Gemm g{WSP(bf16, WS_ACT), WSP(bf16, WS_WFF1), M, DFF, DM}; pg8::StaticOrder S; S.init(M, DFF, F.G, F.bx); pg8::EpiStore<2> E{WSP(bf16, WS_PROJ), DFF};
            pg8::gemm_phase<pg8::EpiStore<2>, pg8::StaticOrder, true, true>(F.lds, g, S, E); }
        SEAM(kb + 7);
        if (PH(8) && IN(kb + 8)) { const Ctx F = make_ctx(ldsb); pg8::Gemm g{WSP(bf16, WS_PROJ), WSP(bf16, WS_WFF2), M, DM, DFF}; pg8::StaticOrder S; S.init(M, DM, F.G, F.bx); pg8::EpiResid E{outp(args), MOD_L(5), 6 * DM};
            pg8::gemm_phase<pg8::EpiResid, pg8::StaticOrder, true, true>(F.lds, g, S, E); }
        SEAM(kb + 8);
    }
    if (PH(10) && IN(N_PHASES - 1)) { const Ctx F = make_ctx(ldsb); final_norm_phase(F, outp(args), INP(I_FNORM)); }
#undef INP
#undef WSP
#undef MOD_L
#undef IN
#undef SEAM
}

extern "C" void kernel_launch(void* const* d_in, const int* in_sizes, int n_in, void* d_out, int out_size, void* d_ws, size_t ws_size, hipStream_t stream) {
    static int grid = 0;
    if (grid == 0) {
        if (n_in != N_INPUTS || out_size != M * DM || ws_size < WS_END) { fprintf(stderr, "kernel_launch: unexpected shapes (n_in %d, out %d, ws %zu); nothing launched\n", n_in, out_size, ws_size); grid = -1; return; }
        int dev = 0, cus = 0, per_cu = 0;
        if (hipGetDevice(&dev) != hipSuccess || hipDeviceGetAttribute(&cus, hipDeviceAttributeMultiprocessorCount, dev) != hipSuccess) { grid = -1; return; }
        if (hipFuncSetAttribute((const void*)fwd, hipFuncAttributeMaxDynamicSharedMemorySize, LDS_BYTES) != hipSuccess) { grid = -1; return; }
        if (hipOccupancyMaxActiveBlocksPerMultiprocessor(&per_cu, (const void*)fwd, NWAVES * 64, LDS_BYTES) != hipSuccess || per_cu < 1) { fprintf(stderr, "kernel_launch: occupancy query says %d blocks per CU; nothing launched\n", per_cu); (void)hipGetLastError(); grid = -1; return; }
        grid = cus;
    }
    if (grid < 0) return;
    (void)hipMemsetAsync((char*)d_ws + WS_CTL, 0, CTL_ZERO_BYTES, stream);
    Args a{};
    for (int i = 0; i < N_INPUTS; ++i) a.in[i] = (const float*)d_in[i];
    a.out = (float*)d_out; a.ws = (unsigned char*)d_ws;
#if MK_ONE_LAUNCH
    a.ph_lo = 0; a.ph_hi = N_PHASES;
    hipLaunchKernelGGL(fwd, dim3(grid), dim3(NWAVES * 64), LDS_BYTES, stream, a);
#else
    for (int k = 0; k < N_PHASES; ++k) { a.ph_lo = k; a.ph_hi = k + 1; hipLaunchKernelGGL(fwd, dim3(grid), dim3(NWAVES * 64), LDS_BYTES, stream, a); }
#endif
}
```

```cpp
#include <hip/hip_runtime.h>
#include <cstdio>
#include <cstdint>
#include <cmath>
constexpr int NB = 8, SEQ = 2048, DM = 1024, DIN = 10240, DFF = 4096, NL = 4, M = NB * SEQ;
constexpr int OFF_RQ = 0, OFF_RK = 512, OFF_RV = 1024, OFF_RG = 2048, OFF_LX = 3072, OFF_LY = 4096, OFF_MX = 5120, OFF_MO = 6144, OFF_GATE = 7168;
constexpr float EPSF = 1e-6f;
#define MK_ONE_LAUNCH 1
namespace pg8 {
#define PG8_LAS __attribute__((address_space(3)))
typedef unsigned short bf16_t;
typedef short bf16x8 __attribute__((ext_vector_type(8)));
typedef float f32x4 __attribute__((ext_vector_type(4)));
typedef unsigned u32x4 __attribute__((ext_vector_type(4)));
constexpr int BM = 256, BK = 64, HALF = 128, HTB = HALF * BK * 2  , STAGE_BYTES = 8 * HTB, NXCD = 8, WGM = 8;

__host__ __device__ __forceinline__ int lds_byte(int r, int c) { const int st = (r >> 4) * 2 + (c >> 5), rr = r & 15, cc = c & 31, ob = rr * 64 + cc * 2; return st * 1024 + (ob ^ (((ob >> 9) & 1) << 5)); }
__host__ __device__ __forceinline__ void stage_rc(int b, int& R, int& C) { const int st = b / 1024, sb = b % 1024, swz = sb ^ (((sb >> 9) & 1) << 5); R = (st >> 1) * 16 + swz / 64; C = (st & 1) * 32 + (swz % 64) / 2; }
__host__ __device__ __forceinline__ int perm32(int rho) { const int n = rho >> 4, i = rho & 15; return 8 * (i >> 2) + 4 * n + (i & 3); }

struct Unit { int pm, pn; };
struct Gemm { const bf16_t* A; const bf16_t* Bt; int M, N, K; };

struct StaticOrder {
    int nM, nN, nwg, G, c;
    __host__ __device__ void init(int M, int N, int G_, int c_) { nM = M / BM; nN = N / BM; nwg = nM * nN; G = G_; c = c_; }
    __host__ __device__ bool next(int i, Unit& u) const {
        const long L = (long)i * G + c; if (L >= nwg) return false;
        int wgid = (int)L; { const int q = nwg / NXCD, r = nwg % NXCD, xcd = wgid % NXCD, off = wgid / NXCD; wgid = (xcd < r ? xcd * (q + 1) : r * (q + 1) + (xcd - r) * q) + off; }
        const int nig = WGM * nN, gid = wgid / nig, fm = gid * WGM, gsz = (nM - fm) < WGM ? (nM - fm) : WGM;
        u.pm = fm + ((wgid % nig) % gsz); u.pn = (wgid % nig) / gsz; return true;
    }
    __device__ __forceinline__ void a_ready(const Unit&) const {}
    __device__ __forceinline__ void done(const Unit&) const {}
};
__device__ __forceinline__ unsigned cvt_pk_bf16(float lo, float hi) { unsigned r; asm volatile("v_cvt_pk_bf16_f32 %0, %1, %2" : "=v"(r) : "v"(lo), "v"(hi)); return r; }
typedef float f32x2 __attribute__((ext_vector_type(2)));
__device__ __forceinline__ float bf_lo(unsigned w) { return __builtin_bit_cast(float, w << 16); }
__device__ __forceinline__ float bf_hi(unsigned w) { return __builtin_bit_cast(float, w & 0xffff0000u); }
__device__ __forceinline__ float sigmoid_f(float x) { return 1.0f / (1.0f + __expf(-x)); }
template <int ACT> struct EpiStore {
    static constexpr bool PERM = true, AFTER_DRAIN = false;
    bf16_t* O; int ldc;
    __device__ __forceinline__ void operator()(const f32x4 (&acc)[2][2][4][2], const Unit& u, int wr, int wc, int fr, int fq) const {
        const int row0 = u.pm * BM + wr * 64 + fr, col0 = u.pn * BM + wc * 32 + 8 * fq;
#pragma unroll
        for (int ai = 0; ai < 2; ++ai)
#pragma unroll
            for (int m = 0; m < 4; ++m) { bf16_t* rowp = O + (size_t)(row0 + ai * HALF + m * 16) * ldc + col0;
#pragma unroll
                for (int bj = 0; bj < 2; ++bj) { f32x4 v0 = acc[ai][bj][m][0], v1 = acc[ai][bj][m][1];
                    if (ACT == 2) {
#pragma unroll
                        for (int e = 0; e < 4; ++e) { const float a = fmaxf(v0[e], 0.f), b = fmaxf(v1[e], 0.f); v0[e] = a * a; v1[e] = b * b; } }
                    u32x4 w; w.x = cvt_pk_bf16(v0[0], v0[1]); w.y = cvt_pk_bf16(v0[2], v0[3]); w.z = cvt_pk_bf16(v1[0], v1[1]); w.w = cvt_pk_bf16(v1[2], v1[3]);
                    *(u32x4*)(rowp + bj * HALF) = w; } }
    }
};
template <int MODE> struct EpiGate {
    static constexpr bool PERM = true, AFTER_DRAIN = false;
    const bf16_t* G; int ldg; bf16_t* O; const bf16_t* Y1; const bf16_t* Y2; int ldc;
    __device__ __forceinline__ void operator()(const f32x4 (&acc)[2][2][4][2], const Unit& u, int wr, int wc, int fr, int fq) const {
        const int row0 = u.pm * BM + wr * 64 + fr, col0 = u.pn * BM + wc * 32 + 8 * fq;
#pragma unroll
        for (int ai = 0; ai < 2; ++ai)
#pragma unroll
            for (int m = 0; m < 4; ++m) { const size_t row = (size_t)(row0 + ai * HALF + m * 16);
#pragma unroll
                for (int bj = 0; bj < 2; ++bj) { f32x4 v0 = acc[ai][bj][m][0], v1 = acc[ai][bj][m][1];
                    const u32x4 gw = *(const u32x4*)(G + row * ldg + col0 + bj * HALF);
                    v0[0] *= sigmoid_f(bf_lo(gw.x)); v0[1] *= sigmoid_f(bf_hi(gw.x)); v0[2] *= sigmoid_f(bf_lo(gw.y)); v0[3] *= sigmoid_f(bf_hi(gw.y));
                    v1[0] *= sigmoid_f(bf_lo(gw.z)); v1[1] *= sigmoid_f(bf_hi(gw.z)); v1[2] *= sigmoid_f(bf_lo(gw.w)); v1[3] *= sigmoid_f(bf_hi(gw.w));
                    if (MODE == 1) {
                        const u32x4 a = *(const u32x4*)(Y1 + row * ldc + col0 + bj * HALF), b = *(const u32x4*)(Y2 + row * ldc + col0 + bj * HALF);
                        v0[0] += bf_lo(a.x) + bf_lo(b.x); v0[1] += bf_hi(a.x) + bf_hi(b.x); v0[2] += bf_lo(a.y) + bf_lo(b.y); v0[3] += bf_hi(a.y) + bf_hi(b.y);
                        v1[0] += bf_lo(a.z) + bf_lo(b.z); v1[1] += bf_hi(a.z) + bf_hi(b.z); v1[2] += bf_lo(a.w) + bf_lo(b.w); v1[3] += bf_hi(a.w) + bf_hi(b.w); }
                    u32x4 w; w.x = cvt_pk_bf16(v0[0], v0[1]); w.y = cvt_pk_bf16(v0[2], v0[3]); w.z = cvt_pk_bf16(v1[0], v1[1]); w.w = cvt_pk_bf16(v1[2], v1[3]);
                    *(u32x4*)(O + row * ldc + col0 + bj * HALF) = w; }
                asm volatile("" ::: "memory"); }
    }
};
struct EpiResid {
    static constexpr bool PERM = false, AFTER_DRAIN = false;
    float* X; const float* g; int gstride;
    __device__ __forceinline__ void operator()(const f32x4 (&acc)[2][2][4][2], const Unit& u, int wr, int wc, int fr, int fq) const {
        const float* gb = g + (size_t)(u.pm >> 3) * gstride;
        const int row0 = u.pm * BM + wr * 64 + fr, col0 = u.pn * BM + wc * 32 + 4 * fq;
#pragma unroll
        for (int bj = 0; bj < 2; ++bj)
#pragma unroll
            for (int n = 0; n < 2; ++n) { const f32x4 gv = *(const f32x4*)(gb + col0 + bj * HALF + n * 16);
#pragma unroll
                for (int ai = 0; ai < 2; ++ai)
#pragma unroll
                    for (int m = 0; m < 4; ++m) { float* p = X + (size_t)(row0 + ai * HALF + m * 16) * 1024 + col0 + bj * HALF + n * 16;
                        const f32x4 xv = *(const f32x4*)p; *(f32x4*)p = xv + gv * acc[ai][bj][m][n]; if (m & 1) asm volatile("" ::: "memory"); } }
    }
};
template <class Epi, class Sched, bool ALIGN_EPI = false, bool SP2 = false>
__device__ __forceinline__ void gemm_phase(PG8_LAS unsigned char* lds, const Gemm g, const Sched& S, const Epi& E) {
    const int tid = threadIdx.x, wid = __builtin_amdgcn_readfirstlane(tid >> 6), lane = tid & 63, wr = wid >> 2, wc = wid & 3, fr = lane & 15, fq = lane >> 4;
    const int K = g.K, nt = K / BK;
    unsigned voffA[2], voffB[2];
#pragma unroll
    for (int i = 0; i < 2; ++i) { int R, C; stage_rc(tid * 16 + i * 8192, R, C); const int Rb = Epi::PERM ? ((R & ~31) + perm32(R & 31)) : R;
        voffA[i] = (unsigned)(R * K + C) * 2u; voffB[i] = (unsigned)(Rb * K + C) * 2u; }
    const size_t kstep = (size_t)(BK * 2);
    const size_t hstep = (size_t)HALF * K * 2;
    const size_t tstep = 2 * hstep;
    const unsigned ldsw = (unsigned)wid * 1024u;
    const int aoff = lds_byte(wr * 64 + fr, fq * 8), boff = lds_byte(wc * 32 + fr, fq * 8);
#define PG8_SA(b, h) (((b) * 2 + (h)) * HTB)
#define PG8_SB(b, h) ((4 + (b) * 2 + (h)) * HTB)
#define PG8_STAGE(bufoff, gbase, voff) do { _Pragma("unroll") for (int _i = 0; _i < 2; ++_i) \
        __builtin_amdgcn_global_load_lds((const unsigned*)((const char*)(gbase) + (voff)[_i]), (PG8_LAS unsigned*)(lds + (bufoff) + ldsw + _i * 8192), 16, 0, 0); } while (0)
#define PG8_LDA(dst, b, h) do { _Pragma("unroll") for (int m = 0; m < 4; ++m) _Pragma("unroll") for (int k = 0; k < 2; ++k) dst[m][k] = *(const PG8_LAS bf16x8*)(lds + PG8_SA(b, h) + aoff + m * 2048 + k * 1024); } while (0)
#define PG8_LDB(dst, b, h) do { _Pragma("unroll") for (int n = 0; n < 2; ++n) _Pragma("unroll") for (int k = 0; k < 2; ++k) dst[n][k] = *(const PG8_LAS bf16x8*)(lds + PG8_SB(b, h) + boff + n * 2048 + k * 1024); } while (0)
#define PG8_MMA(ai, bj, At, Bt) do { __builtin_amdgcn_s_setprio(1); _Pragma("unroll") for (int m = 0; m < 4; ++m) _Pragma("unroll") for (int n = 0; n < 2; ++n) _Pragma("unroll") for (int k = 0; k < 2; ++k) \
        acc[ai][bj][m][n] = __builtin_amdgcn_mfma_f32_16x16x32_bf16(Bt[n][k], At[m][k], acc[ai][bj][m][n], 0, 0, 0); __builtin_amdgcn_s_setprio(0); } while (0)
#define PG8_WAIT_V(n) asm volatile("s_waitcnt vmcnt(" #n ")" ::: "memory")
#define PG8_WAIT_L(n) asm volatile("s_waitcnt lgkmcnt(" #n ")" ::: "memory")
#define PG8_BAR __builtin_amdgcn_s_barrier()
#define PG8_SCHED __builtin_amdgcn_sched_barrier(0)
    Unit cur, nxt; int ui = 0;
    if (!S.next(0, cur)) return;
    f32x4 acc[2][2][4][2];
#pragma unroll
    for (int a = 0; a < 2; ++a)
#pragma unroll
        for (int b = 0; b < 2; ++b)
#pragma unroll
            for (int m = 0; m < 4; ++m)
#pragma unroll
                for (int n = 0; n < 2; ++n) acc[a][b][m][n] = (f32x4){0.f, 0.f, 0.f, 0.f};
    bf16x8 At[4][2], B0[2][2], B1[2][2];
    const char* cA = (const char*)g.A + (size_t)cur.pm * tstep; const char* cB = (const char*)g.Bt + (size_t)cur.pn * tstep;
    S.a_ready(cur);
    if constexpr (SP2) {
        PG8_STAGE(PG8_SB(0, 0), cB, voffB); PG8_STAGE(PG8_SB(0, 1), cB + hstep, voffB); PG8_STAGE(PG8_SA(0, 0), cA, voffA); PG8_STAGE(PG8_SA(0, 1), cA + hstep, voffA);
        if (wr == 1) PG8_BAR;
        PG8_WAIT_V(2); PG8_BAR;
        PG8_STAGE(PG8_SB(1, 0), cB + kstep, voffB); PG8_STAGE(PG8_SA(1, 0), cA + kstep, voffA); PG8_STAGE(PG8_SB(1, 1), cB + hstep + kstep, voffB);
        PG8_WAIT_V(6); PG8_BAR;
    } else {
        PG8_STAGE(PG8_SB(0, 0), cB, voffB); PG8_STAGE(PG8_SA(0, 0), cA, voffA); PG8_STAGE(PG8_SB(0, 1), cB + hstep, voffB); PG8_STAGE(PG8_SA(0, 1), cA + hstep, voffA);
        if (wr == 1) PG8_BAR;
        PG8_WAIT_V(4); PG8_BAR;
        PG8_STAGE(PG8_SB(1, 0), cB + kstep, voffB); PG8_STAGE(PG8_SA(1, 0), cA + kstep, voffA); PG8_STAGE(PG8_SB(1, 1), cB + hstep + kstep, voffB);
        PG8_WAIT_V(6); PG8_BAR;
    }
    for (;;) {
        const bool has_next = S.next(ui + 1, nxt);
        const char* nA = has_next ? (const char*)g.A + (size_t)nxt.pm * tstep : cA; const char* nB = has_next ? (const char*)g.Bt + (size_t)nxt.pn * tstep : cB;
        for (int t = 0; t < nt; t += 2) {
            const bool last = (t == nt - 2);
            const char* a1 = cA + (size_t)(t + 1) * kstep;
            const char* a2 = last ? nA : cA + (size_t)(t + 2) * kstep; const char* b2 = last ? nB : cB + (size_t)(t + 2) * kstep;
            const char* a3 = a2 + kstep; const char* b3 = b2 + kstep;
            if (last && has_next) S.a_ready(nxt);
            if constexpr (SP2) {
            PG8_LDB(B0, 0, 0); PG8_LDB(B1, 0, 1); PG8_SCHED; PG8_LDA(At, 0, 0); PG8_STAGE(PG8_SA(1, 1), a1 + hstep, voffA);
            PG8_WAIT_V(8); PG8_WAIT_L(0); PG8_BAR; PG8_MMA(0, 0, At, B0); PG8_MMA(0, 1, At, B1); PG8_BAR; PG8_SCHED;
            PG8_LDA(At, 0, 1); PG8_STAGE(PG8_SB(0, 0), b2, voffB); PG8_STAGE(PG8_SB(0, 1), b2 + hstep, voffB); PG8_STAGE(PG8_SA(0, 0), a2, voffA);
            PG8_WAIT_V(8); PG8_WAIT_L(0); PG8_BAR; PG8_MMA(1, 0, At, B0); PG8_MMA(1, 1, At, B1); PG8_BAR; PG8_SCHED;
            PG8_LDB(B0, 1, 0); PG8_LDB(B1, 1, 1); PG8_SCHED; PG8_LDA(At, 1, 0); PG8_STAGE(PG8_SA(0, 1), a2 + hstep, voffA);
            PG8_WAIT_V(8); PG8_WAIT_L(0); PG8_BAR; PG8_MMA(0, 0, At, B0); PG8_MMA(0, 1, At, B1); PG8_BAR; PG8_SCHED;
            PG8_LDA(At, 1, 1); PG8_STAGE(PG8_SB(1, 0), b3, voffB); PG8_STAGE(PG8_SB(1, 1), b3 + hstep, voffB); PG8_STAGE(PG8_SA(1, 0), a3, voffA);
            PG8_WAIT_V(8); PG8_WAIT_L(0); PG8_BAR; PG8_MMA(1, 0, At, B0); PG8_MMA(1, 1, At, B1); PG8_BAR; PG8_SCHED;
            } else {
            PG8_LDB(B0, 0, 0); PG8_SCHED; PG8_LDA(At, 0, 0); PG8_STAGE(PG8_SA(1, 1), a1 + hstep, voffA);
            PG8_WAIT_L(8); PG8_BAR; PG8_WAIT_L(0); PG8_MMA(0, 0, At, B0); PG8_BAR; PG8_SCHED;
            PG8_LDB(B1, 0, 1); PG8_STAGE(PG8_SB(0, 0), b2, voffB);
            PG8_BAR; PG8_WAIT_L(0); PG8_MMA(0, 1, At, B1); PG8_BAR;
            PG8_LDA(At, 0, 1); PG8_STAGE(PG8_SA(0, 0), a2, voffA);
            PG8_BAR; PG8_WAIT_L(0); PG8_MMA(1, 0, At, B0); PG8_BAR; PG8_SCHED;
            PG8_STAGE(PG8_SB(0, 1), b2 + hstep, voffB);
            PG8_WAIT_V(6); PG8_BAR; PG8_MMA(1, 1, At, B1); PG8_BAR;
            PG8_LDB(B0, 1, 0); PG8_SCHED; PG8_LDA(At, 1, 0); PG8_STAGE(PG8_SA(0, 1), a2 + hstep, voffA);
            PG8_WAIT_L(8); PG8_BAR; PG8_WAIT_L(0); PG8_MMA(0, 0, At, B0); PG8_BAR; PG8_SCHED;
            PG8_LDB(B1, 1, 1); PG8_STAGE(PG8_SB(1, 0), b3, voffB);
            PG8_BAR; PG8_WAIT_L(0); PG8_MMA(0, 1, At, B1); PG8_BAR;
            PG8_LDA(At, 1, 1); PG8_STAGE(PG8_SA(1, 0), a3, voffA);
            PG8_BAR; PG8_WAIT_L(0); PG8_MMA(1, 0, At, B0); PG8_BAR; PG8_SCHED;
            PG8_STAGE(PG8_SB(1, 1), b3 + hstep, voffB);
            PG8_WAIT_V(6); PG8_BAR; PG8_MMA(1, 1, At, B1); PG8_BAR;
            }
        }
        if constexpr (ALIGN_EPI) { if (wr == 0) PG8_BAR; }
        if constexpr (!Epi::AFTER_DRAIN) { E(acc, cur, wr, wc, fr, fq); S.done(cur); }
        if (!has_next) break;
#pragma unroll
        for (int a = 0; a < 2; ++a)
#pragma unroll
            for (int b = 0; b < 2; ++b)
#pragma unroll
                for (int m = 0; m < 4; ++m)
#pragma unroll
                    for (int n = 0; n < 2; ++n) acc[a][b][m][n] = (f32x4){0.f, 0.f, 0.f, 0.f};
        cur = nxt; cA = nA; cB = nB; ++ui;
        if constexpr (ALIGN_EPI) { if (wr == 1) PG8_BAR; }
    }
    PG8_WAIT_V(0);
    if constexpr (!ALIGN_EPI) { if (wr == 0) PG8_BAR; }
    PG8_BAR;
    if constexpr (Epi::AFTER_DRAIN) { E.fused(acc, cur, wr, wc, fr, fq, lds, wid, lane); S.done(cur); }
#undef PG8_SA
#undef PG8_SB
#undef PG8_STAGE
#undef PG8_LDA
#undef PG8_LDB
#undef PG8_MMA
#undef PG8_WAIT_V
#undef PG8_WAIT_L
#undef PG8_BAR
#undef PG8_SCHED
}
}
#ifndef MK_ONE_LAUNCH
#define MK_ONE_LAUNCH 1
#endif
constexpr int NWAVES = 8;
constexpr size_t MiB = 1u << 20;
constexpr size_t WS_CTL = 0, CTL_ZERO_BYTES = 1 * MiB;
constexpr size_t WS_MODF = 1 * MiB;
constexpr size_t WS_ROPE = 2 * MiB;
constexpr size_t WS_IFG = 10 * MiB;
constexpr size_t WS_WIN = 12 * MiB;
constexpr size_t WS_WBR = 32 * MiB;
constexpr size_t WS_WOUT = 38 * MiB;
constexpr size_t WS_WFF1 = 40 * MiB;
constexpr size_t WS_WFF2 = 48 * MiB;
constexpr size_t WS_ACT = 56 * MiB;
constexpr size_t WS_RET = 88 * MiB, WS_LRU = 120 * MiB, WS_MLS = 152 * MiB;
constexpr size_t WS_MQ = 184 * MiB, WS_MK = 216 * MiB, WS_MV = 248 * MiB;
constexpr size_t WS_PROJ = 280 * MiB;
constexpr size_t WS_END = 600 * MiB;
constexpr int LDS_BYTES = 147456;
constexpr int RING_BYTES = 131072, MISC_OFF = RING_BYTES + 320;

#define GAS __attribute__((address_space(1)))
#define LAS __attribute__((address_space(3)))
typedef unsigned short bf16;
typedef unsigned v4u __attribute__((ext_vector_type(4)));
typedef unsigned v2u __attribute__((ext_vector_type(2)));
typedef float f32x4 __attribute__((ext_vector_type(4)));
typedef float f32x2v __attribute__((ext_vector_type(2)));
#define LDS_WAIT() asm volatile("s_waitcnt lgkmcnt(0)" ::: "memory")
#define VM_WAIT() asm volatile("s_waitcnt vmcnt(0)" ::: "memory")
__device__ __forceinline__ unsigned f2bf(float f) { unsigned u = __builtin_bit_cast(unsigned, f); return (u + 0x7fffu + ((u >> 16) & 1u)) >> 16; }
__device__ __forceinline__ unsigned pk2(float lo, float hi) { return f2bf(lo) | (f2bf(hi) << 16); }
__device__ __forceinline__ float bf2f(unsigned short h) { return __builtin_bit_cast(float, (unsigned)h << 16); }
__device__ __forceinline__ float bflo(unsigned w) { return __builtin_bit_cast(float, w << 16); }
__device__ __forceinline__ float bfhi(unsigned w) { return __builtin_bit_cast(float, w & 0xffff0000u); }
__device__ __forceinline__ float sigmoidf_(float x) { return 1.0f / (1.0f + __expf(-x)); }
__device__ __forceinline__ float wave_sum(float v) {
#pragma unroll
    for (int o = 1; o < 64; o <<= 1) v += __shfl_xor(v, o);
    return v;
}
#define XB_TMO      128
#define XB_XCNT(j)  (256  + 64 * (j))
#define XB_XSUB(j)  (1280 + 64 * (j))
#define XB_XGEN(j)  (2304 + 64 * (j))
#define XB_TOP      3328
#define XB_TOPGEN   3392
#define XCD_BAR_WORDS 3456
#define XB_SPIN_CAP (1u << 18)

__device__ __forceinline__ unsigned xb_ld(unsigned* p)              { return __hip_atomic_load(p, __ATOMIC_RELAXED, __HIP_MEMORY_SCOPE_AGENT); }
__device__ __forceinline__ unsigned xb_add(unsigned* p, unsigned v) { return __hip_atomic_fetch_add(p, v, __ATOMIC_RELAXED, __HIP_MEMORY_SCOPE_AGENT); }
__device__ __forceinline__ unsigned xb_xcc_id() { return (unsigned)__builtin_amdgcn_s_getreg((3 << 11) | 20) & 0xFu; }
#define XB_SPIN(cond, bar) do { unsigned _sp = 0; while (cond) { __builtin_amdgcn_s_sleep(1); \
    if ((++_sp & 255u) == 0u) { if (xb_ld(&(bar)[XB_TMO])) break; if (_sp > XB_SPIN_CAP) { atomicAdd(&(bar)[XB_TMO], 1u); break; } } } } while (0)

struct XcdBarrier {
    unsigned* bar; unsigned x;
    volatile LAS unsigned* st;
};

__device__ __forceinline__ XcdBarrier xcd_barrier_post(unsigned* bar, volatile LAS unsigned* st) {
    XcdBarrier b; b.bar = bar; b.x = xb_xcc_id(); b.st = st;
    if (threadIdx.x == 0) (void)xb_add(&bar[XB_XCNT(b.x)], 1u);
    return b;
}
__device__ __forceinline__ void xcd_barrier_complete(unsigned* bar, unsigned x, unsigned& nloc, unsigned& nx) {
    const unsigned G = gridDim.x * gridDim.y * gridDim.z;
    unsigned sum, cnt, mine, sp = 0u;
    for (;;) {
        sum = 0u; cnt = 0u; mine = 0u;
#pragma unroll
        for (unsigned j = 0; j < 16; ++j) { const unsigned c = xb_ld(&bar[XB_XCNT(j)]); sum += c; cnt += (c > 0u) ? 1u : 0u; mine = (j == x) ? c : mine; }
        if (sum == G) break;
        __builtin_amdgcn_s_sleep(1);
        if ((++sp & 255u) == 0u) { if (xb_ld(&bar[XB_TMO])) break; if (sp > XB_SPIN_CAP) { atomicAdd(&bar[XB_TMO], 1u); break; } }
    }
    nloc = mine > 0u ? mine : 1u; nx = cnt > 0u ? cnt : 1u;
}

__device__ __forceinline__ void xcd_barrier(const XcdBarrier& b) {
    asm volatile("s_waitcnt vmcnt(0)" ::: "memory");
    __syncthreads();
    if (threadIdx.x == 0) {
        unsigned* bar = b.bar;
        __builtin_amdgcn_s_waitcnt(0);
        unsigned nloc = b.st[0], nx = b.st[1];
        if (nloc == 0u) { xcd_barrier_complete(bar, b.x, nloc, nx); b.st[0] = nloc; b.st[1] = nx; }
        const unsigned old = xb_add(&bar[XB_XSUB(b.x)], 1u);
        const unsigned gen = old / nloc;
        if (old + 1u == (gen + 1u) * nloc) {
            __builtin_amdgcn_fence(__ATOMIC_RELEASE, "agent");
            asm volatile("s_waitcnt vmcnt(0)" ::: "memory");
            const unsigned og = xb_add(&bar[XB_TOP], 1u);
            const unsigned tg = og / nx;
            if (og + 1u == (tg + 1u) * nx) xb_add(&bar[XB_TOPGEN], 1u);
            else XB_SPIN(xb_ld(&bar[XB_TOPGEN]) == tg, bar);
            __builtin_amdgcn_fence(__ATOMIC_ACQUIRE, "agent");
            xb_add(&bar[XB_XGEN(b.x)], 1u);
            asm volatile("s_waitcnt vmcnt(0)" ::: "memory");
        } else {
            XB_SPIN(xb_ld(&bar[XB_XGEN(b.x)]) == gen, bar);
            __builtin_amdgcn_fence(__ATOMIC_ACQUIRE, "agent");
            asm volatile("s_waitcnt vmcnt(0)" ::: "memory");
        }
    }
    __syncthreads();
}
__device__ __forceinline__ void p0_transpose_item(const float* W, int K, int N, bf16* WT, int row_off, LAS float* scr, int item, int lane) {
    const int nblk = N / 32, kb = item / nblk, nb = item % nblk, k0 = 64 * kb, n0 = 32 * nb;
#pragma unroll 8
    for (int i = 0; i < 32; ++i) { const int kk = 2 * i + (lane >> 5); scr[kk * 33 + (lane & 31)] = W[(size_t)(k0 + kk) * N + n0 + (lane & 31)]; }
    LDS_WAIT(); asm volatile("" ::: "memory");
    const int c = lane & 7;
#pragma unroll
    for (int j = 0; j < 4; ++j) { const int n = (lane >> 3) + 8 * j; const LAS float* s = scr + (8 * c) * 33 + n;
        v4u o; o.x = pk2(s[0 * 33], s[1 * 33]); o.y = pk2(s[2 * 33], s[3 * 33]); o.z = pk2(s[4 * 33], s[5 * 33]); o.w = pk2(s[6 * 33], s[7 * 33]);
        *(GAS v4u*)(WT + (size_t)(row_off + n0 + n) * K + k0 + 8 * c) = o; }
    LDS_WAIT(); asm volatile("" ::: "memory");
}
struct Ctx {
    LAS unsigned char* lds;
    int tid, lane, wave, vcu, G, bx;
};

__device__ __forceinline__ void p0_prologue(const Ctx& F, const float* x, const float* c, const int* positions, const float* w_ada, const float* b_ada,
                                            float* modf, f32x2v* rope, float* xw) {
    LAS float* cond = (LAS float*)F.lds;
    LAS float* red = (LAS float*)(F.lds + 32768);
    for (int i = F.tid; i < NB * DM; i += 512) { const float v = c[i]; cond[i] = v / (1.f + __expf(-v)); }
    __syncthreads();
    const int col = F.tid & 63, ks = F.tid >> 6;
    for (int it = F.vcu; it < NL * 96; it += F.G) {
        const int l = it / 96, cg = it % 96, n = cg * 64 + col;
        const float* w = w_ada + ((size_t)l * DM + ks * 128) * (6 * DM) + n;
        float acc[8];
#pragma unroll
        for (int b = 0; b < 8; ++b) acc[b] = 0.f;
#pragma unroll 8
        for (int k = 0; k < 128; ++k) { const float wv = w[(size_t)k * (6 * DM)];
#pragma unroll
            for (int b = 0; b < 8; ++b) acc[b] += cond[b * DM + ks * 128 + k] * wv; }
#pragma unroll
        for (int b = 0; b < 8; ++b) red[(ks * 8 + b) * 64 + col] = acc[b];
        __syncthreads();
        { const int b = F.tid >> 6; float s = b_ada[l * 6 * DM + n];
#pragma unroll
          for (int k2 = 0; k2 < 8; ++k2) s += red[(k2 * 8 + b) * 64 + col];
          modf[((size_t)l * NB + b) * (6 * DM) + n] = s; }
        __syncthreads();
    }
    const int gt = F.vcu * 512 + F.tid, NT = F.G * 512;
    for (int idx = gt; idx < M * 64; idx += NT) { const int tok = idx >> 6, i = idx & 63;
        const float inv = powf(10000.0f, -(float)i * (1.0f / 64.0f)); const float ang = (float)positions[tok] * inv;
        float sn, cs; sincosf(ang, &sn, &cs); rope[idx] = (f32x2v){cs, sn}; }
    for (int idx = gt; idx < M * DM / 4; idx += NT) ((f32x4*)xw)[idx] = ((const f32x4*)x)[idx];
}

__device__ __forceinline__ void convert_weights(const Ctx& F, const float* w_in, const float* w_br0, const float* w_br1, const float* w_br2, const float* w_out,
                                                const float* w_ff1, const float* w_ff2, bf16* Win, bf16* Wbr, bf16* Wout, bf16* Wff1, bf16* Wff2) {
    LAS float* scr = (LAS float*)(F.lds + F.wave * 16384);
    const int gw = F.vcu * NWAVES + F.wave, NGW = F.G * NWAVES;
    constexpr int I_IN = (DM / 64) * (DIN / 32), I_SQ = (DM / 64) * (DM / 32), I_F1 = (DM / 64) * (DFF / 32), I_F2 = (DFF / 64) * (DM / 32);
    constexpr int NITEMS = I_IN + 4 * I_SQ + I_F1 + I_F2;
    for (int it = gw; it < NITEMS; it += NGW) {
        int r = it;
        if (r < I_IN) { p0_transpose_item(w_in, DM, DIN, Win, 0, scr, r, F.lane); continue; } r -= I_IN;
        if (r < I_SQ) { p0_transpose_item(w_br0, DM, DM, Wbr, 0, scr, r, F.lane); continue; } r -= I_SQ;
        if (r < I_SQ) { p0_transpose_item(w_br1, DM, DM, Wbr, DM, scr, r, F.lane); continue; } r -= I_SQ;
        if (r < I_SQ) { p0_transpose_item(w_br2, DM, DM, Wbr, 2 * DM, scr, r, F.lane); continue; } r -= I_SQ;
        if (r < I_SQ) { p0_transpose_item(w_out, DM, DM, Wout, 0, scr, r, F.lane); continue; } r -= I_SQ;
        if (r < I_F1) { p0_transpose_item(w_ff1, DM, DFF, Wff1, 0, scr, r, F.lane); continue; } r -= I_F1;
        p0_transpose_item(w_ff2, DFF, DM, Wff2, 0, scr, r, F.lane);
    }
}

__device__ __forceinline__ void norm_phase(const Ctx& F, const float* xw, const float* gain, const float* sc, const float* sh, bf16* out) {
    const int gw = F.vcu * NWAVES + F.wave, NGW = F.G * NWAVES;
    for (int ri = gw; ri < M / 8; ri += NGW) {
        const int b = ri / (SEQ / 8);
        f32x4 A[4], Bv[4];
#pragma unroll
        for (int j = 0; j < 4; ++j) { const int cidx = 4 * F.lane + 256 * j;
            const f32x4 g = *(const f32x4*)(gain + cidx), s1 = *(const f32x4*)(sc + (size_t)b * 6 * DM + cidx); A[j] = g * (s1 + 1.0f); Bv[j] = *(const f32x4*)(sh + (size_t)b * 6 * DM + cidx); }
        for (int r = 0; r < 8; ++r) { const size_t row = (size_t)ri * 8 + r;
            const f32x4* xr = (const f32x4*)(xw + row * DM) + F.lane;
            f32x4 v[4]; float ss = 0.f;
#pragma unroll
            for (int j = 0; j < 4; ++j) { v[j] = xr[64 * j]; ss += (v[j].x * v[j].x + v[j].y * v[j].y) + (v[j].z * v[j].z + v[j].w * v[j].w); }
            const float rs = rsqrtf(wave_sum(ss) * (1.0f / DM) + EPSF);
            unsigned long long* o8 = (unsigned long long*)(out + row * DM) + F.lane;
#pragma unroll
            for (int j = 0; j < 4; ++j) { const f32x4 o = v[j] * rs * A[j] + Bv[j];
                o8[64 * j] = (unsigned long long)pk2(o.x, o.y) | ((unsigned long long)pk2(o.z, o.w) << 32); } }
    }
}
__device__ __forceinline__ void final_norm_phase(const Ctx& F, float* xw, const float* gain) {
    const int gw = F.vcu * NWAVES + F.wave, NGW = F.G * NWAVES;
    f32x4 A[4];
#pragma unroll
    for (int j = 0; j < 4; ++j) A[j] = *(const f32x4*)(gain + 4 * F.lane + 256 * j);
    for (int row = gw; row < M; row += NGW) {
        f32x4* xr = (f32x4*)(xw + (size_t)row * DM) + F.lane;
        f32x4 v[4]; float ss = 0.f;
#pragma unroll
        for (int j = 0; j < 4; ++j) { v[j] = xr[64 * j]; ss += (v[j].x * v[j].x + v[j].y * v[j].y) + (v[j].z * v[j].z + v[j].w * v[j].w); }
        const float rs = rsqrtf(wave_sum(ss) * (1.0f / DM) + EPSF);
#pragma unroll
        for (int j = 0; j < 4; ++j) xr[64 * j] = v[j] * rs * A[j];
    }
}

__device__ __forceinline__ void mlstm_pre(const Ctx& F, const bf16* proj, const float* conv_w, const float* conv_b, const float* wq, const float* wk, const float* wv,
                                          const float* w_if, const float* b_if, bf16* MQ, bf16* MK, bf16* MV, float* IFG) {
    LAS f32x4* wif = (LAS f32x4*)F.lds;
    LAS float* part = (LAS float*)(F.lds + 98304);
    for (int e = F.tid; e < 3 * DM * 8; e += 512) { const int j = e >> 3, g = e & 7, src = j >> 10, ch = j & 1023, nb = ch >> 2, d = ch & 3, vi = (src * 4 + d) * 8 + g;
        ((LAS float*)wif)[((vi >> 2) * 256 + nb) * 4 + (vi & 3)] = w_if[e]; }
    const int u = F.tid & 255, rg = F.tid >> 8, c0 = 4 * u, wrun = F.wave & 3;
    f32x4 cw[4], Wq[4], Wk[4], Wv[4];
#pragma unroll
    for (int k = 0; k < 4; ++k) { cw[k] = *(const f32x4*)(conv_w + k * DM + c0); Wq[k] = *(const f32x4*)(wq + u * 16 + k * 4); Wk[k] = *(const f32x4*)(wk + u * 16 + k * 4); Wv[k] = *(const f32x4*)(wv + u * 16 + k * 4); }
    const f32x4 cb = *(const f32x4*)(conv_b + c0);
    __syncthreads();
    for (int rr = F.vcu; rr < M / 64; rr += F.G) {
        const int r = 2 * rr + rg, t0 = (r & 63) * 32;
        const bf16* mx = proj + (size_t)r * 32 * DIN + OFF_MX + c0;
        f32x4 x0 = {0.f, 0.f, 0.f, 0.f}, x1 = x0, x2 = x0;
        if (t0 != 0) { v2u a = *(const v2u*)(mx - 3 * (size_t)DIN), b = *(const v2u*)(mx - 2 * (size_t)DIN), cc = *(const v2u*)(mx - (size_t)DIN);
            x0 = (f32x4){bflo(a.x), bfhi(a.x), bflo(a.y), bfhi(a.y)}; x1 = (f32x4){bflo(b.x), bfhi(b.x), bflo(b.y), bfhi(b.y)}; x2 = (f32x4){bflo(cc.x), bfhi(cc.x), bflo(cc.y), bfhi(cc.y)}; }
#pragma unroll 1
        for (int tt = 0; tt < 32; ++tt) {
            const size_t row = (size_t)r * 32 + tt;
            const v2u xr = *(const v2u*)(mx + (size_t)tt * DIN);
            const f32x4 x3 = {bflo(xr.x), bfhi(xr.x), bflo(xr.y), bfhi(xr.y)};
            f32x4 cv = cb + cw[0] * x0 + cw[1] * x1 + cw[2] * x2 + cw[3] * x3;
            f32x4 xc; xc.x = cv.x * sigmoidf_(cv.x); xc.y = cv.y * sigmoidf_(cv.y); xc.z = cv.z * sigmoidf_(cv.z); xc.w = cv.w * sigmoidf_(cv.w);
            const f32x4 q = Wq[0] * xc.x + Wq[1] * xc.y + Wq[2] * xc.z + Wq[3] * xc.w;
            const f32x4 k = Wk[0] * xc.x + Wk[1] * xc.y + Wk[2] * xc.z + Wk[3] * xc.w;
            const f32x4 v = Wv[0] * x3.x + Wv[1] * x3.y + Wv[2] * x3.z + Wv[3] * x3.w;
            *(v2u*)(MQ + row * DM + c0) = (v2u){pk2(q.x, q.y), pk2(q.z, q.w)};
            *(v2u*)(MK + row * DM + c0) = (v2u){pk2(k.x, k.y), pk2(k.z, k.w)};
            *(v2u*)(MV + row * DM + c0) = (v2u){pk2(v.x, v.y), pk2(v.z, v.w)};
            f32x4 pa = {0.f, 0.f, 0.f, 0.f}, pb = pa;
            const float vals[12] = {q.x, q.y, q.z, q.w, k.x, k.y, k.z, k.w, v.x, v.y, v.z, v.w};
#pragma unroll
            for (int sd = 0; sd < 12; ++sd) { pa += wif[(sd * 2) * 256 + u] * vals[sd]; pb += wif[(sd * 2 + 1) * 256 + u] * vals[sd]; }
            const bool b0 = F.lane & 1, b1 = F.lane & 2, b2 = F.lane & 4;
            float a4[4];
#pragma unroll
            for (int i = 0; i < 4; ++i) { const float snd = b0 ? pa[i] : pb[i], kp = b0 ? pb[i] : pa[i]; a4[i] = kp + __shfl_xor(snd, 1); }
            float c2[2];
#pragma unroll
            for (int i = 0; i < 2; ++i) { const float snd = b1 ? a4[i] : a4[i + 2], kp = b1 ? a4[i + 2] : a4[i]; c2[i] = kp + __shfl_xor(snd, 2); }
            float d1; { const float snd = b2 ? c2[0] : c2[1], kp = b2 ? c2[1] : c2[0]; d1 = kp + __shfl_xor(snd, 4); }
            d1 += __shfl_xor(d1, 8); d1 += __shfl_xor(d1, 16); d1 += __shfl_xor(d1, 32);
            if (F.lane < 8) { const int gi = 4 * (F.lane & 1) + 2 * ((F.lane >> 1) & 1) + ((F.lane >> 2) & 1); part[((rg * 32 + tt) * 4 + wrun) * 8 + gi] = d1; }
            x0 = x1; x1 = x2; x2 = x3;
        }
        __syncthreads();
        { const int rg2 = F.tid >> 8, tt = (F.tid >> 3) & 31, g = F.tid & 7; const LAS float* p = part + ((rg2 * 32 + tt) * 4) * 8 + g;
          IFG[((size_t)(2 * rr + rg2) * 32 + tt) * 8 + g] = (p[0] + p[8]) + (p[16] + p[24]) + b_if[g]; }
        __syncthreads();
    }
}

__device__ __forceinline__ float log_sigmoid_f(float x) { return x >= 0.f ? -log1pf(expf(-x)) : x - log1pf(expf(x)); }
__device__ __forceinline__ float gelu_tanh_f(float x) { return 0.5f * x * (1.0f + tanhf(0.7978845608028654f * (x + 0.044715f * x * x * x))); }

__device__ __forceinline__ void mlstm_simple(const Ctx& F, int b, int h, const bf16* MQ, const bf16* MK, const bf16* MV, const float* IFG, const bf16* proj, const float* m_norm, bf16* MLS) {
    LAS float* qs = (LAS float*)F.lds;
    LAS float* ks = qs + 2048;
    LAS float* vs = ks + 2048;
    LAS float* nump = vs + 2048;
    LAS float* gi = nump + 4096;
    LAS float* gf = gi + 8;
    LAS float* ms = gf + 8;
    LAS float* denp = ms + 8;
    const int e = F.tid & 255, half = F.tid >> 8;
    float C[128];
#pragma unroll
    for (int d = 0; d < 128; ++d) C[d] = 0.f;
    float nown = 0.f, m = 0.f;
    __syncthreads();
    for (int tile = 0; tile < SEQ / 8; ++tile) {
        const size_t row0 = (size_t)b * SEQ + tile * 8;
        for (int i = F.tid; i < 2048; i += 512) { const int tk = i >> 8, ee = i & 255; const size_t o = (row0 + tk) * DM + h * 256 + ee;
            qs[i] = bf2f(MQ[o]); ks[i] = bf2f(MK[o]) * 0.0625f; vs[i] = bf2f(MV[o]); }
        if (F.tid < 8) { gi[F.tid] = IFG[(row0 + F.tid) * 8 + h]; gf[F.tid] = log_sigmoid_f(IFG[(row0 + F.tid) * 8 + 4 + h]); }
        __syncthreads();
#pragma unroll 1
        for (int tk = 0; tk < 8; ++tk) {
            const float it = gi[tk], lf = gf[tk], mn = fmaxf(lf + m, it), fs = __expf(lf + m - mn), is = __expf(it - mn); m = mn;
            const float isv = is * vs[tk * 256 + e];
            const LAS f32x4* k4 = (const LAS f32x4*)(ks + tk * 256 + half * 128);
            const LAS f32x4* q4 = (const LAS f32x4*)(qs + tk * 256 + half * 128);
            float num = 0.f;
#pragma unroll
            for (int d4 = 0; d4 < 32; ++d4) { const f32x4 kk = k4[d4], qq = q4[d4];
                C[4 * d4 + 0] = fs * C[4 * d4 + 0] + isv * kk.x; num += C[4 * d4 + 0] * qq.x;
                C[4 * d4 + 1] = fs * C[4 * d4 + 1] + isv * kk.y; num += C[4 * d4 + 1] * qq.y;
                C[4 * d4 + 2] = fs * C[4 * d4 + 2] + isv * kk.z; num += C[4 * d4 + 2] * qq.z;
                C[4 * d4 + 3] = fs * C[4 * d4 + 3] + isv * kk.w; num += C[4 * d4 + 3] * qq.w; }
            nump[(tk * 2 + half) * 256 + e] = num;
            if (half == 0) { nown = fs * nown + is * ks[tk * 256 + e]; const float dp = wave_sum(nown * qs[tk * 256 + e]); if (F.lane == 0) denp[tk * 4 + F.wave] = dp; }
            if (F.tid == 0) ms[tk] = mn;
        }
        __syncthreads();
        { const int tk = F.wave; const size_t row = row0 + tk;
          const float den = (denp[tk * 4 + 0] + denp[tk * 4 + 1]) + (denp[tk * 4 + 2] + denp[tk * 4 + 3]);
          const float dn = fmaxf(fabsf(den), __expf(-ms[tk])), rdn = 1.0f / dn;
          float hm[4], ss = 0.f;
#pragma unroll
          for (int j = 0; j < 4; ++j) { const int ee = F.lane + 64 * j; const float hh = (nump[(tk * 2) * 256 + ee] + nump[(tk * 2 + 1) * 256 + ee]) * rdn;
              hm[j] = hh * sigmoidf_(bf2f(proj[row * DIN + OFF_MO + h * 256 + ee])); ss += hm[j] * hm[j]; }
          const float rs = rsqrtf(wave_sum(ss) * (1.0f / 256.0f) + EPSF);
#pragma unroll
          for (int j = 0; j < 4; ++j) { const int ee = F.lane + 64 * j; MLS[row * DM + h * 256 + ee] = (bf16)f2bf(hm[j] * rs * m_norm[h * 256 + ee]); } }
        __syncthreads();
    }
}

__device__ __forceinline__ void ret_simple(const Ctx& F, int b, int h, const bf16* proj, const f32x2v* rope, bf16* RET) {
    LAS float* qs = (LAS float*)F.lds;
    LAS float* ks = qs + 1024;
    LAS float* vs = ks + 1024;
    LAS float* op = vs + 2048;
    const int e = F.tid & 255, half = F.tid >> 8;
    const float gamma = 1.0f - exp2f(-5.0f - (float)h);
    float S[64];
#pragma unroll
    for (int d = 0; d < 64; ++d) S[d] = 0.f;
    __syncthreads();
    for (int tile = 0; tile < SEQ / 8; ++tile) {
        const size_t row0 = (size_t)b * SEQ + tile * 8;
        for (int idx = F.tid; idx < 1024; idx += 512) { const int which = idx >> 9, tk = (idx >> 6) & 7, i = idx & 63; const size_t row = row0 + tk;
            const bf16* src = proj + row * DIN + (which ? OFF_RK : OFF_RQ) + h * 128;
            const float x1 = bf2f(src[i]), x2 = bf2f(src[64 + i]); const f32x2v cs = rope[row * 64 + i];
            const float sc = which ? 0.08838834764831845f : 1.0f;
            LAS float* dst = (which ? ks : qs) + tk * 128;
            dst[i] = (x1 * cs.x - x2 * cs.y) * sc; dst[64 + i] = (x1 * cs.y + x2 * cs.x) * sc; }
        for (int i = F.tid; i < 2048; i += 512) { const int tk = i >> 8, ee = i & 255; vs[i] = bf2f(proj[(row0 + tk) * DIN + OFF_RV + h * 256 + ee]); }
        __syncthreads();
#pragma unroll 1
        for (int tk = 0; tk < 8; ++tk) {
            const float ve = vs[tk * 256 + e];
            const LAS f32x4* k4 = (const LAS f32x4*)(ks + tk * 128 + half * 64);
            const LAS f32x4* q4 = (const LAS f32x4*)(qs + tk * 128 + half * 64);
            float o = 0.f;
#pragma unroll
            for (int d4 = 0; d4 < 16; ++d4) { const f32x4 kk = k4[d4], qq = q4[d4];
                S[4 * d4 + 0] = gamma * S[4 * d4 + 0] + ve * kk.x; o += S[4 * d4 + 0] * qq.x;
                S[4 * d4 + 1] = gamma * S[4 * d4 + 1] + ve * kk.y; o += S[4 * d4 + 1] * qq.y;
                S[4 * d4 + 2] = gamma * S[4 * d4 + 2] + ve * kk.z; o += S[4 * d4 + 2] * qq.z;
                S[4 * d4 + 3] = gamma * S[4 * d4 + 3] + ve * kk.w; o += S[4 * d4 + 3] * qq.w; }
            op[(tk * 2 + half) * 256 + e] = o;
        }
        __syncthreads();
        { const int tk = F.wave; const size_t row = row0 + tk;
          float ov[4], ss = 0.f;
#pragma unroll
          for (int j = 0; j < 4; ++j) { const int ee = F.lane + 64 * j; ov[j] = op[(tk * 2) * 256 + ee] + op[(tk * 2 + 1) * 256 + ee]; ss += ov[j] * ov[j]; }
          const float rs = rsqrtf(wave_sum(ss) * (1.0f / 256.0f) + EPSF);
#pragma unroll
          for (int j = 0; j < 4; ++j) { const int ee = F.lane + 64 * j; const float g = bf2f(proj[row * DIN + OFF_RG + h * 256 + ee]);
              RET[row * DM + h * 256 + ee] = (bf16)f2bf(ov[j] * rs * (g * sigmoidf_(g))); } }
        __syncthreads();
    }
}

__device__ __forceinline__ void lru_simple(const Ctx& F, int b, int cb, const bf16* proj, const float* conv_w, const float* conv_b, const float* w_r, const float* b_r,
                                           const float* w_i, const float* b_i, const float* lam, bf16* LRU) {
    LAS float* wr = (LAS float*)F.lds;
    LAS float* wi = wr + 4096;
    LAS float* xls = wi + 4096;
    LAS float* as_ = xls + 512;
    LAS float* us = as_ + 512;
    LAS float* hs = us + 512;
    __syncthreads();
    for (int i = F.tid; i < 4096; i += 512) { wr[i] = w_r[(size_t)cb * 4096 + i]; wi[i] = w_i[(size_t)cb * 4096 + i]; }
    const int ch = F.tid & 63, tt = F.tid >> 6, gch = cb * 64 + ch;
    float cw[4];
#pragma unroll
    for (int k = 0; k < 4; ++k) cw[k] = conv_w[k * DM + gch];
    const float cbias = conv_b[gch], br = b_r[gch], bi = b_i[gch];
    const float lm = lam[gch], sp = (-lm > 20.f) ? -lm : log1pf(expf(-lm));
    float hstate = 0.f;
    __syncthreads();
    for (int tile = 0; tile < SEQ / 8; ++tile) {
        const int t = tile * 8 + tt; const size_t row = (size_t)b * SEQ + t;
        float xl = cbias;
#pragma unroll
        for (int k = 0; k < 4; ++k) { const int ts = t - 3 + k; if (ts >= 0) xl += cw[k] * bf2f(proj[((size_t)b * SEQ + ts) * DIN + OFF_LX + gch]); }
        xls[tt * 64 + ch] = xl;
        __syncthreads();
        float rp = br, ip = bi;
#pragma unroll 16
        for (int d = 0; d < 64; ++d) { const float xv = xls[tt * 64 + d]; rp += xv * wr[d * 64 + ch]; ip += xv * wi[d * 64 + ch]; }
        const float r = sigmoidf_(rp), ig = sigmoidf_(ip), log_a = -8.0f * r * sp, a = expf(log_a);
        as_[tt * 64 + ch] = a; us[tt * 64 + ch] = sqrtf(-expm1f(2.0f * log_a)) * (ig * xl);
        __syncthreads();
        if (F.wave == 0) {
#pragma unroll
            for (int k = 0; k < 8; ++k) { hstate = as_[k * 64 + F.lane] * hstate + us[k * 64 + F.lane]; hs[k * 64 + F.lane] = hstate; } }
        __syncthreads();
        LRU[row * DM + gch] = (bf16)f2bf(hs[tt * 64 + ch] * gelu_tanh_f(bf2f(proj[row * DIN + OFF_LY + gch])));
    }
}
enum { I_X = 0, I_C, I_POS, I_WADA, I_BADA, I_NMIX, I_NMLP, I_WIN, I_LCW, I_LCB, I_LWR, I_LBR, I_LWI, I_LBI, I_LLAM, I_MCW, I_MCB, I_MWQ, I_MWK, I_MWV, I_MWIF, I_MBIF, I_MNORM,
       I_WBR0, I_WBR1, I_WBR2, I_WOUT, I_WFF1, I_WFF2, I_FNORM, N_INPUTS };
constexpr int PH_PER_LAYER = 9, N_PHASES = 2 + NL * PH_PER_LAYER;
struct Args { const float* in[N_INPUTS]; float* out; unsigned char* ws; int ph_lo, ph_hi; };
static_assert(sizeof(Args) == N_INPUTS * 8 + 8 + 8 + 8, "Args has no padding bytes");

__device__ __forceinline__ const float* inp(const Args& a, int i) { asm volatile("" : "+s"(i)); return a.in[i]; }
__device__ __forceinline__ unsigned char* wsbase(const Args& a) { int z = 0; asm volatile("" : "+s"(z)); return (&a.ws)[z]; }
__device__ __forceinline__ int phlo(const Args& a) { int z = 0; asm volatile("" : "+s"(z)); return (&a.ph_lo)[z]; }
__device__ __forceinline__ int phhi(const Args& a) { int z = 0; asm volatile("" : "+s"(z)); return (&a.ph_hi)[z]; }
__device__ __forceinline__ bool in_range(const Args& a, int k) { return phlo(a) <= k && k < phhi(a); }
__device__ __forceinline__ bool seam_here(const Args& a, int k) { return phlo(a) <= k && k + 1 < phhi(a); }
__device__ __forceinline__ float* outp(const Args& a) { int z = 0; asm volatile("" : "+s"(z)); return (&a.out)[z]; }
__device__ __forceinline__ Ctx make_ctx(LAS unsigned char* lds) {
    Ctx F; int g = (int)gridDim.x, bx = (int)blockIdx.x, t = (int)threadIdx.x;
    asm volatile("" : "+s"(g), "+s"(bx), "+v"(t));
    F.lds = lds; F.tid = t; F.lane = t & 63; F.wave = __builtin_amdgcn_readfirstlane(t >> 6); F.G = g; F.bx = bx; F.vcu = (g % 8 == 0) ? (bx % 8) * (g / 8) + bx / 8 : bx;
    return F;
}
__global__ void __launch_bounds__(NWAVES * 64, 2) fwd(Args args) {
    extern __shared__ __attribute__((aligned(16))) unsigned char lds_raw[];
    LAS unsigned char* const ldsb = (LAS unsigned char*)lds_raw;
    volatile LAS unsigned* MISC = (volatile LAS unsigned*)(ldsb + MISC_OFF);
    for (int u = threadIdx.x; u < (LDS_BYTES - RING_BYTES) / 4; u += NWAVES * 64) ((LAS unsigned*)(ldsb + RING_BYTES))[u] = 0u;
    __syncthreads();
    { const int span = phhi(args) - phlo(args);
      if (span > 1) (void)xcd_barrier_post((unsigned*)(wsbase(args) + WS_CTL) + 4096, MISC + 8); }
#ifndef PMASK
#define PMASK 0xFFFF
#endif
#define IN(k) in_range(args, (k))
#define PH(j) ((PMASK >> (j)) & 1)
#define SEAM(k) do { if (seam_here(args, (k))) { XcdBarrier b_; b_.bar = (unsigned*)(wsbase(args) + WS_CTL) + 4096; b_.x = xb_xcc_id(); b_.st = MISC + 8; xcd_barrier(b_); } } while (0)

#define INP(i) inp(args, (i))
#define WSP(T, off) ((T*)(wsbase(args) + (off)))
    if (PH(9) && IN(0)) { const Ctx F = make_ctx(ldsb); p0_prologue(F, INP(I_X), INP(I_C), (const int*)INP(I_POS), INP(I_WADA), INP(I_BADA), WSP(float, WS_MODF), WSP(f32x2v, WS_ROPE), outp(args)); }
    SEAM(0);

    for (int l = 0; l < NL; ++l) {
        const int kb = 1 + l * PH_PER_LAYER;
#define MOD_L(j) (WSP(float, WS_MODF) + ((size_t)l * NB * 6 + (j)) * DM)
        if (PH(0) && IN(kb + 0)) { const Ctx F = make_ctx(ldsb);
            convert_weights(F, INP(I_WIN) + (size_t)l * DM * DIN, INP(I_WBR0) + (size_t)l * DM * DM, INP(I_WBR1) + (size_t)l * DM * DM, INP(I_WBR2) + (size_t)l * DM * DM,
                            INP(I_WOUT) + (size_t)l * DM * DM, INP(I_WFF1) + (size_t)l * DM * DFF, INP(I_WFF2) + (size_t)l * DFF * DM,
                            WSP(bf16, WS_WIN), WSP(bf16, WS_WBR), WSP(bf16, WS_WOUT), WSP(bf16, WS_WFF1), WSP(bf16, WS_WFF2));
            norm_phase(F, outp(args), INP(I_NMIX) + l * DM, MOD_L(1), MOD_L(0), WSP(bf16, WS_ACT));
        }
        SEAM(kb + 0);
        if (PH(1) && IN(kb + 1)) { const Ctx F = make_ctx(ldsb); pg8::Gemm g{WSP(bf16, WS_ACT), WSP(bf16, WS_WIN), M, DIN, DM}; pg8::StaticOrder S; S.init(M, DIN, F.G, F.bx); pg8::EpiStore<0> E{WSP(bf16, WS_PROJ), DIN};
            pg8::gemm_phase<pg8::EpiStore<0>, pg8::StaticOrder, true, true>(F.lds, g, S, E); }
        SEAM(kb + 1);
        if (PH(2) && IN(kb + 2)) { const Ctx F = make_ctx(ldsb); mlstm_pre(F, WSP(bf16, WS_PROJ), INP(I_MCW) + l * 4 * DM, INP(I_MCB) + l * DM, INP(I_MWQ) + l * DM * 4, INP(I_MWK) + l * DM * 4, INP(I_MWV) + l * DM * 4,
                                  INP(I_MWIF) + (size_t)l * 3 * DM * 8, INP(I_MBIF) + l * 8, WSP(bf16, WS_MQ), WSP(bf16, WS_MK), WSP(bf16, WS_MV), WSP(float, WS_IFG)); }
        SEAM(kb + 2);
        if (PH(3) && IN(kb + 3)) { const Ctx F = make_ctx(ldsb);
            for (int it = F.vcu; it < 192; it += F.G) {
                if (it < 32) mlstm_simple(F, it >> 2, it & 3, WSP(bf16, WS_MQ), WSP(bf16, WS_MK), WSP(bf16, WS_MV), WSP(float, WS_IFG), WSP(bf16, WS_PROJ), INP(I_MNORM) + l * DM, WSP(bf16, WS_MLS));
                else if (it < 64) ret_simple(F, (it - 32) >> 2, (it - 32) & 3, WSP(bf16, WS_PROJ), WSP(f32x2v, WS_ROPE), WSP(bf16, WS_RET));
                else lru_simple(F, (it - 64) >> 4, (it - 64) & 15, WSP(bf16, WS_PROJ), INP(I_LCW) + l * 4 * DM, INP(I_LCB) + l * DM, INP(I_LWR) + (size_t)l * DM * 64, INP(I_LBR) + l * DM,
                                INP(I_LWI) + (size_t)l * DM * 64, INP(I_LBI) + l * DM, INP(I_LLAM) + l * DM, WSP(bf16, WS_LRU));
            }
        }
        SEAM(kb + 3);
        if (PH(4) && IN(kb + 4)) {
            { const Ctx F = make_ctx(ldsb); pg8::StaticOrder S; S.init(M, DM, F.G, F.bx); pg8::Gemm g{WSP(bf16, WS_RET), WSP(bf16, WS_WBR), M, DM, DM};
              pg8::EpiGate<0> E{WSP(bf16, WS_PROJ) + OFF_GATE, DIN, WSP(bf16, WS_MQ), nullptr, nullptr, DM}; pg8::gemm_phase<pg8::EpiGate<0>, pg8::StaticOrder, true, true>(F.lds, g, S, E); }
            { const Ctx F = make_ctx(ldsb); pg8::StaticOrder S; S.init(M, DM, F.G, F.bx); pg8::Gemm g{WSP(bf16, WS_LRU), WSP(bf16, WS_WBR) + (size_t)DM * DM, M, DM, DM};
              pg8::EpiGate<0> E{WSP(bf16, WS_PROJ) + OFF_GATE + DM, DIN, WSP(bf16, WS_MK), nullptr, nullptr, DM}; pg8::gemm_phase<pg8::EpiGate<0>, pg8::StaticOrder, true, true>(F.lds, g, S, E); }
            { const Ctx F = make_ctx(ldsb); pg8::StaticOrder S; S.init(M, DM, F.G, F.bx); pg8::Gemm g{WSP(bf16, WS_MLS), WSP(bf16, WS_WBR) + (size_t)2 * DM * DM, M, DM, DM};
              pg8::EpiGate<1> E{WSP(bf16, WS_PROJ) + OFF_GATE + 2 * DM, DIN, WSP(bf16, WS_ACT), WSP(bf16, WS_MQ), WSP(bf16, WS_MK), DM}; pg8::gemm_phase<pg8::EpiGate<1>, pg8::StaticOrder, true, true>(F.lds, g, S, E); }
        }
        SEAM(kb + 4);
        if (PH(5) && IN(kb + 5)) { const Ctx F = make_ctx(ldsb); pg8::Gemm g{WSP(bf16, WS_ACT), WSP(bf16, WS_WOUT), M, DM, DM}; pg8::StaticOrder S; S.init(M, DM, F.G, F.bx); pg8::EpiResid E{outp(args), MOD_L(2), 6 * DM};
            pg8::gemm_phase<pg8::EpiResid, pg8::StaticOrder, true, true>(F.lds, g, S, E); }
        SEAM(kb + 5);
        if (PH(6) && IN(kb + 6)) { const Ctx F = make_ctx(ldsb); norm_phase(F, outp(args), INP(I_NMLP) + l * DM, MOD_L(4), MOD_L(3), WSP(bf16, WS_ACT)); }
        SEAM(kb + 6);
        if (PH(7) && IN(kb + 7)) { const Ctx F = make_ctx(ldsb); pg8::Gemm g{WSP(bf16, WS_ACT), WSP(bf16, WS_WFF1), M, DFF, DM}; pg8::StaticOrder S; S.init(M, DFF, F.G, F.bx); pg8::EpiStore<2> E{WSP(bf16, WS_PROJ), DFF};
            pg8::gemm_phase<pg8::EpiStore<2>, pg8::StaticOrder, true, true>(F.lds, g, S, E); }
        SEAM(kb + 7);
        if (PH(8) && IN(kb + 8)) { const Ctx F = make_ctx(ldsb); pg8::Gemm g{WSP(bf16, WS_PROJ), WSP(bf16, WS_WFF2), M, DM, DFF}; pg8::StaticOrder S; S.init(M, DM, F.G, F.bx); pg8::EpiResid E{outp(args), MOD_L(5), 6 * DM};
            pg8::gemm_phase<pg8::EpiResid, pg8::StaticOrder, true, true>(F.lds, g, S, E); }
        SEAM(kb + 8);
    }
    if (PH(10) && IN(N_PHASES - 1)) { const Ctx F = make_ctx(ldsb); final_norm_phase(F, outp(args), INP(I_FNORM)); }
#undef INP
#undef WSP
#undef MOD_L
#undef IN
#undef SEAM
}

extern "C" void kernel_launch(void* const* d_in, const int* in_sizes, int n_in, void* d_out, int out_size, void* d_ws, size_t ws_size, hipStream_t stream) {
    static int grid = 0;
    if (grid == 0) {
        if (n_in != N_INPUTS || out_size != M * DM || ws_size < WS_END) { fprintf(stderr, "kernel_launch: unexpected shapes (n_in %d, out %d, ws %zu); nothing launched\n", n_in, out_size, ws_size); grid = -1; return; }
        int dev = 0, cus = 0, per_cu = 0;
        if (hipGetDevice(&dev) != hipSuccess || hipDeviceGetAttribute(&cus, hipDeviceAttributeMultiprocessorCount, dev) != hipSuccess) { grid = -1; return; }
        if (hipFuncSetAttribute((const void*)fwd, hipFuncAttributeMaxDynamicSharedMemorySize, LDS_BYTES) != hipSuccess) { grid = -1; return; }
        if (hipOccupancyMaxActiveBlocksPerMultiprocessor(&per_cu, (const void*)fwd, NWAVES * 64, LDS_BYTES) != hipSuccess || per_cu < 1) { fprintf(stderr, "kernel_launch: occupancy query says %d blocks per CU; nothing launched\n", per_cu); (void)hipGetLastError(); grid = -1; return; }
        grid = cus;
    }
    if (grid < 0) return;
    (void)hipMemsetAsync((char*)d_ws + WS_CTL, 0, CTL_ZERO_BYTES, stream);
    Args a{};
    for (int i = 0; i < N_INPUTS; ++i) a.in[i] = (const float*)d_in[i];
    a.out = (float*)d_out; a.ws = (unsigned char*)d_ws;
#if MK_ONE_LAUNCH
    a.ph_lo = 0; a.ph_hi = N_PHASES;
    hipLaunchKernelGGL(fwd, dim3(grid), dim3(NWAVES * 64), LDS_BYTES, stream, a);
#else
    for (int k = 0; k < N_PHASES; ++k) { a.ph_lo = k; a.ph_hi = k + 1; hipLaunchKernelGGL(fwd, dim3(grid), dim3(NWAVES * 64), LDS_BYTES, stream, a); }
#endif
}
```

```cpp
#include <hip/hip_runtime.h>
#include <cstdio>
#include <cstdint>
#include <cmath>
constexpr int NB = 8, SEQ = 2048, DM = 1024, DIN = 10240, DFF = 4096, NL = 4, M = NB * SEQ;
constexpr int OFF_RQ = 0, OFF_RK = 512, OFF_RV = 1024, OFF_RG = 2048, OFF_LX = 3072, OFF_LY = 4096, OFF_MX = 5120, OFF_MO = 6144, OFF_GATE = 7168;
constexpr float EPSF = 1e-6f;
#define MK_ONE_LAUNCH 1
namespace pg8 {
#define PG8_LAS __attribute__((address_space(3)))
typedef unsigned short bf16_t;
typedef short bf16x8 __attribute__((ext_vector_type(8)));
typedef float f32x4 __attribute__((ext_vector_type(4)));
typedef unsigned u32x4 __attribute__((ext_vector_type(4)));
constexpr int BM = 256, BK = 64, HALF = 128, HTB = HALF * BK * 2  , STAGE_BYTES = 8 * HTB, NXCD = 8, WGM = 8;

__host__ __device__ __forceinline__ int lds_byte(int r, int c) { const int st = (r >> 4) * 2 + (c >> 5), rr = r & 15, cc = c & 31, ob = rr * 64 + cc * 2; return st * 1024 + (ob ^ (((ob >> 9) & 1) << 5)); }
__host__ __device__ __forceinline__ void stage_rc(int b, int& R, int& C) { const int st = b / 1024, sb = b % 1024, swz = sb ^ (((sb >> 9) & 1) << 5); R = (st >> 1) * 16 + swz / 64; C = (st & 1) * 32 + (swz % 64) / 2; }
__host__ __device__ __forceinline__ int perm32(int rho) { const int n = rho >> 4, i = rho & 15; return 8 * (i >> 2) + 4 * n + (i & 3); }

struct Unit { int pm, pn; };
struct Gemm { const bf16_t* A; const bf16_t* Bt; int M, N, K; };

struct StaticOrder {
    int nM, nN, nwg, G, c;
    __host__ __device__ void init(int M, int N, int G_, int c_) { nM = M / BM; nN = N / BM; nwg = nM * nN; G = G_; c = c_; }
    __host__ __device__ bool next(int i, Unit& u) const {
        const long L = (long)i * G + c; if (L >= nwg) return false;
        int wgid = (int)L; { const int q = nwg / NXCD, r = nwg % NXCD, xcd = wgid % NXCD, off = wgid / NXCD; wgid = (xcd < r ? xcd * (q + 1) : r * (q + 1) + (xcd - r) * q) + off; }
        const int nig = WGM * nN, gid = wgid / nig, fm = gid * WGM, gsz = (nM - fm) < WGM ? (nM - fm) : WGM;
        u.pm = fm + ((wgid % nig) % gsz); u.pn = (wgid % nig) / gsz; return true;
    }
    __device__ __forceinline__ void a_ready(const Unit&) const {}
    __device__ __forceinline__ void done(const Unit&) const {}
};
__device__ __forceinline__ unsigned cvt_pk_bf16(float lo, float hi) { unsigned r; asm volatile("v_cvt_pk_bf16_f32 %0, %1, %2" : "=v"(r) : "v"(lo), "v"(hi)); return r; }
typedef float f32x2 __attribute__((ext_vector_type(2)));
__device__ __forceinline__ float bf_lo(unsigned w) { return __builtin_bit_cast(float, w << 16); }
__device__ __forceinline__ float bf_hi(unsigned w) { return __builtin_bit_cast(float, w & 0xffff0000u); }
__device__ __forceinline__ float sigmoid_f(float x) { return 1.0f / (1.0f + __expf(-x)); }
template <int ACT> struct EpiStore {
    static constexpr bool PERM = true, AFTER_DRAIN = false;
    bf16_t* O; int ldc;
    __device__ __forceinline__ void operator()(const f32x4 (&acc)[2][2][4][2], const Unit& u, int wr, int wc, int fr, int fq) const {
        const int row0 = u.pm * BM + wr * 64 + fr, col0 = u.pn * BM + wc * 32 + 8 * fq;
#pragma unroll
        for (int ai = 0; ai < 2; ++ai)
#pragma unroll
            for (int m = 0; m < 4; ++m) { bf16_t* rowp = O + (size_t)(row0 + ai * HALF + m * 16) * ldc + col0;
#pragma unroll
                for (int bj = 0; bj < 2; ++bj) { f32x4 v0 = acc[ai][bj][m][0], v1 = acc[ai][bj][m][1];
                    if (ACT == 2) {
#pragma unroll
                        for (int e = 0; e < 4; ++e) { const float a = fmaxf(v0[e], 0.f), b = fmaxf(v1[e], 0.f); v0[e] = a * a; v1[e] = b * b; } }
                    u32x4 w; w.x = cvt_pk_bf16(v0[0], v0[1]); w.y = cvt_pk_bf16(v0[2], v0[3]); w.z = cvt_pk_bf16(v1[0], v1[1]); w.w = cvt_pk_bf16(v1[2], v1[3]);
                    *(u32x4*)(rowp + bj * HALF) = w; } }
    }
};
template <int MODE> struct EpiGate {
    static constexpr bool PERM = true, AFTER_DRAIN = false;
    const bf16_t* G; int ldg; bf16_t* O; const bf16_t* Y1; const bf16_t* Y2; int ldc;
    __device__ __forceinline__ void operator()(const f32x4 (&acc)[2][2][4][2], const Unit& u, int wr, int wc, int fr, int fq) const {
        const int row0 = u.pm * BM + wr * 64 + fr, col0 = u.pn * BM + wc * 32 + 8 * fq;
#pragma unroll
        for (int ai = 0; ai < 2; ++ai)
#pragma unroll
            for (int m = 0; m < 4; ++m) { const size_t row = (size_t)(row0 + ai * HALF + m * 16);
#pragma unroll
                for (int bj = 0; bj < 2; ++bj) { f32x4 v0 = acc[ai][bj][m][0], v1 = acc[ai][bj][m][1];
                    const u32x4 gw = *(const u32x4*)(G + row * ldg + col0 + bj * HALF);
                    v0[0] *= sigmoid_f(bf_lo(gw.x)); v0[1] *= sigmoid_f(bf_hi(gw.x)); v0[2] *= sigmoid_f(bf_lo(gw.y)); v0[3] *= sigmoid_f(bf_hi(gw.y));
                    v1[0] *= sigmoid_f(bf_lo(gw.z)); v1[1] *= sigmoid_f(bf_hi(gw.z)); v1[2] *= sigmoid_f(bf_lo(gw.w)); v1[3] *= sigmoid_f(bf_hi(gw.w));
                    if (MODE == 1) {
                        const u32x4 a = *(const u32x4*)(Y1 + row * ldc + col0 + bj * HALF), b = *(const u32x4*)(Y2 + row * ldc + col0 + bj * HALF);
                        v0[0] += bf_lo(a.x) + bf_lo(b.x); v0[1] += bf_hi(a.x) + bf_hi(b.x); v0[2] += bf_lo(a.y) + bf_lo(b.y); v0[3] += bf_hi(a.y) + bf_hi(b.y);
                        v1[0] += bf_lo(a.z) + bf_lo(b.z); v1[1] += bf_hi(a.z) + bf_hi(b.z); v1[2] += bf_lo(a.w) + bf_lo(b.w); v1[3] += bf_hi(a.w) + bf_hi(b.w); }
                    u32x4 w; w.x = cvt_pk_bf16(v0[0], v0[1]); w.y = cvt_pk_bf16(v0[2], v0[3]); w.z = cvt_pk_bf16(v1[0], v1[1]); w.w = cvt_pk_bf16(v1[2], v1[3]);
                    *(u32x4*)(O + row * ldc + col0 + bj * HALF) = w; }
                asm volatile("" ::: "memory"); }
    }
};
struct EpiResid {
    static constexpr bool PERM = false, AFTER_DRAIN = false;
    float* X; const float* g; int gstride;
    __device__ __forceinline__ void operator()(const f32x4 (&acc)[2][2][4][2], const Unit& u, int wr, int wc, int fr, int fq) const {
        const float* gb = g + (size_t)(u.pm >> 3) * gstride;
        const int row0 = u.pm * BM + wr * 64 + fr, col0 = u.pn * BM + wc * 32 + 4 * fq;
#pragma unroll
        for (int bj = 0; bj < 2; ++bj)
#pragma unroll
            for (int n = 0; n < 2; ++n) { const f32x4 gv = *(const f32x4*)(gb + col0 + bj * HALF + n * 16);
#pragma unroll
                for (int ai = 0; ai < 2; ++ai)
#pragma unroll
                    for (int m = 0; m < 4; ++m) { float* p = X + (size_t)(row0 + ai * HALF + m * 16) * 1024 + col0 + bj * HALF + n * 16;
                        const f32x4 xv = *(const f32x4*)p; *(f32x4*)p = xv + gv * acc[ai][bj][m][n]; if (m & 1) asm volatile("" ::: "memory"); } }
    }
};
template <class Epi, class Sched, bool ALIGN_EPI = false, bool SP2 = false>
__device__ __forceinline__ void gemm_phase(PG8_LAS unsigned char* lds, const Gemm g, const Sched& S, const Epi& E) {
    int tid_o = threadIdx.x; asm volatile("" : "+v"(tid_o));
    const int tid = tid_o, wid = __builtin_amdgcn_readfirstlane(tid >> 6), lane = tid & 63, wr = wid >> 2, wc = wid & 3, fr = lane & 15, fq = lane >> 4;
    const int K = g.K, nt = K / BK;
    unsigned voffA[2], voffB[2];
#pragma unroll
    for (int i = 0; i < 2; ++i) { int R, C; stage_rc(tid * 16 + i * 8192, R, C); const int Rb = Epi::PERM ? ((R & ~31) + perm32(R & 31)) : R;
        voffA[i] = (unsigned)(R * K + C) * 2u; voffB[i] = (unsigned)(Rb * K + C) * 2u; }
    const size_t kstep = (size_t)(BK * 2);
    const size_t hstep = (size_t)HALF * K * 2;
    const size_t tstep = 2 * hstep;
    const unsigned ldsw = (unsigned)wid * 1024u;
    const int aoff = lds_byte(wr * 64 + fr, fq * 8), boff = lds_byte(wc * 32 + fr, fq * 8);
#define PG8_SA(b, h) (((b) * 2 + (h)) * HTB)
#define PG8_SB(b, h) ((4 + (b) * 2 + (h)) * HTB)
#define PG8_STAGE(bufoff, gbase, voff) do { _Pragma("unroll") for (int _i = 0; _i < 2; ++_i) \
        __builtin_amdgcn_global_load_lds((const unsigned*)((const char*)(gbase) + (voff)[_i]), (PG8_LAS unsigned*)(lds + (bufoff) + ldsw + _i * 8192), 16, 0, 0); } while (0)
#define PG8_LDA(dst, b, h) do { _Pragma("unroll") for (int m = 0; m < 4; ++m) _Pragma("unroll") for (int k = 0; k < 2; ++k) dst[m][k] = *(const PG8_LAS bf16x8*)(lds + PG8_SA(b, h) + aoff + m * 2048 + k * 1024); } while (0)
#define PG8_LDB(dst, b, h) do { _Pragma("unroll") for (int n = 0; n < 2; ++n) _Pragma("unroll") for (int k = 0; k < 2; ++k) dst[n][k] = *(const PG8_LAS bf16x8*)(lds + PG8_SB(b, h) + boff + n * 2048 + k * 1024); } while (0)
#define PG8_MMA(ai, bj, At, Bt) do { __builtin_amdgcn_s_setprio(1); _Pragma("unroll") for (int m = 0; m < 4; ++m) _Pragma("unroll") for (int n = 0; n < 2; ++n) _Pragma("unroll") for (int k = 0; k < 2; ++k) \
        acc[ai][bj][m][n] = __builtin_amdgcn_mfma_f32_16x16x32_bf16(Bt[n][k], At[m][k], acc[ai][bj][m][n], 0, 0, 0); __builtin_amdgcn_s_setprio(0); } while (0)
#define PG8_WAIT_V(n) asm volatile("s_waitcnt vmcnt(" #n ")" ::: "memory")
#define PG8_WAIT_L(n) asm volatile("s_waitcnt lgkmcnt(" #n ")" ::: "memory")
#define PG8_BAR __builtin_amdgcn_s_barrier()
#define PG8_SCHED __builtin_amdgcn_sched_barrier(0)
    Unit cur, nxt; int ui = 0;
    if (!S.next(0, cur)) return;
    f32x4 acc[2][2][4][2];
#pragma unroll
    for (int a = 0; a < 2; ++a)
#pragma unroll
        for (int b = 0; b < 2; ++b)
#pragma unroll
            for (int m = 0; m < 4; ++m)
#pragma unroll
                for (int n = 0; n < 2; ++n) acc[a][b][m][n] = (f32x4){0.f, 0.f, 0.f, 0.f};
    bf16x8 At[4][2], B0[2][2], B1[2][2];
    const char* cA = (const char*)g.A + (size_t)cur.pm * tstep; const char* cB = (const char*)g.Bt + (size_t)cur.pn * tstep;
    S.a_ready(cur);
    if constexpr (SP2) {
        PG8_STAGE(PG8_SB(0, 0), cB, voffB); PG8_STAGE(PG8_SB(0, 1), cB + hstep, voffB); PG8_STAGE(PG8_SA(0, 0), cA, voffA); PG8_STAGE(PG8_SA(0, 1), cA + hstep, voffA);
        if (wr == 1) PG8_BAR;
        PG8_WAIT_V(2); PG8_BAR;
        PG8_STAGE(PG8_SB(1, 0), cB + kstep, voffB); PG8_STAGE(PG8_SA(1, 0), cA + kstep, voffA); PG8_STAGE(PG8_SB(1, 1), cB + hstep + kstep, voffB);
        PG8_WAIT_V(6); PG8_BAR;
    } else {
        PG8_STAGE(PG8_SB(0, 0), cB, voffB); PG8_STAGE(PG8_SA(0, 0), cA, voffA); PG8_STAGE(PG8_SB(0, 1), cB + hstep, voffB); PG8_STAGE(PG8_SA(0, 1), cA + hstep, voffA);
        if (wr == 1) PG8_BAR;
        PG8_WAIT_V(4); PG8_BAR;
        PG8_STAGE(PG8_SB(1, 0), cB + kstep, voffB); PG8_STAGE(PG8_SA(1, 0), cA + kstep, voffA); PG8_STAGE(PG8_SB(1, 1), cB + hstep + kstep, voffB);
        PG8_WAIT_V(6); PG8_BAR;
    }
    for (;;) {
        const bool has_next = S.next(ui + 1, nxt);
        const char* nA = has_next ? (const char*)g.A + (size_t)nxt.pm * tstep : cA; const char* nB = has_next ? (const char*)g.Bt + (size_t)nxt.pn * tstep : cB;
        for (int t = 0; t < nt; t += 2) {
            const bool last = (t == nt - 2);
            const char* a1 = cA + (size_t)(t + 1) * kstep;
            const char* a2 = last ? nA : cA + (size_t)(t + 2) * kstep; const char* b2 = last ? nB : cB + (size_t)(t + 2) * kstep;
            const char* a3 = a2 + kstep; const char* b3 = b2 + kstep;
            if (last && has_next) S.a_ready(nxt);
            if constexpr (SP2) {
            PG8_LDB(B0, 0, 0); PG8_LDB(B1, 0, 1); PG8_SCHED; PG8_LDA(At, 0, 0); PG8_STAGE(PG8_SA(1, 1), a1 + hstep, voffA);
            PG8_WAIT_V(8); PG8_WAIT_L(0); PG8_BAR; PG8_MMA(0, 0, At, B0); PG8_MMA(0, 1, At, B1); PG8_BAR; PG8_SCHED;
            PG8_LDA(At, 0, 1); PG8_STAGE(PG8_SB(0, 0), b2, voffB); PG8_STAGE(PG8_SB(0, 1), b2 + hstep, voffB); PG8_STAGE(PG8_SA(0, 0), a2, voffA);
            PG8_WAIT_V(8); PG8_WAIT_L(0); PG8_BAR; PG8_MMA(1, 0, At, B0); PG8_MMA(1, 1, At, B1); PG8_BAR; PG8_SCHED;
            PG8_LDB(B0, 1, 0); PG8_LDB(B1, 1, 1); PG8_SCHED; PG8_LDA(At, 1, 0); PG8_STAGE(PG8_SA(0, 1), a2 + hstep, voffA);
            PG8_WAIT_V(8); PG8_WAIT_L(0); PG8_BAR; PG8_MMA(0, 0, At, B0); PG8_MMA(0, 1, At, B1); PG8_BAR; PG8_SCHED;
            PG8_LDA(At, 1, 1); PG8_STAGE(PG8_SB(1, 0), b3, voffB); PG8_STAGE(PG8_SB(1, 1), b3 + hstep, voffB); PG8_STAGE(PG8_SA(1, 0), a3, voffA);
            PG8_WAIT_V(8); PG8_WAIT_L(0); PG8_BAR; PG8_MMA(1, 0, At, B0); PG8_MMA(1, 1, At, B1); PG8_BAR; PG8_SCHED;
            } else {
            PG8_LDB(B0, 0, 0); PG8_SCHED; PG8_LDA(At, 0, 0); PG8_STAGE(PG8_SA(1, 1), a1 + hstep, voffA);
            PG8_WAIT_L(8); PG8_BAR; PG8_WAIT_L(0); PG8_MMA(0, 0, At, B0); PG8_BAR; PG8_SCHED;
            PG8_LDB(B1, 0, 1); PG8_STAGE(PG8_SB(0, 0), b2, voffB);
            PG8_BAR; PG8_WAIT_L(0); PG8_MMA(0, 1, At, B1); PG8_BAR;
            PG8_LDA(At, 0, 1); PG8_STAGE(PG8_SA(0, 0), a2, voffA);
            PG8_BAR; PG8_WAIT_L(0); PG8_MMA(1, 0, At, B0); PG8_BAR; PG8_SCHED;
            PG8_STAGE(PG8_SB(0, 1), b2 + hstep, voffB);
            PG8_WAIT_V(6); PG8_BAR; PG8_MMA(1, 1, At, B1); PG8_BAR;
            PG8_LDB(B0, 1, 0); PG8_SCHED; PG8_LDA(At, 1, 0); PG8_STAGE(PG8_SA(0, 1), a2 + hstep, voffA);
            PG8_WAIT_L(8); PG8_BAR; PG8_WAIT_L(0); PG8_MMA(0, 0, At, B0); PG8_BAR; PG8_SCHED;
            PG8_LDB(B1, 1, 1); PG8_STAGE(PG8_SB(1, 0), b3, voffB);
            PG8_BAR; PG8_WAIT_L(0); PG8_MMA(0, 1, At, B1); PG8_BAR;
            PG8_LDA(At, 1, 1); PG8_STAGE(PG8_SA(1, 0), a3, voffA);
            PG8_BAR; PG8_WAIT_L(0); PG8_MMA(1, 0, At, B0); PG8_BAR; PG8_SCHED;
            PG8_STAGE(PG8_SB(1, 1), b3 + hstep, voffB);
            PG8_WAIT_V(6); PG8_BAR; PG8_MMA(1, 1, At, B1); PG8_BAR;
            }
        }
        if constexpr (ALIGN_EPI) { if (wr == 0) PG8_BAR; }
        if constexpr (!Epi::AFTER_DRAIN) { E(acc, cur, wr, wc, fr, fq); S.done(cur); }
        if (!has_next) break;
#pragma unroll
        for (int a = 0; a < 2; ++a)
#pragma unroll
            for (int b = 0; b < 2; ++b)
#pragma unroll
                for (int m = 0; m < 4; ++m)
#pragma unroll
                    for (int n = 0; n < 2; ++n) acc[a][b][m][n] = (f32x4){0.f, 0.f, 0.f, 0.f};
        cur = nxt; cA = nA; cB = nB; ++ui;
        if constexpr (ALIGN_EPI) { if (wr == 1) PG8_BAR; }
    }
    PG8_WAIT_V(0);
    if constexpr (!ALIGN_EPI) { if (wr == 0) PG8_BAR; }
    PG8_BAR;
    if constexpr (Epi::AFTER_DRAIN) { E.fused(acc, cur, wr, wc, fr, fq, lds, wid, lane); S.done(cur); }
#undef PG8_SA
#undef PG8_SB
#undef PG8_STAGE
#undef PG8_LDA
#undef PG8_LDB
#undef PG8_MMA
#undef PG8_WAIT_V
#undef PG8_WAIT_L
#undef PG8_BAR
#undef PG8_SCHED
}
}
#ifndef MK_ONE_LAUNCH
#define MK_ONE_LAUNCH 1
#endif
constexpr int NWAVES = 8;
constexpr size_t MiB = 1u << 20;
constexpr size_t WS_CTL = 0, CTL_ZERO_BYTES = 1 * MiB;
constexpr size_t WS_MODF = 1 * MiB;
constexpr size_t WS_ROPE = 2 * MiB;
constexpr size_t WS_IFG = 10 * MiB;
constexpr size_t WS_WIN = 12 * MiB;
constexpr size_t WS_WBR = 32 * MiB;
constexpr size_t WS_WOUT = 38 * MiB;
constexpr size_t WS_WFF1 = 40 * MiB;
constexpr size_t WS_WFF2 = 48 * MiB;
constexpr size_t WS_ACT = 56 * MiB;
constexpr size_t WS_RET = 88 * MiB, WS_LRU = 120 * MiB, WS_MLS = 152 * MiB;
constexpr size_t WS_MQ = 184 * MiB, WS_MK = 216 * MiB, WS_MV = 248 * MiB;
constexpr size_t WS_PROJ = 280 * MiB;
constexpr size_t WS_END = 600 * MiB;
constexpr int LDS_BYTES = 163840;
constexpr int SCRATCH_BYTES = 163584, MISC_OFF = SCRATCH_BYTES;

#define GAS __attribute__((address_space(1)))
#define LAS __attribute__((address_space(3)))
typedef unsigned short bf16;
typedef unsigned v4u __attribute__((ext_vector_type(4)));
typedef unsigned v2u __attribute__((ext_vector_type(2)));
typedef float f32x4 __attribute__((ext_vector_type(4)));
typedef float f32x2v __attribute__((ext_vector_type(2)));
#define LDS_WAIT() asm volatile("s_waitcnt lgkmcnt(0)" ::: "memory")
#define VM_WAIT() asm volatile("s_waitcnt vmcnt(0)" ::: "memory")
__device__ __forceinline__ unsigned f2bf(float f) { unsigned u = __builtin_bit_cast(unsigned, f); return (u + 0x7fffu + ((u >> 16) & 1u)) >> 16; }
__device__ __forceinline__ unsigned pk2(float lo, float hi) { return f2bf(lo) | (f2bf(hi) << 16); }
__device__ __forceinline__ float bf2f(unsigned short h) { return __builtin_bit_cast(float, (unsigned)h << 16); }
__device__ __forceinline__ float bflo(unsigned w) { return __builtin_bit_cast(float, w << 16); }
__device__ __forceinline__ float bfhi(unsigned w) { return __builtin_bit_cast(float, w & 0xffff0000u); }
__device__ __forceinline__ float sigmoidf_(float x) { return 1.0f / (1.0f + __expf(-x)); }
__device__ __forceinline__ float wave_sum(float v) {
#pragma unroll
    for (int o = 1; o < 64; o <<= 1) v += __shfl_xor(v, o);
    return v;
}
#define XB_TMO      128
#define XB_XCNT(j)  (256  + 64 * (j))
#define XB_XSUB(j)  (1280 + 64 * (j))
#define XB_XGEN(j)  (2304 + 64 * (j))
#define XB_TOP      3328
#define XB_TOPGEN   3392
#define XCD_BAR_WORDS 3456
#define XB_SPIN_CAP (1u << 18)

__device__ __forceinline__ unsigned xb_ld(unsigned* p)              { return __hip_atomic_load(p, __ATOMIC_RELAXED, __HIP_MEMORY_SCOPE_AGENT); }
__device__ __forceinline__ unsigned xb_add(unsigned* p, unsigned v) { return __hip_atomic_fetch_add(p, v, __ATOMIC_RELAXED, __HIP_MEMORY_SCOPE_AGENT); }
__device__ __forceinline__ unsigned xb_xcc_id() { return (unsigned)__builtin_amdgcn_s_getreg((3 << 11) | 20) & 0xFu; }
#define XB_SPIN(cond, bar) do { unsigned _sp = 0; while (cond) { __builtin_amdgcn_s_sleep(1); \
    if ((++_sp & 255u) == 0u) { if (xb_ld(&(bar)[XB_TMO])) break; if (_sp > XB_SPIN_CAP) { atomicAdd(&(bar)[XB_TMO], 1u); break; } } } } while (0)

struct XcdBarrier {
    unsigned* bar; unsigned x;
    volatile LAS unsigned* st;
};

__device__ __forceinline__ XcdBarrier xcd_barrier_post(unsigned* bar, volatile LAS unsigned* st) {
    XcdBarrier b; b.bar = bar; b.x = xb_xcc_id(); b.st = st;
    if (threadIdx.x == 0) (void)xb_add(&bar[XB_XCNT(b.x)], 1u);
    return b;
}
__device__ __forceinline__ void xcd_barrier_complete(unsigned* bar, unsigned x, unsigned& nloc, unsigned& nx) {
    const unsigned G = gridDim.x * gridDim.y * gridDim.z;
    unsigned sum, cnt, mine, sp = 0u;
    for (;;) {
        sum = 0u; cnt = 0u; mine = 0u;
#pragma unroll
        for (unsigned j = 0; j < 16; ++j) { const unsigned c = xb_ld(&bar[XB_XCNT(j)]); sum += c; cnt += (c > 0u) ? 1u : 0u; mine = (j == x) ? c : mine; }
        if (sum == G) break;
        __builtin_amdgcn_s_sleep(1);
        if ((++sp & 255u) == 0u) { if (xb_ld(&bar[XB_TMO])) break; if (sp > XB_SPIN_CAP) { atomicAdd(&bar[XB_TMO], 1u); break; } }
    }
    nloc = mine > 0u ? mine : 1u; nx = cnt > 0u ? cnt : 1u;
}

__device__ __forceinline__ void xcd_barrier(const XcdBarrier& b) {
    asm volatile("s_waitcnt vmcnt(0)" ::: "memory");
    __syncthreads();
    if (threadIdx.x == 0) {
        unsigned* bar = b.bar;
        __builtin_amdgcn_s_waitcnt(0);
        unsigned nloc = b.st[0], nx = b.st[1];
        if (nloc == 0u) { xcd_barrier_complete(bar, b.x, nloc, nx); b.st[0] = nloc; b.st[1] = nx; }
        const unsigned old = xb_add(&bar[XB_XSUB(b.x)], 1u);
        const unsigned gen = old / nloc;
        if (old + 1u == (gen + 1u) * nloc) {
            __builtin_amdgcn_fence(__ATOMIC_RELEASE, "agent");
            asm volatile("s_waitcnt vmcnt(0)" ::: "memory");
            const unsigned og = xb_add(&bar[XB_TOP], 1u);
            const unsigned tg = og / nx;
            if (og + 1u == (tg + 1u) * nx) xb_add(&bar[XB_TOPGEN], 1u);
            else XB_SPIN(xb_ld(&bar[XB_TOPGEN]) == tg, bar);
            __builtin_amdgcn_fence(__ATOMIC_ACQUIRE, "agent");
            xb_add(&bar[XB_XGEN(b.x)], 1u);
            asm volatile("s_waitcnt vmcnt(0)" ::: "memory");
        } else {
            XB_SPIN(xb_ld(&bar[XB_XGEN(b.x)]) == gen, bar);
            __builtin_amdgcn_fence(__ATOMIC_ACQUIRE, "agent");
            asm volatile("s_waitcnt vmcnt(0)" ::: "memory");
        }
    }
    __syncthreads();
}
__device__ __forceinline__ void p0_transpose_item(const float* W, int K, int N, bf16* WT, int row_off, LAS float* scr, int item, int lane) {
    const int nblk = N / 32, kb = item / nblk, nb = item % nblk, k0 = 64 * kb, n0 = 32 * nb;
#pragma unroll 8
    for (int i = 0; i < 32; ++i) { const int kk = 2 * i + (lane >> 5); scr[kk * 33 + (lane & 31)] = W[(size_t)(k0 + kk) * N + n0 + (lane & 31)]; }
    LDS_WAIT(); asm volatile("" ::: "memory");
    const int c = lane & 7;
#pragma unroll
    for (int j = 0; j < 4; ++j) { const int n = (lane >> 3) + 8 * j; const LAS float* s = scr + (8 * c) * 33 + n;
        v4u o; o.x = pk2(s[0 * 33], s[1 * 33]); o.y = pk2(s[2 * 33], s[3 * 33]); o.z = pk2(s[4 * 33], s[5 * 33]); o.w = pk2(s[6 * 33], s[7 * 33]);
        *(GAS v4u*)(WT + (size_t)(row_off + n0 + n) * K + k0 + 8 * c) = o; }
    LDS_WAIT(); asm volatile("" ::: "memory");
}
struct Ctx {
    LAS unsigned char* lds;
    int tid, lane, wave, vcu, G, bx;
};

__device__ __forceinline__ void p0_prologue(const Ctx& F, const float* x, const float* c, const int* positions, const float* w_ada, const float* b_ada,
                                            float* modf, f32x2v* rope, float* xw) {
    LAS float* cond = (LAS float*)F.lds;
    LAS float* red = (LAS float*)(F.lds + 32768);
    for (int i = F.tid; i < NB * DM; i += 512) { const float v = c[i]; cond[i] = v / (1.f + __expf(-v)); }
    __syncthreads();
    const int col = F.tid & 63, ks = F.tid >> 6;
    for (int it = F.vcu; it < NL * 96; it += F.G) {
        const int l = it / 96, cg = it % 96, n = cg * 64 + col;
        const float* w = w_ada + ((size_t)l * DM + ks * 128) * (6 * DM) + n;
        float acc[8];
#pragma unroll
        for (int b = 0; b < 8; ++b) acc[b] = 0.f;
#pragma unroll 8
        for (int k = 0; k < 128; ++k) { const float wv = w[(size_t)k * (6 * DM)];
#pragma unroll
            for (int b = 0; b < 8; ++b) acc[b] += cond[b * DM + ks * 128 + k] * wv; }
#pragma unroll
        for (int b = 0; b < 8; ++b) red[(ks * 8 + b) * 64 + col] = acc[b];
        __syncthreads();
        { const int b = F.tid >> 6; float s = b_ada[l * 6 * DM + n];
#pragma unroll
          for (int k2 = 0; k2 < 8; ++k2) s += red[(k2 * 8 + b) * 64 + col];
          modf[((size_t)l * NB + b) * (6 * DM) + n] = s; }
        __syncthreads();
    }
    const int gt = F.vcu * 512 + F.tid, NT = F.G * 512;
    for (int idx = gt; idx < M * 64; idx += NT) { const int tok = idx >> 6, i = idx & 63;
        const float inv = powf(10000.0f, -(float)i * (1.0f / 64.0f)); const float ang = (float)positions[tok] * inv;
        float sn, cs; sincosf(ang, &sn, &cs); rope[idx] = (f32x2v){cs, sn}; }
    for (int idx = gt; idx < M * DM / 4; idx += NT) ((f32x4*)xw)[idx] = ((const f32x4*)x)[idx];
}

__device__ __forceinline__ void convert_weights(const Ctx& F, const float* w_in, const float* w_br0, const float* w_br1, const float* w_br2, const float* w_out,
                                                const float* w_ff1, const float* w_ff2, bf16* Win, bf16* Wbr, bf16* Wout, bf16* Wff1, bf16* Wff2) {
    LAS float* scr = (LAS float*)(F.lds + F.wave * 16384);
    const int gw = F.vcu * NWAVES + F.wave, NGW = F.G * NWAVES;
    constexpr int I_IN = (DM / 64) * (DIN / 32), I_SQ = (DM / 64) * (DM / 32), I_F1 = (DM / 64) * (DFF / 32), I_F2 = (DFF / 64) * (DM / 32);
    constexpr int NITEMS = I_IN + 4 * I_SQ + I_F1 + I_F2;
    for (int it = gw; it < NITEMS; it += NGW) {
        int r = it;
        if (r < I_IN) { p0_transpose_item(w_in, DM, DIN, Win, 0, scr, r, F.lane); continue; } r -= I_IN;
        if (r < I_SQ) { p0_transpose_item(w_br0, DM, DM, Wbr, 0, scr, r, F.lane); continue; } r -= I_SQ;
        if (r < I_SQ) { p0_transpose_item(w_br1, DM, DM, Wbr, DM, scr, r, F.lane); continue; } r -= I_SQ;
        if (r < I_SQ) { p0_transpose_item(w_br2, DM, DM, Wbr, 2 * DM, scr, r, F.lane); continue; } r -= I_SQ;
        if (r < I_SQ) { p0_transpose_item(w_out, DM, DM, Wout, 0, scr, r, F.lane); continue; } r -= I_SQ;
        if (r < I_F1) { p0_transpose_item(w_ff1, DM, DFF, Wff1, 0, scr, r, F.lane); continue; } r -= I_F1;
        p0_transpose_item(w_ff2, DFF, DM, Wff2, 0, scr, r, F.lane);
    }
}

__device__ __forceinline__ void norm_phase(const Ctx& F, const float* xw, const float* gain, const float* sc, const float* sh, bf16* out) {
    const int gw = F.vcu * NWAVES + F.wave, NGW = F.G * NWAVES;
    for (int ri = gw; ri < M / 8; ri += NGW) {
        const int b = ri / (SEQ / 8);
        f32x4 A[4], Bv[4];
#pragma unroll
        for (int j = 0; j < 4; ++j) { const int cidx = 4 * F.lane + 256 * j;
            const f32x4 g = *(const f32x4*)(gain + cidx), s1 = *(const f32x4*)(sc + (size_t)b * 6 * DM + cidx); A[j] = g * (s1 + 1.0f); Bv[j] = *(const f32x4*)(sh + (size_t)b * 6 * DM + cidx); }
        for (int r = 0; r < 8; ++r) { const size_t row = (size_t)ri * 8 + r;
            const f32x4* xr = (const f32x4*)(xw + row * DM) + F.lane;
            f32x4 v[4]; float ss = 0.f;
#pragma unroll
            for (int j = 0; j < 4; ++j) { v[j] = xr[64 * j]; ss += (v[j].x * v[j].x + v[j].y * v[j].y) + (v[j].z * v[j].z + v[j].w * v[j].w); }
            const float rs = rsqrtf(wave_sum(ss) * (1.0f / DM) + EPSF);
            unsigned long long* o8 = (unsigned long long*)(out + row * DM) + F.lane;
#pragma unroll
            for (int j = 0; j < 4; ++j) { const f32x4 o = v[j] * rs * A[j] + Bv[j];
                o8[64 * j] = (unsigned long long)pk2(o.x, o.y) | ((unsigned long long)pk2(o.z, o.w) << 32); } }
    }
}
__device__ __forceinline__ void final_norm_phase(const Ctx& F, float* xw, const float* gain) {
    const int gw = F.vcu * NWAVES + F.wave, NGW = F.G * NWAVES;
    f32x4 A[4];
#pragma unroll
    for (int j = 0; j < 4; ++j) A[j] = *(const f32x4*)(gain + 4 * F.lane + 256 * j);
    for (int row = gw; row < M; row += NGW) {
        f32x4* xr = (f32x4*)(xw + (size_t)row * DM) + F.lane;
        f32x4 v[4]; float ss = 0.f;
#pragma unroll
        for (int j = 0; j < 4; ++j) { v[j] = xr[64 * j]; ss += (v[j].x * v[j].x + v[j].y * v[j].y) + (v[j].z * v[j].z + v[j].w * v[j].w); }
        const float rs = rsqrtf(wave_sum(ss) * (1.0f / DM) + EPSF);
#pragma unroll
        for (int j = 0; j < 4; ++j) xr[64 * j] = v[j] * rs * A[j];
    }
}

__device__ __forceinline__ void mlstm_pre(const Ctx& F, const bf16* proj, const float* conv_w, const float* conv_b, const float* wq, const float* wk, const float* wv,
                                          const float* w_if, const float* b_if, bf16* MQ, bf16* MK, bf16* MV, float* IFG) {
    LAS f32x4* wif = (LAS f32x4*)F.lds;
    LAS float* part = (LAS float*)(F.lds + 98304);
    for (int e = F.tid; e < 3 * DM * 8; e += 512) { const int j = e >> 3, g = e & 7, src = j >> 10, ch = j & 1023, nb = ch >> 2, d = ch & 3, vi = (src * 4 + d) * 8 + g;
        ((LAS float*)wif)[((vi >> 2) * 256 + nb) * 4 + (vi & 3)] = w_if[e]; }
    const int u = F.tid & 255, rg = F.tid >> 8, c0 = 4 * u, wrun = F.wave & 3;
    f32x4 cw[4], Wq[4], Wk[4], Wv[4];
#pragma unroll
    for (int k = 0; k < 4; ++k) { cw[k] = *(const f32x4*)(conv_w + k * DM + c0); Wq[k] = *(const f32x4*)(wq + u * 16 + k * 4); Wk[k] = *(const f32x4*)(wk + u * 16 + k * 4); Wv[k] = *(const f32x4*)(wv + u * 16 + k * 4); }
    const f32x4 cb = *(const f32x4*)(conv_b + c0);
    __syncthreads();
    for (int rr = F.vcu; rr < M / 64; rr += F.G) {
        const int r = 2 * rr + rg, t0 = (r & 63) * 32;
        const bf16* mx = proj + (size_t)r * 32 * DIN + OFF_MX + c0;
        f32x4 x0 = {0.f, 0.f, 0.f, 0.f}, x1 = x0, x2 = x0;
        if (t0 != 0) { v2u a = *(const v2u*)(mx - 3 * (size_t)DIN), b = *(const v2u*)(mx - 2 * (size_t)DIN), cc = *(const v2u*)(mx - (size_t)DIN);
            x0 = (f32x4){bflo(a.x), bfhi(a.x), bflo(a.y), bfhi(a.y)}; x1 = (f32x4){bflo(b.x), bfhi(b.x), bflo(b.y), bfhi(b.y)}; x2 = (f32x4){bflo(cc.x), bfhi(cc.x), bflo(cc.y), bfhi(cc.y)}; }
#pragma unroll 1
        for (int tt = 0; tt < 32; ++tt) {
            const size_t row = (size_t)r * 32 + tt;
            const v2u xr = *(const v2u*)(mx + (size_t)tt * DIN);
            const f32x4 x3 = {bflo(xr.x), bfhi(xr.x), bflo(xr.y), bfhi(xr.y)};
            f32x4 cv = cb + cw[0] * x0 + cw[1] * x1 + cw[2] * x2 + cw[3] * x3;
            f32x4 xc; xc.x = cv.x * sigmoidf_(cv.x); xc.y = cv.y * sigmoidf_(cv.y); xc.z = cv.z * sigmoidf_(cv.z); xc.w = cv.w * sigmoidf_(cv.w);
            const f32x4 q = Wq[0] * xc.x + Wq[1] * xc.y + Wq[2] * xc.z + Wq[3] * xc.w;
            const f32x4 k = Wk[0] * xc.x + Wk[1] * xc.y + Wk[2] * xc.z + Wk[3] * xc.w;
            const f32x4 v = Wv[0] * x3.x + Wv[1] * x3.y + Wv[2] * x3.z + Wv[3] * x3.w;
            *(v2u*)(MQ + row * DM + c0) = (v2u){pk2(q.x, q.y), pk2(q.z, q.w)};
            *(v2u*)(MK + row * DM + c0) = (v2u){pk2(k.x, k.y), pk2(k.z, k.w)};
            *(v2u*)(MV + row * DM + c0) = (v2u){pk2(v.x, v.y), pk2(v.z, v.w)};
            f32x4 pa = {0.f, 0.f, 0.f, 0.f}, pb = pa;
            const float vals[12] = {q.x, q.y, q.z, q.w, k.x, k.y, k.z, k.w, v.x, v.y, v.z, v.w};
#pragma unroll
            for (int sd = 0; sd < 12; ++sd) { pa += wif[(sd * 2) * 256 + u] * vals[sd]; pb += wif[(sd * 2 + 1) * 256 + u] * vals[sd]; }
            const bool b0 = F.lane & 1, b1 = F.lane & 2, b2 = F.lane & 4;
            float a4[4];
#pragma unroll
            for (int i = 0; i < 4; ++i) { const float snd = b0 ? pa[i] : pb[i], kp = b0 ? pb[i] : pa[i]; a4[i] = kp + __shfl_xor(snd, 1); }
            float c2[2];
#pragma unroll
            for (int i = 0; i < 2; ++i) { const float snd = b1 ? a4[i] : a4[i + 2], kp = b1 ? a4[i + 2] : a4[i]; c2[i] = kp + __shfl_xor(snd, 2); }
            float d1; { const float snd = b2 ? c2[0] : c2[1], kp = b2 ? c2[1] : c2[0]; d1 = kp + __shfl_xor(snd, 4); }
            d1 += __shfl_xor(d1, 8); d1 += __shfl_xor(d1, 16); d1 += __shfl_xor(d1, 32);
            if (F.lane < 8) { const int gi = 4 * (F.lane & 1) + 2 * ((F.lane >> 1) & 1) + ((F.lane >> 2) & 1); part[((rg * 32 + tt) * 4 + wrun) * 8 + gi] = d1; }
            x0 = x1; x1 = x2; x2 = x3;
        }
        __syncthreads();
        { const int rg2 = F.tid >> 8, tt = (F.tid >> 3) & 31, g = F.tid & 7; const LAS float* p = part + ((rg2 * 32 + tt) * 4) * 8 + g;
          IFG[((size_t)(2 * rr + rg2) * 32 + tt) * 8 + g] = (p[0] + p[8]) + (p[16] + p[24]) + b_if[g]; }
        __syncthreads();
    }
}

__device__ __forceinline__ float log_sigmoid_f(float x) { return x >= 0.f ? -log1pf(expf(-x)) : x - log1pf(expf(x)); }
__device__ __forceinline__ float gelu_tanh_f(float x) { return 0.5f * x * (1.0f + tanhf(0.7978845608028654f * (x + 0.044715f * x * x * x))); }

__device__ __forceinline__ void mlstm_simple(const Ctx& F, int b, int h, const bf16* MQ, const bf16* MK, const bf16* MV, const float* IFG, const bf16* proj, const float* m_norm, bf16* MLS) {
    LAS float* qs = (LAS float*)F.lds;
    LAS float* ks = qs + 2048;
    LAS float* vs = ks + 2048;
    LAS float* nump = vs + 2048;
    LAS float* gi = nump + 4096;
    LAS float* gf = gi + 8;
    LAS float* ms = gf + 8;
    LAS float* denp = ms + 8;
    const int e = F.tid & 255, half = F.tid >> 8;
    float C[128];
#pragma unroll
    for (int d = 0; d < 128; ++d) C[d] = 0.f;
    float nown = 0.f, m = 0.f;
    __syncthreads();
    for (int tile = 0; tile < SEQ / 8; ++tile) {
        const size_t row0 = (size_t)b * SEQ + tile * 8;
        for (int i = F.tid; i < 2048; i += 512) { const int tk = i >> 8, ee = i & 255; const size_t o = (row0 + tk) * DM + h * 256 + ee;
            qs[i] = bf2f(MQ[o]); ks[i] = bf2f(MK[o]) * 0.0625f; vs[i] = bf2f(MV[o]); }
        if (F.tid < 8) { gi[F.tid] = IFG[(row0 + F.tid) * 8 + h]; gf[F.tid] = log_sigmoid_f(IFG[(row0 + F.tid) * 8 + 4 + h]); }
        __syncthreads();
#pragma unroll 1
        for (int tk = 0; tk < 8; ++tk) {
            const float it = gi[tk], lf = gf[tk], mn = fmaxf(lf + m, it), fs = __expf(lf + m - mn), is = __expf(it - mn); m = mn;
            const float isv = is * vs[tk * 256 + e];
            const LAS f32x4* k4 = (const LAS f32x4*)(ks + tk * 256 + half * 128);
            const LAS f32x4* q4 = (const LAS f32x4*)(qs + tk * 256 + half * 128);
            float num = 0.f;
#pragma unroll
            for (int d4 = 0; d4 < 32; ++d4) { const f32x4 kk = k4[d4], qq = q4[d4];
                C[4 * d4 + 0] = fs * C[4 * d4 + 0] + isv * kk.x; num += C[4 * d4 + 0] * qq.x;
                C[4 * d4 + 1] = fs * C[4 * d4 + 1] + isv * kk.y; num += C[4 * d4 + 1] * qq.y;
                C[4 * d4 + 2] = fs * C[4 * d4 + 2] + isv * kk.z; num += C[4 * d4 + 2] * qq.z;
                C[4 * d4 + 3] = fs * C[4 * d4 + 3] + isv * kk.w; num += C[4 * d4 + 3] * qq.w; }
            nump[(tk * 2 + half) * 256 + e] = num;
            if (half == 0) { nown = fs * nown + is * ks[tk * 256 + e]; const float dp = wave_sum(nown * qs[tk * 256 + e]); if (F.lane == 0) denp[tk * 4 + F.wave] = dp; }
            if (F.tid == 0) ms[tk] = mn;
        }
        __syncthreads();
        { const int tk = F.wave; const size_t row = row0 + tk;
          const float den = (denp[tk * 4 + 0] + denp[tk * 4 + 1]) + (denp[tk * 4 + 2] + denp[tk * 4 + 3]);
          const float dn = fmaxf(fabsf(den), __expf(-ms[tk])), rdn = 1.0f / dn;
          float hm[4], ss = 0.f;
#pragma unroll
          for (int j = 0; j < 4; ++j) { const int ee = F.lane + 64 * j; const float hh = (nump[(tk * 2) * 256 + ee] + nump[(tk * 2 + 1) * 256 + ee]) * rdn;
              hm[j] = hh * sigmoidf_(bf2f(proj[row * DIN + OFF_MO + h * 256 + ee])); ss += hm[j] * hm[j]; }
          const float rs = rsqrtf(wave_sum(ss) * (1.0f / 256.0f) + EPSF);
#pragma unroll
          for (int j = 0; j < 4; ++j) { const int ee = F.lane + 64 * j; MLS[row * DM + h * 256 + ee] = (bf16)f2bf(hm[j] * rs * m_norm[h * 256 + ee]); } }
        __syncthreads();
    }
}

__device__ __forceinline__ void ret_simple(const Ctx& F, int b, int h, const bf16* proj, const f32x2v* rope, bf16* RET) {
    LAS float* qs = (LAS float*)F.lds;
    LAS float* ks = qs + 1024;
    LAS float* vs = ks + 1024;
    LAS float* op = vs + 2048;
    const int e = F.tid & 255, half = F.tid >> 8;
    const float gamma = 1.0f - exp2f(-5.0f - (float)h);
    float S[64];
#pragma unroll
    for (int d = 0; d < 64; ++d) S[d] = 0.f;
    __syncthreads();
    for (int tile = 0; tile < SEQ / 8; ++tile) {
        const size_t row0 = (size_t)b * SEQ + tile * 8;
        for (int idx = F.tid; idx < 1024; idx += 512) { const int which = idx >> 9, tk = (idx >> 6) & 7, i = idx & 63; const size_t row = row0 + tk;
            const bf16* src = proj + row * DIN + (which ? OFF_RK : OFF_RQ) + h * 128;
            const float x1 = bf2f(src[i]), x2 = bf2f(src[64 + i]); const f32x2v cs = rope[row * 64 + i];
            const float sc = which ? 0.08838834764831845f : 1.0f;
            LAS float* dst = (which ? ks : qs) + tk * 128;
            dst[i] = (x1 * cs.x - x2 * cs.y) * sc; dst[64 + i] = (x1 * cs.y + x2 * cs.x) * sc; }
        for (int i = F.tid; i < 2048; i += 512) { const int tk = i >> 8, ee = i & 255; vs[i] = bf2f(proj[(row0 + tk) * DIN + OFF_RV + h * 256 + ee]); }
        __syncthreads();
#pragma unroll 1
        for (int tk = 0; tk < 8; ++tk) {
            const float ve = vs[tk * 256 + e];
            const LAS f32x4* k4 = (const LAS f32x4*)(ks + tk * 128 + half * 64);
            const LAS f32x4* q4 = (const LAS f32x4*)(qs + tk * 128 + half * 64);
            float o = 0.f;
#pragma unroll
            for (int d4 = 0; d4 < 16; ++d4) { const f32x4 kk = k4[d4], qq = q4[d4];
                S[4 * d4 + 0] = gamma * S[4 * d4 + 0] + ve * kk.x; o += S[4 * d4 + 0] * qq.x;
                S[4 * d4 + 1] = gamma * S[4 * d4 + 1] + ve * kk.y; o += S[4 * d4 + 1] * qq.y;
                S[4 * d4 + 2] = gamma * S[4 * d4 + 2] + ve * kk.z; o += S[4 * d4 + 2] * qq.z;
                S[4 * d4 + 3] = gamma * S[4 * d4 + 3] + ve * kk.w; o += S[4 * d4 + 3] * qq.w; }
            op[(tk * 2 + half) * 256 + e] = o;
        }
        __syncthreads();
        { const int tk = F.wave; const size_t row = row0 + tk;
          float ov[4], ss = 0.f;
#pragma unroll
          for (int j = 0; j < 4; ++j) { const int ee = F.lane + 64 * j; ov[j] = op[(tk * 2) * 256 + ee] + op[(tk * 2 + 1) * 256 + ee]; ss += ov[j] * ov[j]; }
          const float rs = rsqrtf(wave_sum(ss) * (1.0f / 256.0f) + EPSF);
#pragma unroll
          for (int j = 0; j < 4; ++j) { const int ee = F.lane + 64 * j; const float g = bf2f(proj[row * DIN + OFF_RG + h * 256 + ee]);
              RET[row * DM + h * 256 + ee] = (bf16)f2bf(ov[j] * rs * (g * sigmoidf_(g))); } }
        __syncthreads();
    }
}

__device__ __forceinline__ void lru_simple(const Ctx& F, int b, int cb, const bf16* proj, const float* conv_w, const float* conv_b, const float* w_r, const float* b_r,
                                           const float* w_i, const float* b_i, const float* lam, bf16* LRU) {
    LAS float* wr = (LAS float*)F.lds;
    LAS float* wi = wr + 4096;
    LAS float* xls = wi + 4096;
    LAS float* as_ = xls + 512;
    LAS float* us = as_ + 512;
    LAS float* hs = us + 512;
    __syncthreads();
    for (int i = F.tid; i < 4096; i += 512) { wr[i] = w_r[(size_t)cb * 4096 + i]; wi[i] = w_i[(size_t)cb * 4096 + i]; }
    const int ch = F.tid & 63, tt = F.tid >> 6, gch = cb * 64 + ch;
    float cw[4];
#pragma unroll
    for (int k = 0; k < 4; ++k) cw[k] = conv_w[k * DM + gch];
    const float cbias = conv_b[gch], br = b_r[gch], bi = b_i[gch];
    const float lm = lam[gch], sp = (-lm > 20.f) ? -lm : log1pf(expf(-lm));
    float hstate = 0.f;
    __syncthreads();
    for (int tile = 0; tile < SEQ / 8; ++tile) {
        const int t = tile * 8 + tt; const size_t row = (size_t)b * SEQ + t;
        float xl = cbias;
#pragma unroll
        for (int k = 0; k < 4; ++k) { const int ts = t - 3 + k; if (ts >= 0) xl += cw[k] * bf2f(proj[((size_t)b * SEQ + ts) * DIN + OFF_LX + gch]); }
        xls[tt * 64 + ch] = xl;
        __syncthreads();
        float rp = br, ip = bi;
#pragma unroll 16
        for (int d = 0; d < 64; ++d) { const float xv = xls[tt * 64 + d]; rp += xv * wr[d * 64 + ch]; ip += xv * wi[d * 64 + ch]; }
        const float r = sigmoidf_(rp), ig = sigmoidf_(ip), log_a = -8.0f * r * sp, a = expf(log_a);
        as_[tt * 64 + ch] = a; us[tt * 64 + ch] = sqrtf(-expm1f(2.0f * log_a)) * (ig * xl);
        __syncthreads();
        if (F.wave == 0) {
#pragma unroll
            for (int k = 0; k < 8; ++k) { hstate = as_[k * 64 + F.lane] * hstate + us[k * 64 + F.lane]; hs[k * 64 + F.lane] = hstate; } }
        __syncthreads();
        LRU[row * DM + gch] = (bf16)f2bf(hs[tt * 64 + ch] * gelu_tanh_f(bf2f(proj[row * DIN + OFF_LY + gch])));
    }
}
typedef short s16x4 __attribute__((ext_vector_type(4)));
typedef short bf16x8 __attribute__((ext_vector_type(8)));
__device__ __forceinline__ unsigned offR(unsigned rowbytes, unsigned row, unsigned ch) { return rowbytes * row + 16u * (ch ^ (row & 15u)); }
__device__ __forceinline__ unsigned offT(unsigned rowbytes, unsigned row, unsigned ch) { return rowbytes * row + 16u * (ch ^ (((row & 3u) << 2) | ((row >> 2) & 3u))); }
__device__ __forceinline__ unsigned offP(unsigned row, unsigned ch) { return 128u * row + 16u * (ch ^ ((row >> 1) & 7u)); }
__device__ __forceinline__ bf16x8 tr_frag(LAS unsigned char* base, unsigned a0, unsigned a1) {
    const s16x4 lo = __builtin_amdgcn_ds_read_tr16_b64_v4i16((LAS s16x4*)(base + a0));
    const s16x4 hi = __builtin_amdgcn_ds_read_tr16_b64_v4i16((LAS s16x4*)(base + a1));
    return (bf16x8){lo[0], lo[1], lo[2], lo[3], hi[0], hi[1], hi[2], hi[3]};
}
__device__ __forceinline__ bf16x8 pack8(const f32x4& a, const f32x4& b) {
    const unsigned w0 = pg8::cvt_pk_bf16(a[0], a[1]), w1 = pg8::cvt_pk_bf16(a[2], a[3]), w2 = pg8::cvt_pk_bf16(b[0], b[1]), w3 = pg8::cvt_pk_bf16(b[2], b[3]);
    return __builtin_bit_cast(bf16x8, (v4u){w0, w1, w2, w3});
}
__device__ __forceinline__ float scan_add(float v, int lane) {
#pragma unroll
    for (int o = 1; o < 64; o <<= 1) { const float t = __shfl_up(v, o); if (lane >= o) v += t; }
    return v;
}
__device__ __forceinline__ float scan_max(float v, int lane) {
#pragma unroll
    for (int o = 1; o < 64; o <<= 1) { const float t = __shfl_up(v, o); if (lane >= o) v = fmaxf(v, t); }
    return v;
}

template <bool ML>
__device__ __forceinline__ void chunk_mixer(const Ctx& F, int b, int h, const bf16* Qg, const bf16* Kg, const bf16* Vg, int qk_pitch, int v_pitch,
                                            const f32x2v* rope, const float* IFG, const bf16* Gg, const float* m_norm_h, bf16* OUT) {
    constexpr int DK = ML ? 256 : 128, RB = 2 * DK, NKS = DK / 32, NT = DK / 16;
    constexpr unsigned oQ = 0, oK = 64 * RB, oKW = 2 * 64 * RB, oV = 3 * 64 * RB, oP = oV + 32768, oDEN = oP + 8192, oNV = oDEN + 256;
    static_assert(oNV + 1024 <= 163584 - 0, "mixer LDS map");
    LAS unsigned char* const L = F.lds;
    LAS float* const OT = (LAS float*)L;
    LAS float* const DEN = (LAS float*)(L + oDEN);
    LAS float* const NV = (LAS float*)(L + oNV);
    const int lane = F.lane, w = F.wave;
    const float lg = log1pf(-exp2f(-5.0f - (float)h));
    f32x4 C[NT][2];
#pragma unroll
    for (int t = 0; t < NT; ++t) { C[t][0] = (f32x4){0.f, 0.f, 0.f, 0.f}; C[t][1] = C[t][0]; }
    float m_s = 0.f;
    __syncthreads();
    if (ML) { if (F.tid < 256) NV[F.tid] = 0.f; }
#pragma unroll 1
    for (int c = 0; c < SEQ / 64; ++c) {
        const size_t row0 = (size_t)b * SEQ + (size_t)c * 64;
        int lane_o = lane, g, fr, q4, p4, tid_o = F.tid;
#define RETID() asm volatile("" : "+v"(tid_o))
        RETID();
#define RELANE() do { asm volatile("" : "+v"(lane_o)); g = lane_o >> 4; fr = lane_o & 15; q4 = fr >> 2; p4 = lane_o & 3; } while (0)
        RELANE();
        float ic = 0.f, bcum = 0.f, mi = 0.f, winter = 0.f, wk, decay, rowterm = 0.f, agate = 0.f, m_new = 0.f;
        if (ML) {
            ic = IFG[(row0 + lane) * 8 + h]; const float lf = log_sigmoid_f(IFG[(row0 + lane) * 8 + 4 + h]);
            bcum = scan_add(lf, lane); agate = ic - bcum; const float cm = scan_max(agate, lane);
            mi = bcum + fmaxf(m_s, cm); winter = __expf(bcum + m_s - mi);
            const float b_last = __shfl(bcum, 63); m_new = __shfl(mi, 63);
            wk = __expf(b_last - bcum + ic - m_new); decay = __expf(b_last + m_s - m_new); rowterm = bcum - mi;
        } else { wk = __expf(lg * (float)(63 - lane)); decay = __expf(lg * 64.0f); }
        if (ML) {
#pragma unroll
            for (int i = 0; i < 4; ++i) { const int id = tid_o + 512 * i, row = id >> 5, ch = id & 31; const size_t go = (row0 + row) * (size_t)qk_pitch + 8 * ch;
                *(LAS v4u*)(L + oQ + offR(RB, row, ch)) = *(const v4u*)(Qg + go);
                const v4u kv = *(const v4u*)(Kg + go); const float wr = __shfl(wk, row) * 0.0625f;
                v4u k1, k2;
                k1.x = pg8::cvt_pk_bf16(bflo(kv.x) * 0.0625f, bfhi(kv.x) * 0.0625f); k1.y = pg8::cvt_pk_bf16(bflo(kv.y) * 0.0625f, bfhi(kv.y) * 0.0625f);
                k1.z = pg8::cvt_pk_bf16(bflo(kv.z) * 0.0625f, bfhi(kv.z) * 0.0625f); k1.w = pg8::cvt_pk_bf16(bflo(kv.w) * 0.0625f, bfhi(kv.w) * 0.0625f);
                k2.x = pg8::cvt_pk_bf16(bflo(kv.x) * wr, bfhi(kv.x) * wr); k2.y = pg8::cvt_pk_bf16(bflo(kv.y) * wr, bfhi(kv.y) * wr);
                k2.z = pg8::cvt_pk_bf16(bflo(kv.z) * wr, bfhi(kv.z) * wr); k2.w = pg8::cvt_pk_bf16(bflo(kv.w) * wr, bfhi(kv.w) * wr);
                *(LAS v4u*)(L + oK + offR(RB, row, ch)) = k1; *(LAS v4u*)(L + oKW + offT(RB, row, ch)) = k2; }
        } else {
            const int row = tid_o >> 3, c8 = tid_o & 7; const size_t go = (row0 + row) * (size_t)qk_pitch + 8 * c8;
            const v4u qa = *(const v4u*)(Qg + go), qb = *(const v4u*)(Qg + go + 64), ka = *(const v4u*)(Kg + go), kb = *(const v4u*)(Kg + go + 64);
            const f32x4* rp = (const f32x4*)(rope + (row0 + row) * 64 + 8 * c8);
            const f32x4 r0 = rp[0], r1 = rp[1], r2 = rp[2], r3 = rp[3];
            const float cs[8] = {r0.x, r0.z, r1.x, r1.z, r2.x, r2.z, r3.x, r3.z}, sn[8] = {r0.y, r0.w, r1.y, r1.w, r2.y, r2.w, r3.y, r3.w};
            const unsigned qaw[4] = {qa.x, qa.y, qa.z, qa.w}, qbw[4] = {qb.x, qb.y, qb.z, qb.w}, kaw[4] = {ka.x, ka.y, ka.z, ka.w}, kbw[4] = {kb.x, kb.y, kb.z, kb.w};
            const float ksc = 0.08838834764831845f, wr = __shfl(wk, row);
            unsigned q1[4], q2[4], k1[4], k2[4], kw1[4], kw2[4];
#pragma unroll
            for (int e = 0; e < 4; ++e) {
                const float x1a = bflo(qaw[e]), x1b = bfhi(qaw[e]), x2a = bflo(qbw[e]), x2b = bfhi(qbw[e]);
                q1[e] = pg8::cvt_pk_bf16(x1a * cs[2 * e] - x2a * sn[2 * e], x1b * cs[2 * e + 1] - x2b * sn[2 * e + 1]);
                q2[e] = pg8::cvt_pk_bf16(x1a * sn[2 * e] + x2a * cs[2 * e], x1b * sn[2 * e + 1] + x2b * cs[2 * e + 1]);
                const float y1a = bflo(kaw[e]), y1b = bfhi(kaw[e]), y2a = bflo(kbw[e]), y2b = bfhi(kbw[e]);
                const float o1a = (y1a * cs[2 * e] - y2a * sn[2 * e]) * ksc, o1b = (y1b * cs[2 * e + 1] - y2b * sn[2 * e + 1]) * ksc;
                const float o2a = (y1a * sn[2 * e] + y2a * cs[2 * e]) * ksc, o2b = (y1b * sn[2 * e + 1] + y2b * cs[2 * e + 1]) * ksc;
                k1[e] = pg8::cvt_pk_bf16(o1a, o1b); k2[e] = pg8::cvt_pk_bf16(o2a, o2b); kw1[e] = pg8::cvt_pk_bf16(o1a * wr, o1b * wr); kw2[e] = pg8::cvt_pk_bf16(o2a * wr, o2b * wr); }
            *(LAS v4u*)(L + oQ + offR(RB, row, c8)) = (v4u){q1[0], q1[1], q1[2], q1[3]}; *(LAS v4u*)(L + oQ + offR(RB, row, c8 + 8)) = (v4u){q2[0], q2[1], q2[2], q2[3]};
            *(LAS v4u*)(L + oK + offR(RB, row, c8)) = (v4u){k1[0], k1[1], k1[2], k1[3]}; *(LAS v4u*)(L + oK + offR(RB, row, c8 + 8)) = (v4u){k2[0], k2[1], k2[2], k2[3]};
            *(LAS v4u*)(L + oKW + offT(RB, row, c8)) = (v4u){kw1[0], kw1[1], kw1[2], kw1[3]}; *(LAS v4u*)(L + oKW + offT(RB, row, c8 + 8)) = (v4u){kw2[0], kw2[1], kw2[2], kw2[3]};
        }
        RETID();
#pragma unroll
        for (int i = 0; i < 4; ++i) { const int id = tid_o + 512 * i, row = id >> 5, ch = id & 31;
            *(LAS v4u*)(L + oV + offT(512, row, ch)) = *(const v4u*)(Vg + (row0 + row) * (size_t)v_pitch + 8 * ch); }
        __syncthreads();
        RELANE();
        { const int mt = w >> 1;
          f32x4 S[2] = {(f32x4){0.f, 0.f, 0.f, 0.f}, (f32x4){0.f, 0.f, 0.f, 0.f}};
          const int nt0 = 2 * (w & 1);
          if (nt0 <= mt) {
#pragma unroll
              for (int kk = 0; kk < NKS; ++kk) { const bf16x8 a = *(const LAS bf16x8*)(L + oQ + offR(RB, 16 * mt + fr, 4 * kk + g));
#pragma unroll
                  for (int tt = 0; tt < 2; ++tt) { const bf16x8 bb = *(const LAS bf16x8*)(L + oK + offR(RB, 16 * (nt0 + tt) + fr, 4 * kk + g));
                      S[tt] = __builtin_amdgcn_mfma_f32_16x16x32_bf16(a, bb, S[tt], 0, 0, 0); }
                  __builtin_amdgcn_sched_barrier(0); } }
#pragma unroll
          for (int tt = 0; tt < 2; ++tt) { const int j = 16 * (nt0 + tt) + fr; const float aj = ML ? __shfl(agate, j) : 0.f;
#pragma unroll
              for (int r = 0; r < 4; ++r) { const int i = 16 * mt + 4 * g + r; float wgt;
                  if (ML) { const float ri = __shfl(rowterm, i); wgt = (j <= i) ? __expf(ri + aj) : 0.f; } else wgt = (j <= i) ? __expf(lg * (float)(i - j)) : 0.f;
                  *(LAS unsigned short*)(L + oP + offP(i, j >> 3) + 2 * (j & 7)) = (unsigned short)f2bf(S[tt][r] * wgt); } } }
        __syncthreads();
        float nnew = 0.f;
        RETID();
        if (ML) {
            { const int i = tid_o >> 3, part = tid_o & 7;
              const v4u pv = *(const LAS v4u*)(L + oP + offP(i, part));
              float ps = (bflo(pv.x) + bfhi(pv.x)) + (bflo(pv.y) + bfhi(pv.y)) + (bflo(pv.z) + bfhi(pv.z)) + (bflo(pv.w) + bfhi(pv.w));
              float qn = 0.f;
#pragma unroll
              for (int cc = 0; cc < 4; ++cc) { const v4u qv = *(const LAS v4u*)(L + oQ + offR(RB, i, 4 * part + cc));
                  const f32x4 n0 = *(const LAS f32x4*)(NV + 32 * part + 8 * cc), n1 = *(const LAS f32x4*)(NV + 32 * part + 8 * cc + 4);
                  qn += bflo(qv.x) * n0.x + bfhi(qv.x) * n0.y + bflo(qv.y) * n0.z + bfhi(qv.y) * n0.w + bflo(qv.z) * n1.x + bfhi(qv.z) * n1.y + bflo(qv.w) * n1.z + bfhi(qv.w) * n1.w; }
              float tot = ps + __shfl(winter, i) * qn;
              tot += __shfl_xor(tot, 1); tot += __shfl_xor(tot, 2); tot += __shfl_xor(tot, 4);
              if (part == 0) DEN[i] = tot; }
            { const int dk = tid_o >> 1, hf = tid_o & 1; float s = 0.f;
#pragma unroll 8
              for (int jj = 0; jj < 32; ++jj) { const int j = 32 * hf + jj; s += bf2f(*(const LAS unsigned short*)(L + oKW + offT(RB, j, dk >> 3) + 2 * (dk & 7))); }
              s += __shfl_xor(s, 1); nnew = decay * NV[dk] + s; }
        }
        f32x4 O[4][2];
#pragma unroll
        for (int mt = 0; mt < 4; ++mt) { O[mt][0] = (f32x4){0.f, 0.f, 0.f, 0.f}; O[mt][1] = O[mt][0]; }
#pragma unroll
        for (int kk = 0; kk < NKS; ++kk) { RELANE(); const bf16x8 b0 = pack8(C[2 * kk][0], C[2 * kk + 1][0]), b1 = pack8(C[2 * kk][1], C[2 * kk + 1][1]);
#pragma unroll
            for (int mt = 0; mt < 4; ++mt) { const int i = 16 * mt + fr;
                const v2u lo = *(const LAS v2u*)(L + oQ + offR(RB, i, 4 * kk + (g >> 1)) + 8 * (g & 1)), hi = *(const LAS v2u*)(L + oQ + offR(RB, i, 4 * kk + 2 + (g >> 1)) + 8 * (g & 1));
                const bf16x8 a = __builtin_bit_cast(bf16x8, (v4u){lo.x, lo.y, hi.x, hi.y});
                O[mt][0] = __builtin_amdgcn_mfma_f32_16x16x32_bf16(a, b0, O[mt][0], 0, 0, 0); O[mt][1] = __builtin_amdgcn_mfma_f32_16x16x32_bf16(a, b1, O[mt][1], 0, 0, 0); }
            __builtin_amdgcn_sched_barrier(0); }
        RELANE();
#pragma unroll
        for (int mt = 0; mt < 4; ++mt)
#pragma unroll
            for (int r = 0; r < 4; ++r) { const int i = 16 * mt + 4 * g + r; const float sc = ML ? __shfl(winter, i) : __expf(lg * (float)(i + 1)); O[mt][0][r] *= sc; O[mt][1][r] *= sc; }
        bf16x8 vf[2][2];
        RELANE();
#pragma unroll
        for (int kk2 = 0; kk2 < 2; ++kk2)
#pragma unroll
            for (int nt = 0; nt < 2; ++nt) { const unsigned cidx = 2 * (2 * w + nt) + (p4 >> 1), rb = 32 * kk2 + 8 * g + q4;
                vf[kk2][nt] = tr_frag(L + oV, offT(512, rb, cidx) + 8 * (p4 & 1), offT(512, rb + 4, cidx) + 8 * (p4 & 1)); }
#pragma unroll
        for (int mt = 0; mt < 4; ++mt)
#pragma unroll
            for (int kk2 = 0; kk2 < 2; ++kk2) { RELANE(); const bf16x8 a = *(const LAS bf16x8*)(L + oP + offP(16 * mt + fr, 4 * kk2 + g));
                O[mt][0] = __builtin_amdgcn_mfma_f32_16x16x32_bf16(a, vf[kk2][0], O[mt][0], 0, 0, 0); O[mt][1] = __builtin_amdgcn_mfma_f32_16x16x32_bf16(a, vf[kk2][1], O[mt][1], 0, 0, 0); }
        __builtin_amdgcn_sched_barrier(0);
#pragma unroll
        for (int t = 0; t < NT; ++t) { RELANE(); C[t][0] *= decay; C[t][1] *= decay;
#pragma unroll
            for (int kk2 = 0; kk2 < 2; ++kk2) { const unsigned cidx = 2 * t + (p4 >> 1), rb = 32 * kk2 + 8 * g + q4;
                const bf16x8 a = tr_frag(L + oKW, offT(RB, rb, cidx) + 8 * (p4 & 1), offT(RB, rb + 4, cidx) + 8 * (p4 & 1));
                C[t][0] = __builtin_amdgcn_mfma_f32_16x16x32_bf16(a, vf[kk2][0], C[t][0], 0, 0, 0); C[t][1] = __builtin_amdgcn_mfma_f32_16x16x32_bf16(a, vf[kk2][1], C[t][1], 0, 0, 0); }
            __builtin_amdgcn_sched_barrier(0); }
        __syncthreads();
        if (ML) { if ((tid_o & 1) == 0) NV[tid_o >> 1] = nnew; }
        RELANE();
#pragma unroll
        for (int mt = 0; mt < 4; ++mt)
#pragma unroll
            for (int r = 0; r < 4; ++r) { const int i = 16 * mt + 4 * g + r; float inv = 1.0f;
                if (ML) { const float dn = fmaxf(fabsf(DEN[i]), __expf(-__shfl(mi, i))); inv = 1.0f / dn; }
                OT[i * 256 + 32 * w + fr] = O[mt][0][r] * inv; OT[i * 256 + 32 * w + 16 + fr] = O[mt][1][r] * inv; }
        __syncthreads();
        RETID();
        { const int row = tid_o >> 3, part = tid_o & 7, c0 = 32 * part; const size_t grow = row0 + row;
          float v[32]; float ss = 0.f;
#pragma unroll
          for (int e = 0; e < 8; ++e) { const f32x4 t4 = *(const LAS f32x4*)(OT + row * 256 + c0 + 4 * e); v[4 * e] = t4.x; v[4 * e + 1] = t4.y; v[4 * e + 2] = t4.z; v[4 * e + 3] = t4.w; }
          float gt[32];
#pragma unroll
          for (int e = 0; e < 4; ++e) { const v4u gw = *(const v4u*)(Gg + grow * DIN + c0 + 8 * e);
              gt[8 * e] = bflo(gw.x); gt[8 * e + 1] = bfhi(gw.x); gt[8 * e + 2] = bflo(gw.y); gt[8 * e + 3] = bfhi(gw.y); gt[8 * e + 4] = bflo(gw.z); gt[8 * e + 5] = bfhi(gw.z); gt[8 * e + 6] = bflo(gw.w); gt[8 * e + 7] = bfhi(gw.w); }
#pragma unroll
          for (int e = 0; e < 32; ++e) { if (ML) v[e] *= sigmoidf_(gt[e]); ss += v[e] * v[e]; }
          ss += __shfl_xor(ss, 1); ss += __shfl_xor(ss, 2); ss += __shfl_xor(ss, 4);
          const float rs = rsqrtf(ss * (1.0f / 256.0f) + EPSF);
#pragma unroll
          for (int e = 0; e < 4; ++e) { float o[8];
#pragma unroll
              for (int k = 0; k < 8; ++k) { const int ee = 8 * e + k; o[k] = ML ? v[ee] * rs * m_norm_h[c0 + ee] : v[ee] * rs * (gt[ee] * sigmoidf_(gt[ee])); }
              *(v4u*)(OUT + grow * DM + c0 + 8 * e) = (v4u){pg8::cvt_pk_bf16(o[0], o[1]), pg8::cvt_pk_bf16(o[2], o[3]), pg8::cvt_pk_bf16(o[4], o[5]), pg8::cvt_pk_bf16(o[6], o[7])}; } }
        __syncthreads();
        if (ML) m_s = m_new;
    }
#undef RELANE
#undef RETID
}
enum { I_X = 0, I_C, I_POS, I_WADA, I_BADA, I_NMIX, I_NMLP, I_WIN, I_LCW, I_LCB, I_LWR, I_LBR, I_LWI, I_LBI, I_LLAM, I_MCW, I_MCB, I_MWQ, I_MWK, I_MWV, I_MWIF, I_MBIF, I_MNORM,
       I_WBR0, I_WBR1, I_WBR2, I_WOUT, I_WFF1, I_WFF2, I_FNORM, N_INPUTS };
constexpr int PH_PER_LAYER = 9, N_PHASES = 2 + NL * PH_PER_LAYER;
struct Args { const float* in[N_INPUTS]; float* out; unsigned char* ws; int ph_lo, ph_hi; };
static_assert(sizeof(Args) == N_INPUTS * 8 + 8 + 8 + 8, "Args has no padding bytes");

__device__ __forceinline__ const float* inp(const Args& a, int i) { asm volatile("" : "+s"(i)); return a.in[i]; }
__device__ __forceinline__ unsigned char* wsbase(const Args& a) { int z = 0; asm volatile("" : "+s"(z)); return (&a.ws)[z]; }
__device__ __forceinline__ int phlo(const Args& a) { int z = 0; asm volatile("" : "+s"(z)); return (&a.ph_lo)[z]; }
__device__ __forceinline__ int phhi(const Args& a) { int z = 0; asm volatile("" : "+s"(z)); return (&a.ph_hi)[z]; }
__device__ __forceinline__ bool in_range(const Args& a, int k) { return phlo(a) <= k && k < phhi(a); }
__device__ __forceinline__ bool seam_here(const Args& a, int k) { return phlo(a) <= k && k + 1 < phhi(a); }
__device__ __forceinline__ float* outp(const Args& a) { int z = 0; asm volatile("" : "+s"(z)); return (&a.out)[z]; }
__device__ __forceinline__ Ctx make_ctx(LAS unsigned char* lds) {
    Ctx F; int g = (int)gridDim.x, bx = (int)blockIdx.x, t = (int)threadIdx.x;
    asm volatile("" : "+s"(g), "+s"(bx), "+v"(t));
    F.lds = lds; F.tid = t; F.lane = t & 63; F.wave = __builtin_amdgcn_readfirstlane(t >> 6); F.G = g; F.bx = bx; F.vcu = (g % 8 == 0) ? (bx % 8) * (g / 8) + bx / 8 : bx;
    return F;
}
__global__ void __launch_bounds__(NWAVES * 64, 2) fwd(Args args) {
    extern __shared__ __attribute__((aligned(16))) unsigned char lds_raw[];
    LAS unsigned char* const ldsb = (LAS unsigned char*)lds_raw;
    volatile LAS unsigned* MISC = (volatile LAS unsigned*)(ldsb + MISC_OFF);
    for (int u = threadIdx.x; u < (LDS_BYTES - SCRATCH_BYTES) / 4; u += NWAVES * 64) ((LAS unsigned*)(ldsb + SCRATCH_BYTES))[u] = 0u;
    __syncthreads();
    { const int span = phhi(args) - phlo(args);
      if (span > 1) (void)xcd_barrier_post((unsigned*)(wsbase(args) + WS_CTL) + 4096, MISC + 8); }
#ifndef PMASK
#define PMASK 0xFFFF
#endif
#define IN(k) in_range(args, (k))
#define PH(j) ((PMASK >> (j)) & 1)
#define SEAM(k) do { if (seam_here(args, (k))) { XcdBarrier b_; b_.bar = (unsigned*)(wsbase(args) + WS_CTL) + 4096; b_.x = xb_xcc_id(); b_.st = MISC + 8; xcd_barrier(b_); } } while (0)

#define INP(i) inp(args, (i))
#define WSP(T, off) ((T*)(wsbase(args) + (off)))
    if (PH(9) && IN(0)) { const Ctx F = make_ctx(ldsb); p0_prologue(F, INP(I_X), INP(I_C), (const int*)INP(I_POS), INP(I_WADA), INP(I_BADA), WSP(float, WS_MODF), WSP(f32x2v, WS_ROPE), outp(args)); }
    SEAM(0);

    for (int l = 0; l < NL; ++l) {
        const int kb = 1 + l * PH_PER_LAYER;
#define MOD_L(j) (WSP(float, WS_MODF) + ((size_t)l * NB * 6 + (j)) * DM)
        if (PH(0) && IN(kb + 0)) { const Ctx F = make_ctx(ldsb);
            convert_weights(F, INP(I_WIN) + (size_t)l * DM * DIN, INP(I_WBR0) + (size_t)l * DM * DM, INP(I_WBR1) + (size_t)l * DM * DM, INP(I_WBR2) + (size_t)l * DM * DM,
                            INP(I_WOUT) + (size_t)l * DM * DM, INP(I_WFF1) + (size_t)l * DM * DFF, INP(I_WFF2) + (size_t)l * DFF * DM,
                            WSP(bf16, WS_WIN), WSP(bf16, WS_WBR), WSP(bf16, WS_WOUT), WSP(bf16, WS_WFF1), WSP(bf16, WS_WFF2));
            norm_phase(F, outp(args), INP(I_NMIX) + l * DM, MOD_L(1), MOD_L(0), WSP(bf16, WS_ACT));
        }
        SEAM(kb + 0);
        if (PH(1) && IN(kb + 1)) { const Ctx F = make_ctx(ldsb); pg8::Gemm g{WSP(bf16, WS_ACT), WSP(bf16, WS_WIN), M, DIN, DM}; pg8::StaticOrder S; S.init(M, DIN, F.G, F.bx); pg8::EpiStore<0> E{WSP(bf16, WS_PROJ), DIN};
            pg8::gemm_phase<pg8::EpiStore<0>, pg8::StaticOrder, true, true>(F.lds, g, S, E); }
        SEAM(kb + 1);
        if (PH(2) && IN(kb + 2)) { const Ctx F = make_ctx(ldsb); mlstm_pre(F, WSP(bf16, WS_PROJ), INP(I_MCW) + l * 4 * DM, INP(I_MCB) + l * DM, INP(I_MWQ) + l * DM * 4, INP(I_MWK) + l * DM * 4, INP(I_MWV) + l * DM * 4,
                                  INP(I_MWIF) + (size_t)l * 3 * DM * 8, INP(I_MBIF) + l * 8, WSP(bf16, WS_MQ), WSP(bf16, WS_MK), WSP(bf16, WS_MV), WSP(float, WS_IFG)); }
        SEAM(kb + 2);
        if (PH(3) && IN(kb + 3)) { const Ctx F = make_ctx(ldsb);
            for (int it = F.vcu; it < 192; it += F.G) {
                if (it < 32) { const int b = it >> 2, h = it & 3;
                    chunk_mixer<true>(F, b, h, WSP(bf16, WS_MQ) + h * 256, WSP(bf16, WS_MK) + h * 256, WSP(bf16, WS_MV) + h * 256, DM, DM, nullptr, WSP(float, WS_IFG),
                                      WSP(bf16, WS_PROJ) + OFF_MO + h * 256, INP(I_MNORM) + l * DM + h * 256, WSP(bf16, WS_MLS) + h * 256); }
                else if (it < 64) { const int b = (it - 32) >> 2, h = (it - 32) & 3;
                    chunk_mixer<false>(F, b, h, WSP(bf16, WS_PROJ) + OFF_RQ + h * 128, WSP(bf16, WS_PROJ) + OFF_RK + h * 128, WSP(bf16, WS_PROJ) + OFF_RV + h * 256, DIN, DIN, WSP(f32x2v, WS_ROPE), nullptr,
                                       WSP(bf16, WS_PROJ) + OFF_RG + h * 256, nullptr, WSP(bf16, WS_RET) + h * 256); }
                else lru_simple(F, (it - 64) >> 4, (it - 64) & 15, WSP(bf16, WS_PROJ), INP(I_LCW) + l * 4 * DM, INP(I_LCB) + l * DM, INP(I_LWR) + (size_t)l * DM * 64, INP(I_LBR) + l * DM,
                                INP(I_LWI) + (size_t)l * DM * 64, INP(I_LBI) + l * DM, INP(I_LLAM) + l * DM, WSP(bf16, WS_LRU));
            }
        }
        SEAM(kb + 3);
        if (PH(4) && IN(kb + 4)) {
            { const Ctx F = make_ctx(ldsb); pg8::StaticOrder S; S.init(M, DM, F.G, F.bx); pg8::Gemm g{WSP(bf16, WS_RET), WSP(bf16, WS_WBR), M, DM, DM};
              pg8::EpiGate<0> E{WSP(bf16, WS_PROJ) + OFF_GATE, DIN, WSP(bf16, WS_MQ), nullptr, nullptr, DM}; pg8::gemm_phase<pg8::EpiGate<0>, pg8::StaticOrder, true, true>(F.lds, g, S, E); }
            { const Ctx F = make_ctx(ldsb); pg8::StaticOrder S; S.init(M, DM, F.G, F.bx); pg8::Gemm g{WSP(bf16, WS_LRU), WSP(bf16, WS_WBR) + (size_t)DM * DM, M, DM, DM};
              pg8::EpiGate<0> E{WSP(bf16, WS_PROJ) + OFF_GATE + DM, DIN, WSP(bf16, WS_MK), nullptr, nullptr, DM}; pg8::gemm_phase<pg8::EpiGate<0>, pg8::StaticOrder, true, true>(F.lds, g, S, E); }
            { const Ctx F = make_ctx(ldsb); pg8::StaticOrder S; S.init(M, DM, F.G, F.bx); pg8::Gemm g{WSP(bf16, WS_MLS), WSP(bf16, WS_WBR) + (size_t)2 * DM * DM, M, DM, DM};
              pg8::EpiGate<1> E{WSP(bf16, WS_PROJ) + OFF_GATE + 2 * DM, DIN, WSP(bf16, WS_ACT), WSP(bf16, WS_MQ), WSP(bf16, WS_MK), DM}; pg8::gemm_phase<pg8::EpiGate<1>, pg8::StaticOrder, true, true>(F.lds, g, S, E); }
        }
        SEAM(kb + 4);
        if (PH(5) && IN(kb + 5)) { const Ctx F = make_ctx(ldsb); pg8::Gemm g{WSP(bf16, WS_ACT), WSP(bf16, WS_WOUT), M, DM, DM}; pg8::StaticOrder S; S.init(M, DM, F.G, F.bx); pg8::EpiResid E{outp(args), MOD_L(2), 6 * DM};
            pg8::gemm_phase<pg8::EpiResid, pg8::StaticOrder, true, true>(F.lds, g, S, E); }
        SEAM(kb + 5);
        if (PH(6) && IN(kb + 6)) { const Ctx F = make_ctx(ldsb); norm_phase(F, outp(args), INP(I_NMLP) + l * DM, MOD_L(4), MOD_L(3), WSP(bf16, WS_ACT)); }
        SEAM(kb + 6);
        if (PH(7) && IN(kb + 7)) { const Ctx F = make_ctx(ldsb); pg8::Gemm g{WSP(bf16, WS_ACT), WSP(bf16, WS_WFF1), M, DFF, DM}; pg8::StaticOrder S; S.init(M, DFF, F.G, F.bx); pg8::EpiStore<2> E{WSP(bf16, WS_PROJ), DFF};
            pg8::gemm_phase<pg8::EpiStore<2>, pg8::StaticOrder, true, true>(F.lds, g, S, E); }
        SEAM(kb + 7);
        if (PH(8) && IN(kb + 8)) { const Ctx F = make_ctx(ldsb); pg8::Gemm g{WSP(bf16, WS_PROJ), WSP(bf16, WS_WFF2), M, DM, DFF}; pg8::StaticOrder S; S.init(M, DM, F.G, F.bx); pg8::EpiResid E{outp(args), MOD_L(5), 6 * DM};
            pg8::gemm_phase<pg8::EpiResid, pg8::StaticOrder, true, true>(F.lds, g, S, E); }
        SEAM(kb + 8);
    }
    if (PH(10) && IN(N_PHASES - 1)) { const Ctx F = make_ctx(ldsb); final_norm_phase(F, outp(args), INP(I_FNORM)); }
#undef INP
#undef WSP
#undef MOD_L
#undef IN
#undef SEAM
}

extern "C" void kernel_launch(void* const* d_in, const int* in_sizes, int n_in, void* d_out, int out_size, void* d_ws, size_t ws_size, hipStream_t stream) {
    static int grid = 0;
    if (grid == 0) {
        if (n_in != N_INPUTS || out_size != M * DM || ws_size < WS_END) { fprintf(stderr, "kernel_launch: unexpected shapes (n_in %d, out %d, ws %zu); nothing launched\n", n_in, out_size, ws_size); grid = -1; return; }
        int dev = 0, cus = 0, per_cu = 0;
        if (hipGetDevice(&dev) != hipSuccess || hipDeviceGetAttribute(&cus, hipDeviceAttributeMultiprocessorCount, dev) != hipSuccess) { grid = -1; return; }
        if (hipFuncSetAttribute((const void*)fwd, hipFuncAttributeMaxDynamicSharedMemorySize, LDS_BYTES) != hipSuccess) { grid = -1; return; }
        if (hipOccupancyMaxActiveBlocksPerMultiprocessor(&per_cu, (const void*)fwd, NWAVES * 64, LDS_BYTES) != hipSuccess || per_cu < 1) { fprintf(stderr, "kernel_launch: occupancy query says %d blocks per CU; nothing launched\n", per_cu); (void)hipGetLastError(); grid = -1; return; }
        grid = cus;
    }
    if (grid < 0) return;
    (void)hipMemsetAsync((char*)d_ws + WS_CTL, 0, CTL_ZERO_BYTES, stream);
    Args a{};
    for (int i = 0; i < N_INPUTS; ++i) a.in[i] = (const float*)d_in[i];
    a.out = (float*)d_out; a.ws = (unsigned char*)d_ws;
#if MK_ONE_LAUNCH
    a.ph_lo = 0; a.ph_hi = N_PHASES;
    hipLaunchKernelGGL(fwd, dim3(grid), dim3(NWAVES * 64), LDS_BYTES, stream, a);
#else
    for (int k = 0; k < N_PHASES; ++k) { a.ph_lo = k; a.ph_hi = k + 1; hipLaunchKernelGGL(fwd, dim3(grid), dim3(NWAVES * 64), LDS_BYTES, stream, a); }
#endif
}
```

```cpp
#include <hip/hip_runtime.h>
#include <cstdio>
#include <cstdint>
#include <cmath>
constexpr int NB = 8, SEQ = 2048, DM = 1024, DIN = 10240, DFF = 4096, NL = 4, M = NB * SEQ;
constexpr int OFF_RQ = 0, OFF_RK = 512, OFF_RV = 1024, OFF_RG = 2048, OFF_LX = 3072, OFF_LY = 4096, OFF_MX = 5120, OFF_MO = 6144, OFF_GATE = 7168;
constexpr float EPSF = 1e-6f;
#define MK_ONE_LAUNCH 1
namespace pg8 {
#define PG8_LAS __attribute__((address_space(3)))
typedef unsigned short bf16_t;
typedef short bf16x8 __attribute__((ext_vector_type(8)));
typedef float f32x4 __attribute__((ext_vector_type(4)));
typedef unsigned u32x4 __attribute__((ext_vector_type(4)));
constexpr int BM = 256, BK = 64, HALF = 128, HTB = HALF * BK * 2  , STAGE_BYTES = 8 * HTB, NXCD = 8, WGM = 8;

__host__ __device__ __forceinline__ int lds_byte(int r, int c) { const int st = (r >> 4) * 2 + (c >> 5), rr = r & 15, cc = c & 31, ob = rr * 64 + cc * 2; return st * 1024 + (ob ^ (((ob >> 9) & 1) << 5)); }
__host__ __device__ __forceinline__ void stage_rc(int b, int& R, int& C) { const int st = b / 1024, sb = b % 1024, swz = sb ^ (((sb >> 9) & 1) << 5); R = (st >> 1) * 16 + swz / 64; C = (st & 1) * 32 + (swz % 64) / 2; }
__host__ __device__ __forceinline__ int perm32(int rho) { const int n = rho >> 4, i = rho & 15; return 8 * (i >> 2) + 4 * n + (i & 3); }

struct Unit { int pm, pn; };
struct Gemm { const bf16_t* A; const bf16_t* Bt; int M, N, K; };

struct StaticOrder {
    int nM, nN, nwg, G, c;
    __host__ __device__ void init(int M, int N, int G_, int c_) { nM = M / BM; nN = N / BM; nwg = nM * nN; G = G_; c = c_; }
    __host__ __device__ bool next(int i, Unit& u) const {
        const long L = (long)i * G + c; if (L >= nwg) return false;
        int wgid = (int)L; { const int q = nwg / NXCD, r = nwg % NXCD, xcd = wgid % NXCD, off = wgid / NXCD; wgid = (xcd < r ? xcd * (q + 1) : r * (q + 1) + (xcd - r) * q) + off; }
        const int nig = WGM * nN, gid = wgid / nig, fm = gid * WGM, gsz = (nM - fm) < WGM ? (nM - fm) : WGM;
        u.pm = fm + ((wgid % nig) % gsz); u.pn = (wgid % nig) / gsz; return true;
    }
    __device__ __forceinline__ void a_ready(const Unit&) const {}
    __device__ __forceinline__ void done(const Unit&) const {}
};
__device__ __forceinline__ unsigned cvt_pk_bf16(float lo, float hi) { unsigned r; asm volatile("v_cvt_pk_bf16_f32 %0, %1, %2" : "=v"(r) : "v"(lo), "v"(hi)); return r; }
typedef float f32x2 __attribute__((ext_vector_type(2)));
__device__ __forceinline__ float bf_lo(unsigned w) { return __builtin_bit_cast(float, w << 16); }
__device__ __forceinline__ float bf_hi(unsigned w) { return __builtin_bit_cast(float, w & 0xffff0000u); }
__device__ __forceinline__ float sigmoid_f(float x) { return 1.0f / (1.0f + __expf(-x)); }
template <int ACT> struct EpiStore {
    static constexpr bool PERM = true, AFTER_DRAIN = false;
    bf16_t* O; int ldc;
    __device__ __forceinline__ void operator()(const f32x4 (&acc)[2][2][4][2], const Unit& u, int wr, int wc, int fr, int fq) const {
        const int row0 = u.pm * BM + wr * 64 + fr, col0 = u.pn * BM + wc * 32 + 8 * fq;
#pragma unroll
        for (int ai = 0; ai < 2; ++ai)
#pragma unroll
            for (int m = 0; m < 4; ++m) { bf16_t* rowp = O + (size_t)(row0 + ai * HALF + m * 16) * ldc + col0;
#pragma unroll
                for (int bj = 0; bj < 2; ++bj) { f32x4 v0 = acc[ai][bj][m][0], v1 = acc[ai][bj][m][1];
                    if (ACT == 2) {
#pragma unroll
                        for (int e = 0; e < 4; ++e) { const float a = fmaxf(v0[e], 0.f), b = fmaxf(v1[e], 0.f); v0[e] = a * a; v1[e] = b * b; } }
                    u32x4 w; w.x = cvt_pk_bf16(v0[0], v0[1]); w.y = cvt_pk_bf16(v0[2], v0[3]); w.z = cvt_pk_bf16(v1[0], v1[1]); w.w = cvt_pk_bf16(v1[2], v1[3]);
                    *(u32x4*)(rowp + bj * HALF) = w; } }
    }
};
template <int MODE> struct EpiGate {
    static constexpr bool PERM = true, AFTER_DRAIN = false;
    const bf16_t* G; int ldg; bf16_t* O; const bf16_t* Y1; const bf16_t* Y2; int ldc;
    __device__ __forceinline__ void operator()(const f32x4 (&acc)[2][2][4][2], const Unit& u, int wr, int wc, int fr, int fq) const {
        const int row0 = u.pm * BM + wr * 64 + fr, col0 = u.pn * BM + wc * 32 + 8 * fq;
#pragma unroll
        for (int ai = 0; ai < 2; ++ai)
#pragma unroll
            for (int m = 0; m < 4; ++m) { const size_t row = (size_t)(row0 + ai * HALF + m * 16);
#pragma unroll
                for (int bj = 0; bj < 2; ++bj) { f32x4 v0 = acc[ai][bj][m][0], v1 = acc[ai][bj][m][1];
                    const u32x4 gw = *(const u32x4*)(G + row * ldg + col0 + bj * HALF);
                    v0[0] *= sigmoid_f(bf_lo(gw.x)); v0[1] *= sigmoid_f(bf_hi(gw.x)); v0[2] *= sigmoid_f(bf_lo(gw.y)); v0[3] *= sigmoid_f(bf_hi(gw.y));
                    v1[0] *= sigmoid_f(bf_lo(gw.z)); v1[1] *= sigmoid_f(bf_hi(gw.z)); v1[2] *= sigmoid_f(bf_lo(gw.w)); v1[3] *= sigmoid_f(bf_hi(gw.w));
                    if (MODE == 1) {
                        const u32x4 a = *(const u32x4*)(Y1 + row * ldc + col0 + bj * HALF), b = *(const u32x4*)(Y2 + row * ldc + col0 + bj * HALF);
                        v0[0] += bf_lo(a.x) + bf_lo(b.x); v0[1] += bf_hi(a.x) + bf_hi(b.x); v0[2] += bf_lo(a.y) + bf_lo(b.y); v0[3] += bf_hi(a.y) + bf_hi(b.y);
                        v1[0] += bf_lo(a.z) + bf_lo(b.z); v1[1] += bf_hi(a.z) + bf_hi(b.z); v1[2] += bf_lo(a.w) + bf_lo(b.w); v1[3] += bf_hi(a.w) + bf_hi(b.w); }
                    u32x4 w; w.x = cvt_pk_bf16(v0[0], v0[1]); w.y = cvt_pk_bf16(v0[2], v0[3]); w.z = cvt_pk_bf16(v1[0], v1[1]); w.w = cvt_pk_bf16(v1[2], v1[3]);
                    *(u32x4*)(O + row * ldc + col0 + bj * HALF) = w; }
                asm volatile("" ::: "memory"); }
    }
};
struct EpiResid {
    static constexpr bool PERM = false, AFTER_DRAIN = false;
    float* X; const float* g; int gstride;
    __device__ __forceinline__ void operator()(const f32x4 (&acc)[2][2][4][2], const Unit& u, int wr, int wc, int fr, int fq) const {
        const float* gb = g + (size_t)(u.pm >> 3) * gstride;
        const int row0 = u.pm * BM + wr * 64 + fr, col0 = u.pn * BM + wc * 32 + 4 * fq;
#pragma unroll
        for (int bj = 0; bj < 2; ++bj)
#pragma unroll
            for (int n = 0; n < 2; ++n) { const f32x4 gv = *(const f32x4*)(gb + col0 + bj * HALF + n * 16);
#pragma unroll
                for (int ai = 0; ai < 2; ++ai)
#pragma unroll
                    for (int m = 0; m < 4; ++m) { float* p = X + (size_t)(row0 + ai * HALF + m * 16) * 1024 + col0 + bj * HALF + n * 16;
                        const f32x4 xv = *(const f32x4*)p; *(f32x4*)p = xv + gv * acc[ai][bj][m][n]; if (m & 1) asm volatile("" ::: "memory"); } }
    }
};
template <class Epi, class Sched, bool ALIGN_EPI = false, bool SP2 = false>
__device__ __forceinline__ void gemm_phase(PG8_LAS unsigned char* lds, const Gemm g, const Sched& S, const Epi& E) {
    int tid_o = threadIdx.x; asm volatile("" : "+v"(tid_o));
    const int tid = tid_o, wid = __builtin_amdgcn_readfirstlane(tid >> 6), lane = tid & 63, wr = wid >> 2, wc = wid & 3, fr = lane & 15, fq = lane >> 4;
    const int K = g.K, nt = K / BK;
    unsigned voffA[2], voffB[2];
#pragma unroll
    for (int i = 0; i < 2; ++i) { int R, C; stage_rc(tid * 16 + i * 8192, R, C); const int Rb = Epi::PERM ? ((R & ~31) + perm32(R & 31)) : R;
        voffA[i] = (unsigned)(R * K + C) * 2u; voffB[i] = (unsigned)(Rb * K + C) * 2u; }
    const size_t kstep = (size_t)(BK * 2);
    const size_t hstep = (size_t)HALF * K * 2;
    const size_t tstep = 2 * hstep;
    const unsigned ldsw = (unsigned)wid * 1024u;
    const int aoff = lds_byte(wr * 64 + fr, fq * 8), boff = lds_byte(wc * 32 + fr, fq * 8);
#define PG8_SA(b, h) (((b) * 2 + (h)) * HTB)
#define PG8_SB(b, h) ((4 + (b) * 2 + (h)) * HTB)
#define PG8_STAGE(bufoff, gbase, voff) do { _Pragma("unroll") for (int _i = 0; _i < 2; ++_i) \
        __builtin_amdgcn_global_load_lds((const unsigned*)((const char*)(gbase) + (voff)[_i]), (PG8_LAS unsigned*)(lds + (bufoff) + ldsw + _i * 8192), 16, 0, 0); } while (0)
#define PG8_LDA(dst, b, h) do { _Pragma("unroll") for (int m = 0; m < 4; ++m) _Pragma("unroll") for (int k = 0; k < 2; ++k) dst[m][k] = *(const PG8_LAS bf16x8*)(lds + PG8_SA(b, h) + aoff + m * 2048 + k * 1024); } while (0)
#define PG8_LDB(dst, b, h) do { _Pragma("unroll") for (int n = 0; n < 2; ++n) _Pragma("unroll") for (int k = 0; k < 2; ++k) dst[n][k] = *(const PG8_LAS bf16x8*)(lds + PG8_SB(b, h) + boff + n * 2048 + k * 1024); } while (0)
#define PG8_MMA(ai, bj, At, Bt) do { __builtin_amdgcn_s_setprio(1); _Pragma("unroll") for (int m = 0; m < 4; ++m) _Pragma("unroll") for (int n = 0; n < 2; ++n) _Pragma("unroll") for (int k = 0; k < 2; ++k) \
        acc[ai][bj][m][n] = __builtin_amdgcn_mfma_f32_16x16x32_bf16(Bt[n][k], At[m][k], acc[ai][bj][m][n], 0, 0, 0); __builtin_amdgcn_s_setprio(0); } while (0)
#define PG8_WAIT_V(n) asm volatile("s_waitcnt vmcnt(" #n ")" ::: "memory")
#define PG8_WAIT_L(n) asm volatile("s_waitcnt lgkmcnt(" #n ")" ::: "memory")
#define PG8_BAR __builtin_amdgcn_s_barrier()
#define PG8_SCHED __builtin_amdgcn_sched_barrier(0)
    Unit cur, nxt; int ui = 0;
    if (!S.next(0, cur)) return;
    f32x4 acc[2][2][4][2];
#pragma unroll
    for (int a = 0; a < 2; ++a)
#pragma unroll
        for (int b = 0; b < 2; ++b)
#pragma unroll
            for (int m = 0; m < 4; ++m)
#pragma unroll
                for (int n = 0; n < 2; ++n) acc[a][b][m][n] = (f32x4){0.f, 0.f, 0.f, 0.f};
    bf16x8 At[4][2], B0[2][2], B1[2][2];
    const char* cA = (const char*)g.A + (size_t)cur.pm * tstep; const char* cB = (const char*)g.Bt + (size_t)cur.pn * tstep;
    S.a_ready(cur);
    if constexpr (SP2) {
        PG8_STAGE(PG8_SB(0, 0), cB, voffB); PG8_STAGE(PG8_SB(0, 1), cB + hstep, voffB); PG8_STAGE(PG8_SA(0, 0), cA, voffA); PG8_STAGE(PG8_SA(0, 1), cA + hstep, voffA);
        if (wr == 1) PG8_BAR;
        PG8_WAIT_V(2); PG8_BAR;
        PG8_STAGE(PG8_SB(1, 0), cB + kstep, voffB); PG8_STAGE(PG8_SA(1, 0), cA + kstep, voffA); PG8_STAGE(PG8_SB(1, 1), cB + hstep + kstep, voffB);
        PG8_WAIT_V(6); PG8_BAR;
    } else {
        PG8_STAGE(PG8_SB(0, 0), cB, voffB); PG8_STAGE(PG8_SA(0, 0), cA, voffA); PG8_STAGE(PG8_SB(0, 1), cB + hstep, voffB); PG8_STAGE(PG8_SA(0, 1), cA + hstep, voffA);
        if (wr == 1) PG8_BAR;
        PG8_WAIT_V(4); PG8_BAR;
        PG8_STAGE(PG8_SB(1, 0), cB + kstep, voffB); PG8_STAGE(PG8_SA(1, 0), cA + kstep, voffA); PG8_STAGE(PG8_SB(1, 1), cB + hstep + kstep, voffB);
        PG8_WAIT_V(6); PG8_BAR;
    }
    for (;;) {
        const bool has_next = S.next(ui + 1, nxt);
        const char* nA = has_next ? (const char*)g.A + (size_t)nxt.pm * tstep : cA; const char* nB = has_next ? (const char*)g.Bt + (size_t)nxt.pn * tstep : cB;
        for (int t = 0; t < nt; t += 2) {
            const bool last = (t == nt - 2);
            const char* a1 = cA + (size_t)(t + 1) * kstep;
            const char* a2 = last ? nA : cA + (size_t)(t + 2) * kstep; const char* b2 = last ? nB : cB + (size_t)(t + 2) * kstep;
            const char* a3 = a2 + kstep; const char* b3 = b2 + kstep;
            if (last && has_next) S.a_ready(nxt);
            if constexpr (SP2) {
            PG8_LDB(B0, 0, 0); PG8_LDB(B1, 0, 1); PG8_SCHED; PG8_LDA(At, 0, 0); PG8_STAGE(PG8_SA(1, 1), a1 + hstep, voffA);
            PG8_WAIT_V(8); PG8_WAIT_L(0); PG8_BAR; PG8_MMA(0, 0, At, B0); PG8_MMA(0, 1, At, B1); PG8_BAR; PG8_SCHED;
            PG8_LDA(At, 0, 1); PG8_STAGE(PG8_SB(0, 0), b2, voffB); PG8_STAGE(PG8_SB(0, 1), b2 + hstep, voffB); PG8_STAGE(PG8_SA(0, 0), a2, voffA);
            PG8_WAIT_V(8); PG8_WAIT_L(0); PG8_BAR; PG8_MMA(1, 0, At, B0); PG8_MMA(1, 1, At, B1); PG8_BAR; PG8_SCHED;
            PG8_LDB(B0, 1, 0); PG8_LDB(B1, 1, 1); PG8_SCHED; PG8_LDA(At, 1, 0); PG8_STAGE(PG8_SA(0, 1), a2 + hstep, voffA);
            PG8_WAIT_V(8); PG8_WAIT_L(0); PG8_BAR; PG8_MMA(0, 0, At, B0); PG8_MMA(0, 1, At, B1); PG8_BAR; PG8_SCHED;
            PG8_LDA(At, 1, 1); PG8_STAGE(PG8_SB(1, 0), b3, voffB); PG8_STAGE(PG8_SB(1, 1), b3 + hstep, voffB); PG8_STAGE(PG8_SA(1, 0), a3, voffA);
            PG8_WAIT_V(8); PG8_WAIT_L(0); PG8_BAR; PG8_MMA(1, 0, At, B0); PG8_MMA(1, 1, At, B1); PG8_BAR; PG8_SCHED;
            } else {
            PG8_LDB(B0, 0, 0); PG8_SCHED; PG8_LDA(At, 0, 0); PG8_STAGE(PG8_SA(1, 1), a1 + hstep, voffA);
            PG8_WAIT_L(8); PG8_BAR; PG8_WAIT_L(0); PG8_MMA(0, 0, At, B0); PG8_BAR; PG8_SCHED;
            PG8_LDB(B1, 0, 1); PG8_STAGE(PG8_SB(0, 0), b2, voffB);
            PG8_BAR; PG8_WAIT_L(0); PG8_MMA(0, 1, At, B1); PG8_BAR;
            PG8_LDA(At, 0, 1); PG8_STAGE(PG8_SA(0, 0), a2, voffA);
            PG8_BAR; PG8_WAIT_L(0); PG8_MMA(1, 0, At, B0); PG8_BAR; PG8_SCHED;
            PG8_STAGE(PG8_SB(0, 1), b2 + hstep, voffB);
            PG8_WAIT_V(6); PG8_BAR; PG8_MMA(1, 1, At, B1); PG8_BAR;
            PG8_LDB(B0, 1, 0); PG8_SCHED; PG8_LDA(At, 1, 0); PG8_STAGE(PG8_SA(0, 1), a2 + hstep, voffA);
            PG8_WAIT_L(8); PG8_BAR; PG8_WAIT_L(0); PG8_MMA(0, 0, At, B0); PG8_BAR; PG8_SCHED;
            PG8_LDB(B1, 1, 1); PG8_STAGE(PG8_SB(1, 0), b3, voffB);
            PG8_BAR; PG8_WAIT_L(0); PG8_MMA(0, 1, At, B1); PG8_BAR;
            PG8_LDA(At, 1, 1); PG8_STAGE(PG8_SA(1, 0), a3, voffA);
            PG8_BAR; PG8_WAIT_L(0); PG8_MMA(1, 0, At, B0); PG8_BAR; PG8_SCHED;
            PG8_STAGE(PG8_SB(1, 1), b3 + hstep, voffB);
            PG8_WAIT_V(6); PG8_BAR; PG8_MMA(1, 1, At, B1); PG8_BAR;
            }
        }
        if constexpr (ALIGN_EPI) { if (wr == 0) PG8_BAR; }
        if constexpr (!Epi::AFTER_DRAIN) { E(acc, cur, wr, wc, fr, fq); S.done(cur); }
        if (!has_next) break;
#pragma unroll
        for (int a = 0; a < 2; ++a)
#pragma unroll
            for (int b = 0; b < 2; ++b)
#pragma unroll
                for (int m = 0; m < 4; ++m)
#pragma unroll
                    for (int n = 0; n < 2; ++n) acc[a][b][m][n] = (f32x4){0.f, 0.f, 0.f, 0.f};
        cur = nxt; cA = nA; cB = nB; ++ui;
        if constexpr (ALIGN_EPI) { if (wr == 1) PG8_BAR; }
    }
    PG8_WAIT_V(0);
    if constexpr (!ALIGN_EPI) { if (wr == 0) PG8_BAR; }
    PG8_BAR;
    if constexpr (Epi::AFTER_DRAIN) { E.fused(acc, cur, wr, wc, fr, fq, lds, wid, lane); S.done(cur); }
#undef PG8_SA
#undef PG8_SB
#undef PG8_STAGE
#undef PG8_LDA
#undef PG8_LDB
#undef PG8_MMA
#undef PG8_WAIT_V
#undef PG8_WAIT_L
#undef PG8_BAR
#undef PG8_SCHED
}
}
#ifndef MK_ONE_LAUNCH
#define MK_ONE_LAUNCH 1
#endif
constexpr int NWAVES = 8;
constexpr size_t MiB = 1u << 20;
constexpr size_t WS_CTL = 0, CTL_ZERO_BYTES = 1 * MiB;
constexpr size_t WS_MODF = 1 * MiB;
constexpr size_t WS_ROPE = 2 * MiB;
constexpr size_t WS_IFG = 10 * MiB;
constexpr size_t WS_LRUC = 11 * MiB;
constexpr size_t WS_WIN = 12 * MiB;
constexpr size_t WS_WBR = 32 * MiB;
constexpr size_t WS_WOUT = 38 * MiB;
constexpr size_t WS_WFF1 = 40 * MiB;
constexpr size_t WS_WFF2 = 48 * MiB;
constexpr size_t WS_ACT = 56 * MiB;
constexpr size_t WS_RET = 88 * MiB, WS_LRU = 120 * MiB, WS_MLS = 152 * MiB;
constexpr size_t WS_MQ = 184 * MiB, WS_MK = 216 * MiB, WS_MV = 248 * MiB;
constexpr size_t WS_PROJ = 280 * MiB;
constexpr size_t WS_END = 600 * MiB;
constexpr size_t WS_MLST = WS_ACT, WS_RTST = WS_WIN;
constexpr int LDS_BYTES = 163840;
constexpr int SCRATCH_BYTES = 163584, MISC_OFF = SCRATCH_BYTES;

#define GAS __attribute__((address_space(1)))
#define LAS __attribute__((address_space(3)))
typedef unsigned short bf16;
typedef unsigned v4u __attribute__((ext_vector_type(4)));
typedef unsigned v2u __attribute__((ext_vector_type(2)));
typedef float f32x4 __attribute__((ext_vector_type(4)));
typedef float f32x2v __attribute__((ext_vector_type(2)));
#define LDS_WAIT() asm volatile("s_waitcnt lgkmcnt(0)" ::: "memory")
#define VM_WAIT() asm volatile("s_waitcnt vmcnt(0)" ::: "memory")
__device__ __forceinline__ unsigned f2bf(float f) { unsigned u = __builtin_bit_cast(unsigned, f); return (u + 0x7fffu + ((u >> 16) & 1u)) >> 16; }
__device__ __forceinline__ unsigned pk2(float lo, float hi) { return f2bf(lo) | (f2bf(hi) << 16); }
__device__ __forceinline__ float bf2f(unsigned short h) { return __builtin_bit_cast(float, (unsigned)h << 16); }
__device__ __forceinline__ float bflo(unsigned w) { return __builtin_bit_cast(float, w << 16); }
__device__ __forceinline__ float bfhi(unsigned w) { return __builtin_bit_cast(float, w & 0xffff0000u); }
__device__ __forceinline__ float sigmoidf_(float x) { return 1.0f / (1.0f + __expf(-x)); }
__device__ __forceinline__ float wave_sum(float v) {
#pragma unroll
    for (int o = 1; o < 64; o <<= 1) v += __shfl_xor(v, o);
    return v;
}
#define XB_TMO      128
#define XB_XCNT(j)  (256  + 64 * (j))
#define XB_XSUB(j)  (1280 + 64 * (j))
#define XB_XGEN(j)  (2304 + 64 * (j))
#define XB_TOP      3328
#define XB_TOPGEN   3392
#define XCD_BAR_WORDS 3456
#define XB_SPIN_CAP (1u << 18)

__device__ __forceinline__ unsigned xb_ld(unsigned* p)              { return __hip_atomic_load(p, __ATOMIC_RELAXED, __HIP_MEMORY_SCOPE_AGENT); }
__device__ __forceinline__ unsigned xb_add(unsigned* p, unsigned v) { return __hip_atomic_fetch_add(p, v, __ATOMIC_RELAXED, __HIP_MEMORY_SCOPE_AGENT); }
__device__ __forceinline__ unsigned xb_xcc_id() { return (unsigned)__builtin_amdgcn_s_getreg((3 << 11) | 20) & 0xFu; }
#define XB_SPIN(cond, bar) do { unsigned _sp = 0; while (cond) { __builtin_amdgcn_s_sleep(1); \
    if ((++_sp & 255u) == 0u) { if (xb_ld(&(bar)[XB_TMO])) break; if (_sp > XB_SPIN_CAP) { atomicAdd(&(bar)[XB_TMO], 1u); break; } } } } while (0)

struct XcdBarrier {
    unsigned* bar; unsigned x;
    volatile LAS unsigned* st;
};

__device__ __forceinline__ XcdBarrier xcd_barrier_post(unsigned* bar, volatile LAS unsigned* st) {
    XcdBarrier b; b.bar = bar; b.x = xb_xcc_id(); b.st = st;
    if (threadIdx.x == 0) (void)xb_add(&bar[XB_XCNT(b.x)], 1u);
    return b;
}
__device__ __forceinline__ void xcd_barrier_complete(unsigned* bar, unsigned x, unsigned& nloc, unsigned& nx) {
    const unsigned G = gridDim.x * gridDim.y * gridDim.z;
    unsigned sum, cnt, mine, sp = 0u;
    for (;;) {
        sum = 0u; cnt = 0u; mine = 0u;
#pragma unroll
        for (unsigned j = 0; j < 16; ++j) { const unsigned c = xb_ld(&bar[XB_XCNT(j)]); sum += c; cnt += (c > 0u) ? 1u : 0u; mine = (j == x) ? c : mine; }
        if (sum == G) break;
        __builtin_amdgcn_s_sleep(1);
        if ((++sp & 255u) == 0u) { if (xb_ld(&bar[XB_TMO])) break; if (sp > XB_SPIN_CAP) { atomicAdd(&bar[XB_TMO], 1u); break; } }
    }
    nloc = mine > 0u ? mine : 1u; nx = cnt > 0u ? cnt : 1u;
}

__device__ __forceinline__ void xcd_barrier(const XcdBarrier& b) {
    asm volatile("s_waitcnt vmcnt(0)" ::: "memory");
    __syncthreads();
    if (threadIdx.x == 0) {
        unsigned* bar = b.bar;
        __builtin_amdgcn_s_waitcnt(0);
        unsigned nloc = b.st[0], nx = b.st[1];
        if (nloc == 0u) { xcd_barrier_complete(bar, b.x, nloc, nx); b.st[0] = nloc; b.st[1] = nx; }
        const unsigned old = xb_add(&bar[XB_XSUB(b.x)], 1u);
        const unsigned gen = old / nloc;
        if (old + 1u == (gen + 1u) * nloc) {
            __builtin_amdgcn_fence(__ATOMIC_RELEASE, "agent");
            asm volatile("s_waitcnt vmcnt(0)" ::: "memory");
            const unsigned og = xb_add(&bar[XB_TOP], 1u);
            const unsigned tg = og / nx;
            if (og + 1u == (tg + 1u) * nx) xb_add(&bar[XB_TOPGEN], 1u);
            else XB_SPIN(xb_ld(&bar[XB_TOPGEN]) == tg, bar);
            __builtin_amdgcn_fence(__ATOMIC_ACQUIRE, "agent");
            xb_add(&bar[XB_XGEN(b.x)], 1u);
            asm volatile("s_waitcnt vmcnt(0)" ::: "memory");
        } else {
            XB_SPIN(xb_ld(&bar[XB_XGEN(b.x)]) == gen, bar);
            __builtin_amdgcn_fence(__ATOMIC_ACQUIRE, "agent");
            asm volatile("s_waitcnt vmcnt(0)" ::: "memory");
        }
    }
    __syncthreads();
}
__device__ __forceinline__ void p0_transpose_item(const float* W, int K, int N, bf16* WT, int row_off, LAS float* scr, int item, int lane) {
    const int nblk = N / 32, kb = item / nblk, nb = item % nblk, k0 = 64 * kb, n0 = 32 * nb;
#pragma unroll 8
    for (int i = 0; i < 32; ++i) { const int kk = 2 * i + (lane >> 5); scr[kk * 33 + (lane & 31)] = W[(size_t)(k0 + kk) * N + n0 + (lane & 31)]; }
    LDS_WAIT(); asm volatile("" ::: "memory");
    const int c = lane & 7;
#pragma unroll
    for (int j = 0; j < 4; ++j) { const int n = (lane >> 3) + 8 * j; const LAS float* s = scr + (8 * c) * 33 + n;
        v4u o; o.x = pk2(s[0 * 33], s[1 * 33]); o.y = pk2(s[2 * 33], s[3 * 33]); o.z = pk2(s[4 * 33], s[5 * 33]); o.w = pk2(s[6 * 33], s[7 * 33]);
        *(GAS v4u*)(WT + (size_t)(row_off + n0 + n) * K + k0 + 8 * c) = o; }
    LDS_WAIT(); asm volatile("" ::: "memory");
}
__device__ __forceinline__ float log_sigmoid_f(float x) { return x >= 0.f ? -log1pf(expf(-x)) : x - log1pf(expf(x)); }
struct Ctx {
    LAS unsigned char* lds;
    int tid, lane, wave, vcu, G, bx;
};

__device__ __forceinline__ void p0_prologue(const Ctx& F, const float* x, const float* c, const int* positions, const float* w_ada, const float* b_ada,
                                            float* modf, f32x2v* rope, float* xw) {
    LAS float* cond = (LAS float*)F.lds;
    LAS float* red = (LAS float*)(F.lds + 32768);
    for (int i = F.tid; i < NB * DM; i += 512) { const float v = c[i]; cond[i] = v / (1.f + __expf(-v)); }
    __syncthreads();
    const int col = F.tid & 63, ks = F.tid >> 6;
    for (int it = F.vcu; it < NL * 96; it += F.G) {
        const int l = it / 96, cg = it % 96, n = cg * 64 + col;
        const float* w = w_ada + ((size_t)l * DM + ks * 128) * (6 * DM) + n;
        float acc[8];
#pragma unroll
        for (int b = 0; b < 8; ++b) acc[b] = 0.f;
#pragma unroll 8
        for (int k = 0; k < 128; ++k) { const float wv = w[(size_t)k * (6 * DM)];
#pragma unroll
            for (int b = 0; b < 8; ++b) acc[b] += cond[b * DM + ks * 128 + k] * wv; }
#pragma unroll
        for (int b = 0; b < 8; ++b) red[(ks * 8 + b) * 64 + col] = acc[b];
        __syncthreads();
        { const int b = F.tid >> 6; float s = b_ada[l * 6 * DM + n];
#pragma unroll
          for (int k2 = 0; k2 < 8; ++k2) s += red[(k2 * 8 + b) * 64 + col];
          modf[((size_t)l * NB + b) * (6 * DM) + n] = s; }
        __syncthreads();
    }
    const int gt = F.vcu * 512 + F.tid, NT = F.G * 512;
    for (int idx = gt; idx < M * 64; idx += NT) { const int tok = idx >> 6, i = idx & 63;
        const float inv = powf(10000.0f, -(float)i * (1.0f / 64.0f)); const float ang = (float)positions[tok] * inv;
        float sn, cs; sincosf(ang, &sn, &cs); rope[idx] = (f32x2v){cs, sn}; }
    for (int idx = gt; idx < M * DM / 4; idx += NT) ((f32x4*)xw)[idx] = ((const f32x4*)x)[idx];
}

__device__ __forceinline__ void convert_weights(const Ctx& F, const float* w_in, const float* w_br0, const float* w_br1, const float* w_br2, const float* w_out,
                                                const float* w_ff1, const float* w_ff2, bf16* Win, bf16* Wbr, bf16* Wout, bf16* Wff1, bf16* Wff2) {
    LAS float* scr = (LAS float*)(F.lds + F.wave * 16384);
    const int gw = F.vcu * NWAVES + F.wave, NGW = F.G * NWAVES;
    constexpr int I_IN = (DM / 64) * (DIN / 32), I_SQ = (DM / 64) * (DM / 32), I_F1 = (DM / 64) * (DFF / 32), I_F2 = (DFF / 64) * (DM / 32);
    constexpr int NITEMS = I_IN + 4 * I_SQ + I_F1 + I_F2;
    for (int it = gw; it < NITEMS; it += NGW) {
        int r = it;
        if (r < I_IN) { p0_transpose_item(w_in, DM, DIN, Win, 0, scr, r, F.lane); continue; } r -= I_IN;
        if (r < I_SQ) { p0_transpose_item(w_br0, DM, DM, Wbr, 0, scr, r, F.lane); continue; } r -= I_SQ;
        if (r < I_SQ) { p0_transpose_item(w_br1, DM, DM, Wbr, DM, scr, r, F.lane); continue; } r -= I_SQ;
        if (r < I_SQ) { p0_transpose_item(w_br2, DM, DM, Wbr, 2 * DM, scr, r, F.lane); continue; } r -= I_SQ;
        if (r < I_SQ) { p0_transpose_item(w_out, DM, DM, Wout, 0, scr, r, F.lane); continue; } r -= I_SQ;
        if (r < I_F1) { p0_transpose_item(w_ff1, DM, DFF, Wff1, 0, scr, r, F.lane); continue; } r -= I_F1;
        p0_transpose_item(w_ff2, DFF, DM, Wff2, 0, scr, r, F.lane);
    }
}

__device__ __forceinline__ void norm_phase(const Ctx& F, const float* xw, const float* gain, const float* sc, const float* sh, bf16* out) {
    const int gw = F.vcu * NWAVES + F.wave, NGW = F.G * NWAVES;
    for (int ri = gw; ri < M / 8; ri += NGW) {
        const int b = ri / (SEQ / 8);
        f32x4 A[4], Bv[4];
#pragma unroll
        for (int j = 0; j < 4; ++j) { const int cidx = 4 * F.lane + 256 * j;
            const f32x4 g = *(const f32x4*)(gain + cidx), s1 = *(const f32x4*)(sc + (size_t)b * 6 * DM + cidx); A[j] = g * (s1 + 1.0f); Bv[j] = *(const f32x4*)(sh + (size_t)b * 6 * DM + cidx); }
        for (int r = 0; r < 8; ++r) { const size_t row = (size_t)ri * 8 + r;
            const f32x4* xr = (const f32x4*)(xw + row * DM) + F.lane;
            f32x4 v[4]; float ss = 0.f;
#pragma unroll
            for (int j = 0; j < 4; ++j) { v[j] = xr[64 * j]; ss += (v[j].x * v[j].x + v[j].y * v[j].y) + (v[j].z * v[j].z + v[j].w * v[j].w); }
            const float rs = rsqrtf(wave_sum(ss) * (1.0f / DM) + EPSF);
            unsigned long long* o8 = (unsigned long long*)(out + row * DM) + F.lane;
#pragma unroll
            for (int j = 0; j < 4; ++j) { const f32x4 o = v[j] * rs * A[j] + Bv[j];
                o8[64 * j] = (unsigned long long)pk2(o.x, o.y) | ((unsigned long long)pk2(o.z, o.w) << 32); } }
    }
}
__device__ __forceinline__ void final_norm_phase(const Ctx& F, float* xw, const float* gain) {
    const int gw = F.vcu * NWAVES + F.wave, NGW = F.G * NWAVES;
    f32x4 A[4];
#pragma unroll
    for (int j = 0; j < 4; ++j) A[j] = *(const f32x4*)(gain + 4 * F.lane + 256 * j);
    for (int row = gw; row < M; row += NGW) {
        f32x4* xr = (f32x4*)(xw + (size_t)row * DM) + F.lane;
        f32x4 v[4]; float ss = 0.f;
#pragma unroll
        for (int j = 0; j < 4; ++j) { v[j] = xr[64 * j]; ss += (v[j].x * v[j].x + v[j].y * v[j].y) + (v[j].z * v[j].z + v[j].w * v[j].w); }
        const float rs = rsqrtf(wave_sum(ss) * (1.0f / DM) + EPSF);
#pragma unroll
        for (int j = 0; j < 4; ++j) xr[64 * j] = v[j] * rs * A[j];
    }
}

__device__ __forceinline__ void mlstm_pre(const Ctx& F, const bf16* proj, const float* conv_w, const float* conv_b, const float* wq, const float* wk, const float* wv,
                                          const float* w_if, const float* b_if, bf16* MQ, bf16* MK, bf16* MV, float* IFG) {
    LAS f32x4* wif = (LAS f32x4*)F.lds;
    LAS float* part = (LAS float*)(F.lds + 98304);
    for (int e = F.tid; e < 3 * DM * 8; e += 512) { const int j = e >> 3, g = e & 7, src = j >> 10, ch = j & 1023, nb = ch >> 2, d = ch & 3, vi = (src * 4 + d) * 8 + g;
        ((LAS float*)wif)[((vi >> 2) * 256 + nb) * 4 + (vi & 3)] = w_if[e]; }
    const int u = F.tid & 255, rg = F.tid >> 8, c0 = 4 * u, wrun = F.wave & 3;
    f32x4 cw[4], Wq[4], Wk[4], Wv[4];
#pragma unroll
    for (int k = 0; k < 4; ++k) { cw[k] = *(const f32x4*)(conv_w + k * DM + c0); Wq[k] = *(const f32x4*)(wq + u * 16 + k * 4); Wk[k] = *(const f32x4*)(wk + u * 16 + k * 4); Wv[k] = *(const f32x4*)(wv + u * 16 + k * 4); }
    const f32x4 cb = *(const f32x4*)(conv_b + c0);
    __syncthreads();
    for (int rr = F.vcu; rr < M / 64; rr += F.G) {
        const int r = 2 * rr + rg, t0 = (r & 63) * 32;
        const bf16* mx = proj + (size_t)r * 32 * DIN + OFF_MX + c0;
        f32x4 x0 = {0.f, 0.f, 0.f, 0.f}, x1 = x0, x2 = x0;
        if (t0 != 0) { v2u a = *(const v2u*)(mx - 3 * (size_t)DIN), b = *(const v2u*)(mx - 2 * (size_t)DIN), cc = *(const v2u*)(mx - (size_t)DIN);
            x0 = (f32x4){bflo(a.x), bfhi(a.x), bflo(a.y), bfhi(a.y)}; x1 = (f32x4){bflo(b.x), bfhi(b.x), bflo(b.y), bfhi(b.y)}; x2 = (f32x4){bflo(cc.x), bfhi(cc.x), bflo(cc.y), bfhi(cc.y)}; }
#pragma unroll 1
        for (int tt = 0; tt < 32; ++tt) {
            const size_t row = (size_t)r * 32 + tt;
            const v2u xr = *(const v2u*)(mx + (size_t)tt * DIN);
            const f32x4 x3 = {bflo(xr.x), bfhi(xr.x), bflo(xr.y), bfhi(xr.y)};
            f32x4 cv = cb + cw[0] * x0 + cw[1] * x1 + cw[2] * x2 + cw[3] * x3;
            f32x4 xc; xc.x = cv.x * sigmoidf_(cv.x); xc.y = cv.y * sigmoidf_(cv.y); xc.z = cv.z * sigmoidf_(cv.z); xc.w = cv.w * sigmoidf_(cv.w);
            const f32x4 q = Wq[0] * xc.x + Wq[1] * xc.y + Wq[2] * xc.z + Wq[3] * xc.w;
            const f32x4 k = Wk[0] * xc.x + Wk[1] * xc.y + Wk[2] * xc.z + Wk[3] * xc.w;
            const f32x4 v = Wv[0] * x3.x + Wv[1] * x3.y + Wv[2] * x3.z + Wv[3] * x3.w;
            *(v2u*)(MQ + row * DM + c0) = (v2u){pk2(q.x, q.y), pk2(q.z, q.w)};
            *(v2u*)(MK + row * DM + c0) = (v2u){pk2(k.x * 0.0625f, k.y * 0.0625f), pk2(k.z * 0.0625f, k.w * 0.0625f)};
            *(v2u*)(MV + row * DM + c0) = (v2u){pk2(v.x, v.y), pk2(v.z, v.w)};
            f32x4 pa = {0.f, 0.f, 0.f, 0.f}, pb = pa;
            const float vals[12] = {q.x, q.y, q.z, q.w, k.x, k.y, k.z, k.w, v.x, v.y, v.z, v.w};
#pragma unroll
            for (int sd = 0; sd < 12; ++sd) { pa += wif[(sd * 2) * 256 + u] * vals[sd]; pb += wif[(sd * 2 + 1) * 256 + u] * vals[sd]; }
            const bool b0 = F.lane & 1, b1 = F.lane & 2, b2 = F.lane & 4;
            float a4[4];
#pragma unroll
            for (int i = 0; i < 4; ++i) { const float snd = b0 ? pa[i] : pb[i], kp = b0 ? pb[i] : pa[i]; a4[i] = kp + __shfl_xor(snd, 1); }
            float c2[2];
#pragma unroll
            for (int i = 0; i < 2; ++i) { const float snd = b1 ? a4[i] : a4[i + 2], kp = b1 ? a4[i + 2] : a4[i]; c2[i] = kp + __shfl_xor(snd, 2); }
            float d1; { const float snd = b2 ? c2[0] : c2[1], kp = b2 ? c2[1] : c2[0]; d1 = kp + __shfl_xor(snd, 4); }
            d1 += __shfl_xor(d1, 8); d1 += __shfl_xor(d1, 16); d1 += __shfl_xor(d1, 32);
            if (F.lane < 8) { const int gi = 4 * (F.lane & 1) + 2 * ((F.lane >> 1) & 1) + ((F.lane >> 2) & 1); part[((rg * 32 + tt) * 4 + wrun) * 8 + gi] = d1; }
            x0 = x1; x1 = x2; x2 = x3;
        }
        __syncthreads();
        { const int rg2 = F.tid >> 8, tt = (F.tid >> 3) & 31, g = F.tid & 7; const LAS float* p = part + ((rg2 * 32 + tt) * 4) * 8 + g;
          const float gv = (p[0] + p[8]) + (p[16] + p[24]) + b_if[g];
          IFG[((size_t)(2 * rr + rg2) * 32 + tt) * 8 + g] = (g >= 4) ? log_sigmoid_f(gv) : gv; }
        __syncthreads();
    }
}

__device__ __forceinline__ float gelu_tanh_f(float x) { return 0.5f * x * (1.0f + tanhf(0.7978845608028654f * (x + 0.044715f * x * x * x))); }

typedef short s16x4 __attribute__((ext_vector_type(4)));
typedef short bf16x8 __attribute__((ext_vector_type(8)));
__device__ __forceinline__ bf16x8 tr_frag(LAS unsigned char* p0, LAS unsigned char* p1) {
    const s16x4 lo = __builtin_amdgcn_ds_read_tr16_b64_v4i16((LAS s16x4*)p0);
    const s16x4 hi = __builtin_amdgcn_ds_read_tr16_b64_v4i16((LAS s16x4*)p1);
    return (bf16x8){lo[0], lo[1], lo[2], lo[3], hi[0], hi[1], hi[2], hi[3]};
}
__device__ __forceinline__ bf16x8 pack8(const f32x4& a, const f32x4& b) {
    const unsigned w0 = pg8::cvt_pk_bf16(a[0], a[1]), w1 = pg8::cvt_pk_bf16(a[2], a[3]), w2 = pg8::cvt_pk_bf16(b[0], b[1]), w3 = pg8::cvt_pk_bf16(b[2], b[3]);
    return __builtin_bit_cast(bf16x8, (v4u){w0, w1, w2, w3});
}
__device__ __forceinline__ float scan_add(float v, int lane) {
#pragma unroll
    for (int o = 1; o < 64; o <<= 1) { const float t = __shfl_up(v, o); if (lane >= o) v += t; }
    return v;
}
__device__ __forceinline__ float scan_max(float v, int lane) {
#pragma unroll
    for (int o = 1; o < 64; o <<= 1) { const float t = __shfl_up(v, o); if (lane >= o) v = fmaxf(v, t); }
    return v;
}
__device__ __forceinline__ float rcpf_(float x) { return __builtin_amdgcn_rcpf(x); }
__device__ __forceinline__ float sigm_fast(float x) { return rcpf_(1.0f + __expf(-x)); }
__device__ __forceinline__ int phys_t(int row) { return (row & ~12) | ((row & 4) << 1) | ((row & 8) >> 1); }

constexpr int SC_CHUNKS = 8, N_SC = SEQ / 64 / SC_CHUNKS;
constexpr int ML_SLOT = 65536 + 256 + 64, RT_SLOT = 32768 + 64;

template <bool ML, bool LOCAL>
__device__ __forceinline__ void chunk_mixer(const Ctx& F, int b, int h, int sc, const bf16* Qg, const bf16* Kg, const bf16* Vg, int qk_pitch, int v_pitch,
                                            const f32x2v* rope, const float* IFG, const bf16* Gg, const float* m_norm_h, bf16* OUT, float* slots) {
    constexpr int DK = ML ? 256 : 128, RB = 2 * DK, SR = RB + 32, ST = RB + 32, SV = 512 + 32, SP = 160, NKS = DK / 32, NT = DK / 16, SLOT = ML ? ML_SLOT : RT_SLOT;
    constexpr unsigned oQ = 0, oK = 64 * SR, oKW = oK + 64 * SR, oV = oKW + 64 * ST, oP = oV + 64 * SV, oDEN = oP + 64 * SP, oNV = oDEN + 256;
    static_assert(oNV + 1024 <= 163584, "mixer LDS map");
    LAS unsigned char* const L = F.lds;
    LAS float* const OT = (LAS float*)L;
    LAS float* const DEN = (LAS float*)(L + oDEN);
    LAS float* const NV = (LAS float*)(L + oNV);
    int lane = F.lane, tid_i = F.tid; asm volatile("" : "+v"(lane), "+v"(tid_i));
    const int w = F.wave;
    const float lg = log1pf(-exp2f(-5.0f - (float)h));
    f32x4 C[NT][2];
#pragma unroll
    for (int t = 0; t < NT; ++t) { C[t][0] = (f32x4){0.f, 0.f, 0.f, 0.f}; C[t][1] = C[t][0]; }
    float m_s = LOCAL ? -INFINITY : 0.f, btot = 0.f;
    __syncthreads();
    if (ML) { if (tid_i < 256) NV[tid_i] = 0.f; }
    if (!LOCAL) { if (sc > 0) {
        const float* S = slots + (size_t)(sc - 1) * SLOT; const float* Sl = S + ((size_t)w * NT * 2 * 64 + lane) * 4;
#pragma unroll
        for (int t = 0; t < NT; ++t)
#pragma unroll
            for (int nt = 0; nt < 2; ++nt) C[t][nt] = *(const f32x4*)(Sl + (t * 2 + nt) * 256);
        if (ML) { if (tid_i < 256) NV[tid_i] = S[65536 + tid_i]; m_s = S[65536 + 258]; } } }
#pragma unroll 1
    for (int cc = 0; cc < SC_CHUNKS; ++cc) {
        const int c = sc * SC_CHUNKS + cc;
        const size_t row0 = (size_t)b * SEQ + (size_t)c * 64;
        int lane_o = lane, g, fr, q4, p4, tid_o = tid_i;
#define RELANE() do { asm volatile("" : "+v"(lane_o)); g = lane_o >> 4; fr = lane_o & 15; q4 = fr >> 2; p4 = lane_o & 3; } while (0)
#define RETID() asm volatile("" : "+v"(tid_o))
        RELANE(); RETID();
        float bcum = 0.f, mi = 0.f, winter = 0.f, wk, decay, rowterm = 0.f, agate = 0.f, m_new = 0.f;
        if (ML) {
            const float ic = IFG[(row0 + lane) * 8 + h], lf = IFG[(row0 + lane) * 8 + 4 + h];
            bcum = scan_add(lf, lane); agate = ic - bcum; const float cm = scan_max(agate, lane);
            mi = bcum + fmaxf(m_s, cm); winter = __expf(bcum + m_s - mi);
            const float b_last = __shfl(bcum, 63); m_new = __shfl(mi, 63); btot += b_last;
            wk = __expf(b_last - bcum + ic - m_new); decay = __expf(b_last + m_s - m_new); rowterm = bcum - mi;
        } else { wk = __expf(lg * (float)(63 - lane)); decay = __expf(lg * 64.0f); }
        if (ML) {
#pragma unroll
            for (int i = 0; i < 4; ++i) { const int id = tid_o + 512 * i, row = id >> 5, ch = id & 31; const size_t go = (row0 + row) * (size_t)qk_pitch + 8 * ch;
                if (!LOCAL) *(LAS v4u*)(L + oQ + SR * row + 16 * ch) = *(const v4u*)(Qg + go);
                const v4u kv = *(const v4u*)(Kg + go); const float wr = __shfl(wk, row);
                v4u k2;
                k2.x = pg8::cvt_pk_bf16(bflo(kv.x) * wr, bfhi(kv.x) * wr); k2.y = pg8::cvt_pk_bf16(bflo(kv.y) * wr, bfhi(kv.y) * wr);
                k2.z = pg8::cvt_pk_bf16(bflo(kv.z) * wr, bfhi(kv.z) * wr); k2.w = pg8::cvt_pk_bf16(bflo(kv.w) * wr, bfhi(kv.w) * wr);
                if (!LOCAL) *(LAS v4u*)(L + oK + SR * row + 16 * ch) = kv;
                *(LAS v4u*)(L + oKW + ST * phys_t(row) + 16 * ch) = k2; }
        } else {
            const int row = tid_o >> 3, c8 = tid_o & 7; const size_t go = (row0 + row) * (size_t)qk_pitch + 8 * c8;
            const v4u ka = *(const v4u*)(Kg + go), kb = *(const v4u*)(Kg + go + 64);
            v4u qa = {0u, 0u, 0u, 0u}, qb = qa; if (!LOCAL) { qa = *(const v4u*)(Qg + go); qb = *(const v4u*)(Qg + go + 64); }
            const f32x4* rp = (const f32x4*)(rope + (row0 + row) * 64 + 8 * c8);
            const f32x4 r0 = rp[0], r1 = rp[1], r2 = rp[2], r3 = rp[3];
            const float cs[8] = {r0.x, r0.z, r1.x, r1.z, r2.x, r2.z, r3.x, r3.z}, sn[8] = {r0.y, r0.w, r1.y, r1.w, r2.y, r2.w, r3.y, r3.w};
            const unsigned qaw[4] = {qa.x, qa.y, qa.z, qa.w}, qbw[4] = {qb.x, qb.y, qb.z, qb.w}, kaw[4] = {ka.x, ka.y, ka.z, ka.w}, kbw[4] = {kb.x, kb.y, kb.z, kb.w};
            const float ksc = 0.08838834764831845f, wr = __shfl(wk, row);
            unsigned q1[4], q2[4], k1[4], k2[4], kw1[4], kw2[4];
#pragma unroll
            for (int e = 0; e < 4; ++e) {
                if (!LOCAL) { const float x1a = bflo(qaw[e]), x1b = bfhi(qaw[e]), x2a = bflo(qbw[e]), x2b = bfhi(qbw[e]);
                    q1[e] = pg8::cvt_pk_bf16(x1a * cs[2 * e] - x2a * sn[2 * e], x1b * cs[2 * e + 1] - x2b * sn[2 * e + 1]);
                    q2[e] = pg8::cvt_pk_bf16(x1a * sn[2 * e] + x2a * cs[2 * e], x1b * sn[2 * e + 1] + x2b * cs[2 * e + 1]); }
                const float y1a = bflo(kaw[e]), y1b = bfhi(kaw[e]), y2a = bflo(kbw[e]), y2b = bfhi(kbw[e]);
                const float o1a = (y1a * cs[2 * e] - y2a * sn[2 * e]) * ksc, o1b = (y1b * cs[2 * e + 1] - y2b * sn[2 * e + 1]) * ksc;
                const float o2a = (y1a * sn[2 * e] + y2a * cs[2 * e]) * ksc, o2b = (y1b * sn[2 * e + 1] + y2b * cs[2 * e + 1]) * ksc;
                k1[e] = pg8::cvt_pk_bf16(o1a, o1b); k2[e] = pg8::cvt_pk_bf16(o2a, o2b); kw1[e] = pg8::cvt_pk_bf16(o1a * wr, o1b * wr); kw2[e] = pg8::cvt_pk_bf16(o2a * wr, o2b * wr); }
            if (!LOCAL) {
                *(LAS v4u*)(L + oQ + SR * row + 16 * c8) = (v4u){q1[0], q1[1], q1[2], q1[3]}; *(LAS v4u*)(L + oQ + SR * row + 16 * (c8 + 8)) = (v4u){q2[0], q2[1], q2[2], q2[3]};
                *(LAS v4u*)(L + oK + SR * row + 16 * c8) = (v4u){k1[0], k1[1], k1[2], k1[3]}; *(LAS v4u*)(L + oK + SR * row + 16 * (c8 + 8)) = (v4u){k2[0], k2[1], k2[2], k2[3]}; }
            *(LAS v4u*)(L + oKW + ST * phys_t(row) + 16 * c8) = (v4u){kw1[0], kw1[1], kw1[2], kw1[3]}; *(LAS v4u*)(L + oKW + ST * phys_t(row) + 16 * (c8 + 8)) = (v4u){kw2[0], kw2[1], kw2[2], kw2[3]};
        }
        RETID();
#pragma unroll
        for (int i = 0; i < 4; ++i) { const int id = tid_o + 512 * i, row = id >> 5, ch = id & 31;
            *(LAS v4u*)(L + oV + SV * phys_t(row) + 16 * ch) = *(const v4u*)(Vg + (row0 + row) * (size_t)v_pitch + 8 * ch); }
        __syncthreads();
        RELANE();
        if (!LOCAL) {
        { const int mt = w >> 1;
          f32x4 S[2] = {(f32x4){0.f, 0.f, 0.f, 0.f}, (f32x4){0.f, 0.f, 0.f, 0.f}};
          const int nt0 = 2 * (w & 1);
          if (nt0 <= mt) {
              LAS unsigned char* const qa = L + oQ + SR * (16 * mt + fr) + 16 * g; LAS unsigned char* const ka = L + oK + SR * (16 * nt0 + fr) + 16 * g;
#pragma unroll
              for (int kk = 0; kk < NKS; ++kk) { const bf16x8 a = *(const LAS bf16x8*)(qa + 64 * kk);
#pragma unroll
                  for (int tt = 0; tt < 2; ++tt) { const bf16x8 bb = *(const LAS bf16x8*)(ka + 16 * SR * tt + 64 * kk);
                      S[tt] = __builtin_amdgcn_mfma_f32_16x16x32_bf16(a, bb, S[tt], 0, 0, 0); } } }
#pragma unroll
          for (int tt = 0; tt < 2; ++tt) { const int j = 16 * (nt0 + tt) + fr; const float aj = ML ? __shfl(agate, j) : 0.f;
#pragma unroll
              for (int r = 0; r < 4; ++r) { const int i = 16 * mt + 4 * g + r; float wgt;
                  if (ML) { const float ri = __shfl(rowterm, i); wgt = (j <= i) ? __expf(ri + aj) : 0.f; } else wgt = (j <= i) ? __expf(lg * (float)(i - j)) : 0.f;
                  *(LAS unsigned short*)(L + oP + SP * i + 2 * j) = (unsigned short)f2bf(S[tt][r] * wgt); } } }
        __syncthreads();
        }
        float nnew = 0.f;
        RETID();
        if (ML) {
            if (!LOCAL) { const int i = tid_o >> 3, part = tid_o & 7;
              const v4u pv = *(const LAS v4u*)(L + oP + SP * i + 16 * part);
              float ps = (bflo(pv.x) + bfhi(pv.x)) + (bflo(pv.y) + bfhi(pv.y)) + (bflo(pv.z) + bfhi(pv.z)) + (bflo(pv.w) + bfhi(pv.w));
              float qn = 0.f;
#pragma unroll
              for (int e4 = 0; e4 < 4; ++e4) { const v4u qv = *(const LAS v4u*)(L + oQ + SR * i + 64 * part + 16 * e4);
                  const f32x4 n0 = *(const LAS f32x4*)(NV + 32 * part + 8 * e4), n1 = *(const LAS f32x4*)(NV + 32 * part + 8 * e4 + 4);
                  qn += bflo(qv.x) * n0.x + bfhi(qv.x) * n0.y + bflo(qv.y) * n0.z + bfhi(qv.y) * n0.w + bflo(qv.z) * n1.x + bfhi(qv.z) * n1.y + bflo(qv.w) * n1.z + bfhi(qv.w) * n1.w; }
              float tot = ps + __shfl(winter, i) * qn;
              tot += __shfl_xor(tot, 1); tot += __shfl_xor(tot, 2); tot += __shfl_xor(tot, 4);
              const float em = __expf(-__shfl(mi, i));
              if (part == 0) DEN[i] = rcpf_(fmaxf(fabsf(tot), em)); }
            { const int dk = tid_o >> 1, hf = tid_o & 1; float s = 0.f;
              const LAS unsigned char* kp = L + oKW + ST * (32 * hf) + 2 * dk;
#pragma unroll 8
              for (int jj = 0; jj < 32; ++jj) s += bf2f(*(const LAS unsigned short*)(kp + ST * jj));
              s += __shfl_xor(s, 1); nnew = decay * NV[dk] + s; }
        }
        RELANE();
        f32x4 O[4][2];
        if (!LOCAL) {
#pragma unroll
        for (int mt = 0; mt < 4; ++mt) { O[mt][0] = (f32x4){0.f, 0.f, 0.f, 0.f}; O[mt][1] = O[mt][0]; }
        { LAS unsigned char* const qb = L + oQ + SR * fr + 8 * g;
#pragma unroll
          for (int kk = 0; kk < NKS; ++kk) { const bf16x8 b0 = pack8(C[2 * kk][0], C[2 * kk + 1][0]), b1 = pack8(C[2 * kk][1], C[2 * kk + 1][1]);
#pragma unroll
              for (int mt = 0; mt < 4; ++mt) {
                  const v2u lo = *(const LAS v2u*)(qb + 16 * SR * mt + 64 * kk), hi = *(const LAS v2u*)(qb + 16 * SR * mt + 64 * kk + 32);
                  const bf16x8 a = __builtin_bit_cast(bf16x8, (v4u){lo.x, lo.y, hi.x, hi.y});
                  O[mt][0] = __builtin_amdgcn_mfma_f32_16x16x32_bf16(a, b0, O[mt][0], 0, 0, 0); O[mt][1] = __builtin_amdgcn_mfma_f32_16x16x32_bf16(a, b1, O[mt][1], 0, 0, 0); }
              __builtin_amdgcn_sched_barrier(0); } }
#pragma unroll
        for (int mt = 0; mt < 4; ++mt)
#pragma unroll
            for (int r = 0; r < 4; ++r) { const int i = 16 * mt + 4 * g + r; const float sc_ = ML ? __shfl(winter, i) : __expf(lg * (float)(i + 1)); O[mt][0][r] *= sc_; O[mt][1][r] *= sc_; }
        }
        bf16x8 vf[2][2];
        { LAS unsigned char* const vb = L + oV + SV * (16 * (g >> 1) + 4 * (g & 1) + q4) + 8 * p4 + 64 * w;
#pragma unroll
          for (int kk2 = 0; kk2 < 2; ++kk2)
#pragma unroll
              for (int nt = 0; nt < 2; ++nt) vf[kk2][nt] = tr_frag(vb + 32 * SV * kk2 + 32 * nt, vb + 32 * SV * kk2 + 8 * SV + 32 * nt); }
        if (!LOCAL) {
        LAS unsigned char* const pb = L + oP + SP * fr + 16 * g;
#pragma unroll
        for (int mt = 0; mt < 4; ++mt) {
#pragma unroll
            for (int kk2 = 0; kk2 < 2; ++kk2) { const bf16x8 a = *(const LAS bf16x8*)(pb + 16 * SP * mt + 64 * kk2);
                O[mt][0] = __builtin_amdgcn_mfma_f32_16x16x32_bf16(a, vf[kk2][0], O[mt][0], 0, 0, 0); O[mt][1] = __builtin_amdgcn_mfma_f32_16x16x32_bf16(a, vf[kk2][1], O[mt][1], 0, 0, 0); }
            __builtin_amdgcn_sched_barrier(0); }
        }
        { LAS unsigned char* const kb = L + oKW + ST * (16 * (g >> 1) + 4 * (g & 1) + q4) + 8 * p4;
#pragma unroll
          for (int t = 0; t < NT; ++t) { C[t][0] *= decay; C[t][1] *= decay;
#pragma unroll
              for (int kk2 = 0; kk2 < 2; ++kk2) { const bf16x8 a = tr_frag(kb + 32 * ST * kk2 + 32 * t, kb + 32 * ST * kk2 + 8 * ST + 32 * t);
                  C[t][0] = __builtin_amdgcn_mfma_f32_16x16x32_bf16(a, vf[kk2][0], C[t][0], 0, 0, 0); C[t][1] = __builtin_amdgcn_mfma_f32_16x16x32_bf16(a, vf[kk2][1], C[t][1], 0, 0, 0); }
              __builtin_amdgcn_sched_barrier(0); } }
        __syncthreads();
        RETID();
        if (ML) { if ((tid_o & 1) == 0) NV[tid_o >> 1] = nnew; }
        if (!LOCAL) {
        RELANE();
        { LAS float* const ob = OT + (4 * g) * 256 + 32 * w + fr;
#pragma unroll
          for (int mt = 0; mt < 4; ++mt)
#pragma unroll
              for (int r = 0; r < 4; ++r) { const float inv = ML ? DEN[16 * mt + 4 * g + r] : 1.0f;
                  ob[(16 * mt + r) * 256] = O[mt][0][r] * inv; ob[(16 * mt + r) * 256 + 16] = O[mt][1][r] * inv; } }
        __syncthreads();
        RETID();
        { const int row = tid_o >> 3, part = tid_o & 7, c0 = 32 * part; const size_t grow = row0 + row;
          float v[32]; float ss = 0.f;
#pragma unroll
          for (int e = 0; e < 8; ++e) { const f32x4 t4 = *(const LAS f32x4*)(OT + row * 256 + c0 + 4 * e); v[4 * e] = t4.x; v[4 * e + 1] = t4.y; v[4 * e + 2] = t4.z; v[4 * e + 3] = t4.w; }
          float gt[32];
#pragma unroll
          for (int e = 0; e < 4; ++e) { const v4u gw = *(const v4u*)(Gg + grow * DIN + c0 + 8 * e);
              gt[8 * e] = bflo(gw.x); gt[8 * e + 1] = bfhi(gw.x); gt[8 * e + 2] = bflo(gw.y); gt[8 * e + 3] = bfhi(gw.y); gt[8 * e + 4] = bflo(gw.z); gt[8 * e + 5] = bfhi(gw.z); gt[8 * e + 6] = bflo(gw.w); gt[8 * e + 7] = bfhi(gw.w); }
#pragma unroll
          for (int e = 0; e < 32; ++e) { if (ML) v[e] *= sigm_fast(gt[e]); ss += v[e] * v[e]; }
          ss += __shfl_xor(ss, 1); ss += __shfl_xor(ss, 2); ss += __shfl_xor(ss, 4);
          const float rs = rsqrtf(ss * (1.0f / 256.0f) + EPSF);
#pragma unroll
          for (int e = 0; e < 4; ++e) { float o[8];
#pragma unroll
              for (int k = 0; k < 8; ++k) { const int ee = 8 * e + k; o[k] = ML ? v[ee] * rs * m_norm_h[c0 + ee] : v[ee] * rs * (gt[ee] * sigm_fast(gt[ee])); }
              *(v4u*)(OUT + grow * DM + c0 + 8 * e) = (v4u){pg8::cvt_pk_bf16(o[0], o[1]), pg8::cvt_pk_bf16(o[2], o[3]), pg8::cvt_pk_bf16(o[4], o[5]), pg8::cvt_pk_bf16(o[6], o[7])}; } }
        __syncthreads();
        }
        if (ML) m_s = m_new;
    }
#undef RELANE
#undef RETID
    if (LOCAL) {
        float* S = slots + (size_t)sc * SLOT;
        float* Sl = S + ((size_t)w * NT * 2 * 64 + lane) * 4;
#pragma unroll
        for (int t = 0; t < NT; ++t)
#pragma unroll
            for (int nt = 0; nt < 2; ++nt) *(f32x4*)(Sl + (t * 2 + nt) * 256) = C[t][nt];
        if (ML) { __syncthreads(); if (tid_i < 256) S[65536 + tid_i] = NV[tid_i]; if (tid_i == 0) { S[65536 + 256] = m_s; S[65536 + 257] = btot; } }
    }
}

__device__ __forceinline__ void combine_states(const Ctx& F, float* mlst, float* rtst) {
    for (int it = F.vcu; it < 256; it += F.G) {
        const int type = it >> 7, bh = (it >> 2) & 31, part = it & 3;
        if (type == 0) {
            float* S0 = mlst + (size_t)bh * 3 * ML_SLOT; float* S1 = S0 + ML_SLOT; float* S2 = S1 + ML_SLOT;
            const float ml0 = S0[65792], b0 = S0[65793], ml1 = S1[65792], b1 = S1[65793], ml2 = S2[65792], b2 = S2[65793];
            (void)b0;
            const float m1 = fmaxf(b0 + 0.f, ml0), a1 = __expf(ml0 - m1);
            const float m2 = fmaxf(b1 + m1, ml1), f1 = __expf(b1 + m1 - m2), g1 = __expf(ml1 - m2);
            const float m3 = fmaxf(b2 + m2, ml2), f2 = __expf(b2 + m2 - m3), g2 = __expf(ml2 - m3);
            constexpr int NV4 = (65536 + 256) / 4 / 4;
            for (int i = F.tid; i < NV4; i += 512) { const size_t o = ((size_t)part * NV4 + i) * 4;
                const f32x4 s0 = *(const f32x4*)(S0 + o), s1 = *(const f32x4*)(S1 + o), s2 = *(const f32x4*)(S2 + o);
                const f32x4 t1 = s0 * a1, t2 = t1 * f1 + s1 * g1, t3 = t2 * f2 + s2 * g2;
                *(f32x4*)(S0 + o) = t1; *(f32x4*)(S1 + o) = t2; *(f32x4*)(S2 + o) = t3; }
            if (part == 0 && F.tid == 0) { S0[65794] = m1; S1[65794] = m2; S2[65794] = m3; }
        } else {
            float* S0 = rtst + (size_t)bh * 3 * RT_SLOT; float* S1 = S0 + RT_SLOT; float* S2 = S1 + RT_SLOT;
            const float G = __expf(log1pf(-exp2f(-5.0f - (float)(bh & 3))) * 512.0f);
            constexpr int NV4 = 32768 / 4 / 4;
            for (int i = F.tid; i < NV4; i += 512) { const size_t o = ((size_t)part * NV4 + i) * 4;
                const f32x4 s0 = *(const f32x4*)(S0 + o), s1 = *(const f32x4*)(S1 + o), s2 = *(const f32x4*)(S2 + o);
                const f32x4 t2 = s0 * G + s1, t3 = t2 * G + s2;
                *(f32x4*)(S1 + o) = t2; *(f32x4*)(S2 + o) = t3; }
        }
    }
}
__device__ __forceinline__ unsigned offP(unsigned row, unsigned ch) { return 128u * row + 16u * (ch ^ ((row >> 1) & 7u)); }
__device__ __forceinline__ void lru_chunked(const Ctx& F, int b, int cb, int c_begin, int c_end, float* carry_g, const bf16* proj, const float* conv_w, const float* conv_b, const float* w_r, const float* b_r,
                                            const float* w_i, const float* b_i, const float* lam, bf16* LRU) {
    constexpr unsigned oRAW = 0, RAWB = 8704, oLY = 2 * RAWB, oXL = oLY + 16384, oXH = oXL + 16384, oXO = oXH + 8192, oAS = oXO + 8192, oUS = oAS + 16384, oSEG = oUS + 16384, oCAR = oSEG + 4096;
    LAS unsigned char* const L = F.lds;
    LAS float* const XL = (LAS float*)(L + oXL); LAS float* const AS = (LAS float*)(L + oAS); LAS float* const US = (LAS float*)(L + oUS);
    LAS float* const SEG = (LAS float*)(L + oSEG); LAS float* const CAR = (LAS float*)(L + oCAR);
    const int tid = F.tid, lane = F.lane, w = F.wave, g = lane >> 4, fr = lane & 15;
    const int ch0 = cb * 64;
    const int ctok = tid >> 3, cg = tid & 7;
    LAS float* const CWL = (LAS float*)(L + oCAR + 512);
    __syncthreads();
    if (tid < 320) CWL[tid] = (tid < 256) ? conv_w[(tid >> 6) * DM + ch0 + (tid & 63)] : conv_b[ch0 + (tid & 63)];
    const int mt = w >> 1, nt0 = 2 * (w & 1);
    float brr[2], bii[2], spp[2];
    bf16x8 Bh[2][2][2], Bl[2][2][2];
#pragma unroll
    for (int tt = 0; tt < 2; ++tt) { const int e = 16 * (nt0 + tt) + fr; brr[tt] = b_r[ch0 + e]; bii[tt] = b_i[ch0 + e];
        const float lm = lam[ch0 + e]; spp[tt] = (-lm > 20.f) ? -lm : log1pf(expf(-lm));
#pragma unroll
        for (int gt = 0; gt < 2; ++gt) { const float* W = (gt ? w_i : w_r) + (size_t)cb * 4096 + e;
#pragma unroll
            for (int kk = 0; kk < 2; ++kk) { float hi[8], lo[8];
#pragma unroll
                for (int j = 0; j < 8; ++j) { const float wv = W[(32 * kk + 8 * g + j) * 64]; hi[j] = __builtin_bit_cast(float, f2bf(wv) << 16); lo[j] = wv - hi[j]; }
                Bh[gt][tt][kk] = __builtin_bit_cast(bf16x8, (v4u){pk2(hi[0], hi[1]), pk2(hi[2], hi[3]), pk2(hi[4], hi[5]), pk2(hi[6], hi[7])});
                Bl[gt][tt][kk] = __builtin_bit_cast(bf16x8, (v4u){pk2(lo[0], lo[1]), pk2(lo[2], lo[3]), pk2(lo[4], lo[5]), pk2(lo[6], lo[7])}); } } }
    __syncthreads();
    if (tid < 64) CAR[(c_begin & 1) * 64 + tid] = (c_begin > 0) ? carry_g[tid] : 0.f;
    v4u pr0, pr1 = {0u, 0u, 0u, 0u}, pl;
#define LRU_FETCH(cc) do { const int t0_ = (cc) * 64; const size_t rowb_ = (size_t)b * SEQ; \
        { const int row_ = tid >> 3, c16_ = tid & 7, t_ = t0_ - 3 + row_; pr0 = (t_ >= 0) ? *(const v4u*)(proj + (rowb_ + t_) * DIN + OFF_LX + ch0 + 8 * c16_) : (v4u){0u, 0u, 0u, 0u}; } \
        if (tid < 24) { const int row_ = 64 + (tid >> 3), c16_ = tid & 7, t_ = t0_ - 3 + row_; pr1 = *(const v4u*)(proj + (rowb_ + t_) * DIN + OFF_LX + ch0 + 8 * c16_); } \
        { const int row_ = tid >> 3, c16_ = tid & 7; pl = *(const v4u*)(proj + (rowb_ + t0_ + row_) * DIN + OFF_LY + ch0 + 8 * c16_); } } while (0)
    LRU_FETCH(c_begin);
#pragma unroll 1
    for (int c = c_begin; c < c_end; ++c) {
        const int par = c & 1; const size_t row0 = (size_t)b * SEQ + (size_t)c * 64;
        LAS unsigned char* const RAW = L + oRAW + par * RAWB; LAS unsigned char* const LY = L + oLY + par * 8192;
        *(LAS v4u*)(RAW + tid * 16) = pr0; if (tid < 24) *(LAS v4u*)(RAW + 8192 + tid * 16) = pr1; *(LAS v4u*)(LY + tid * 16) = pl;
        if (c + 1 < c_end) LRU_FETCH(c + 1);
        __syncthreads();
        { float x[8];
          { const f32x4 a = *(const LAS f32x4*)(CWL + 256 + 8 * cg), c4 = *(const LAS f32x4*)(CWL + 256 + 8 * cg + 4); x[0] = a.x; x[1] = a.y; x[2] = a.z; x[3] = a.w; x[4] = c4.x; x[5] = c4.y; x[6] = c4.z; x[7] = c4.w; }
#pragma unroll
          for (int k = 0; k < 4; ++k) { const v4u rv = *(const LAS v4u*)(RAW + (ctok + k) * 128 + cg * 16);
              const f32x4 wa = *(const LAS f32x4*)(CWL + 64 * k + 8 * cg), wb = *(const LAS f32x4*)(CWL + 64 * k + 8 * cg + 4);
              x[0] += wa.x * bflo(rv.x); x[1] += wa.y * bfhi(rv.x); x[2] += wa.z * bflo(rv.y); x[3] += wa.w * bfhi(rv.y);
              x[4] += wb.x * bflo(rv.z); x[5] += wb.y * bfhi(rv.z); x[6] += wb.z * bflo(rv.w); x[7] += wb.w * bfhi(rv.w); }
          *(LAS f32x4*)(XL + ctok * 64 + 8 * cg) = (f32x4){x[0], x[1], x[2], x[3]}; *(LAS f32x4*)(XL + ctok * 64 + 8 * cg + 4) = (f32x4){x[4], x[5], x[6], x[7]};
          float hi[8], lo[8];
#pragma unroll
          for (int e = 0; e < 8; ++e) { hi[e] = __builtin_bit_cast(float, f2bf(x[e]) << 16); lo[e] = x[e] - hi[e]; }
          *(LAS v4u*)(L + oXH + offP(ctok, cg)) = (v4u){pk2(hi[0], hi[1]), pk2(hi[2], hi[3]), pk2(hi[4], hi[5]), pk2(hi[6], hi[7])};
          *(LAS v4u*)(L + oXO + offP(ctok, cg)) = (v4u){pk2(lo[0], lo[1]), pk2(lo[2], lo[3]), pk2(lo[4], lo[5]), pk2(lo[6], lo[7])}; }
        __syncthreads();
        { f32x4 acc[2][2];
#pragma unroll
          for (int gt = 0; gt < 2; ++gt) { acc[gt][0] = (f32x4){0.f, 0.f, 0.f, 0.f}; acc[gt][1] = acc[gt][0]; }
#pragma unroll
          for (int kk = 0; kk < 2; ++kk) { const bf16x8 ah = *(const LAS bf16x8*)(L + oXH + offP(16 * mt + fr, 4 * kk + g)), al = *(const LAS bf16x8*)(L + oXO + offP(16 * mt + fr, 4 * kk + g));
#pragma unroll
              for (int gt = 0; gt < 2; ++gt)
#pragma unroll
                  for (int tt = 0; tt < 2; ++tt) { acc[gt][tt] = __builtin_amdgcn_mfma_f32_16x16x32_bf16(ah, Bh[gt][tt][kk], acc[gt][tt], 0, 0, 0);
                      acc[gt][tt] = __builtin_amdgcn_mfma_f32_16x16x32_bf16(al, Bh[gt][tt][kk], acc[gt][tt], 0, 0, 0); acc[gt][tt] = __builtin_amdgcn_mfma_f32_16x16x32_bf16(ah, Bl[gt][tt][kk], acc[gt][tt], 0, 0, 0); } }
#pragma unroll
          for (int tt = 0; tt < 2; ++tt)
#pragma unroll
              for (int r = 0; r < 4; ++r) { const int i = 16 * mt + 4 * g + r, e = 16 * (nt0 + tt) + fr;
                  const float rg = sigmoidf_(acc[0][tt][r] + brr[tt]), ig = sigmoidf_(acc[1][tt][r] + bii[tt]), log_a = -8.0f * rg * spp[tt];
                  AS[i * 64 + e] = expf(log_a); US[i * 64 + e] = sqrtf(-expm1f(2.0f * log_a)) * (ig * XL[i * 64 + e]); } }
        __syncthreads();
        { const int ch = tid & 63, seg = tid >> 6;
          float hl[8], pc[8]; float h = 0.f, p = 1.f;
#pragma unroll
          for (int k = 0; k < 8; ++k) { const float a = AS[(8 * seg + k) * 64 + ch], u = US[(8 * seg + k) * 64 + ch]; h = a * h + u; p *= a; hl[k] = h; pc[k] = p; }
          SEG[(seg * 64 + ch) * 2] = p; SEG[(seg * 64 + ch) * 2 + 1] = h;
          __syncthreads();
          float hin = CAR[par * 64 + ch];
          for (int s = 0; s < seg; ++s) hin = SEG[(s * 64 + ch) * 2] * hin + SEG[(s * 64 + ch) * 2 + 1];
#pragma unroll
          for (int k = 0; k < 8; ++k) { const float hv = hl[k] + pc[k] * hin; if (k == 7 && seg == 7) CAR[(par ^ 1) * 64 + ch] = hv;
              const float ly = bf2f(*(const LAS unsigned short*)(LY + (8 * seg + k) * 128 + ch * 2));
              LRU[(row0 + 8 * seg + k) * DM + ch0 + ch] = (bf16)f2bf(hv * gelu_tanh_f(ly)); } }
    }
    __syncthreads();
    if (c_end < SEQ / 64 && tid < 64) carry_g[tid] = CAR[(c_end & 1) * 64 + tid];
#undef LRU_FETCH
}
enum { I_X = 0, I_C, I_POS, I_WADA, I_BADA, I_NMIX, I_NMLP, I_WIN, I_LCW, I_LCB, I_LWR, I_LBR, I_LWI, I_LBI, I_LLAM, I_MCW, I_MCB, I_MWQ, I_MWK, I_MWV, I_MWIF, I_MBIF, I_MNORM,
       I_WBR0, I_WBR1, I_WBR2, I_WOUT, I_WFF1, I_WFF2, I_FNORM, N_INPUTS };
constexpr int PH_PER_LAYER = 11, N_PHASES = 2 + NL * PH_PER_LAYER;
constexpr int LRU_SPLIT = 8;
struct Args { const float* in[N_INPUTS]; float* out; unsigned char* ws; int ph_lo, ph_hi; };
static_assert(sizeof(Args) == N_INPUTS * 8 + 8 + 8 + 8, "Args has no padding bytes");

__device__ __forceinline__ const float* inp(const Args& a, int i) { asm volatile("" : "+s"(i)); return a.in[i]; }
__device__ __forceinline__ unsigned char* wsbase(const Args& a) { int z = 0; asm volatile("" : "+s"(z)); return (&a.ws)[z]; }
__device__ __forceinline__ int phlo(const Args& a) { int z = 0; asm volatile("" : "+s"(z)); return (&a.ph_lo)[z]; }
__device__ __forceinline__ int phhi(const Args& a) { int z = 0; asm volatile("" : "+s"(z)); return (&a.ph_hi)[z]; }
__device__ __forceinline__ bool in_range(const Args& a, int k) { return phlo(a) <= k && k < phhi(a); }
__device__ __forceinline__ bool seam_here(const Args& a, int k) { return phlo(a) <= k && k + 1 < phhi(a); }
__device__ __forceinline__ float* outp(const Args& a) { int z = 0; asm volatile("" : "+s"(z)); return (&a.out)[z]; }
__device__ __forceinline__ Ctx make_ctx(LAS unsigned char* lds) {
    Ctx F; int g = (int)gridDim.x, bx = (int)blockIdx.x, t = (int)threadIdx.x;
    asm volatile("" : "+s"(g), "+s"(bx), "+v"(t));
    F.lds = lds; F.tid = t; F.lane = t & 63; F.wave = __builtin_amdgcn_readfirstlane(t >> 6); F.G = g; F.bx = bx; F.vcu = (g % 8 == 0) ? (bx % 8) * (g / 8) + bx / 8 : bx;
    return F;
}
__global__ void __launch_bounds__(NWAVES * 64, 2) fwd(Args args) {
    extern __shared__ __attribute__((aligned(16))) unsigned char lds_raw[];
    LAS unsigned char* const ldsb = (LAS unsigned char*)lds_raw;
    volatile LAS unsigned* MISC = (volatile LAS unsigned*)(ldsb + MISC_OFF);
    for (int u = threadIdx.x; u < (LDS_BYTES - SCRATCH_BYTES) / 4; u += NWAVES * 64) ((LAS unsigned*)(ldsb + SCRATCH_BYTES))[u] = 0u;
    __syncthreads();
    { const int span = phhi(args) - phlo(args);
      if (span > 1) (void)xcd_barrier_post((unsigned*)(wsbase(args) + WS_CTL) + 4096, MISC + 8); }
#ifndef REP0
#define REP0 1
#endif
#ifndef REP1
#define REP1 1
#endif
#ifndef REP2
#define REP2 1
#endif
#ifndef REP3
#define REP3 1
#endif
#ifndef REP4
#define REP4 1
#endif
#ifndef REP5
#define REP5 1
#endif
#ifndef REP7
#define REP7 1
#endif
#ifndef REP8
#define REP8 1
#endif
#ifndef PMASK
#define PMASK 0xFFFF
#endif
#define IN(k) in_range(args, (k))
#define PH(j) ((PMASK >> (j)) & 1)
#define SEAM(k) do { if (seam_here(args, (k))) { XcdBarrier b_; b_.bar = (unsigned*)(wsbase(args) + WS_CTL) + 4096; b_.x = xb_xcc_id(); b_.st = MISC + 8; xcd_barrier(b_); } } while (0)

#define INP(i) inp(args, (i))
#define WSP(T, off) ((T*)(wsbase(args) + (off)))
    if (PH(11) && IN(0)) { const Ctx F = make_ctx(ldsb); p0_prologue(F, INP(I_X), INP(I_C), (const int*)INP(I_POS), INP(I_WADA), INP(I_BADA), WSP(float, WS_MODF), WSP(f32x2v, WS_ROPE), outp(args)); }
    SEAM(0);

    for (int l = 0; l < NL; ++l) {
        const int kb = 1 + l * PH_PER_LAYER;
#define MOD_L(j) (WSP(float, WS_MODF) + ((size_t)l * NB * 6 + (j)) * DM)
        if (PH(0) && IN(kb + 0)) for (int rep_ = 0; rep_ < REP0; ++rep_) { const Ctx F = make_ctx(ldsb);
            convert_weights(F, INP(I_WIN) + (size_t)l * DM * DIN, INP(I_WBR0) + (size_t)l * DM * DM, INP(I_WBR1) + (size_t)l * DM * DM, INP(I_WBR2) + (size_t)l * DM * DM,
                            INP(I_WOUT) + (size_t)l * DM * DM, INP(I_WFF1) + (size_t)l * DM * DFF, INP(I_WFF2) + (size_t)l * DFF * DM,
                            WSP(bf16, WS_WIN), WSP(bf16, WS_WBR), WSP(bf16, WS_WOUT), WSP(bf16, WS_WFF1), WSP(bf16, WS_WFF2));
            norm_phase(F, outp(args), INP(I_NMIX) + l * DM, MOD_L(1), MOD_L(0), WSP(bf16, WS_ACT));
        }
        SEAM(kb + 0);
        if (PH(1) && IN(kb + 1)) for (int rep_ = 0; rep_ < REP1; ++rep_) { const Ctx F = make_ctx(ldsb); pg8::Gemm g{WSP(bf16, WS_ACT), WSP(bf16, WS_WIN), M, DIN, DM}; pg8::StaticOrder S; S.init(M, DIN, F.G, F.bx); pg8::EpiStore<0> E{WSP(bf16, WS_PROJ), DIN};
            pg8::gemm_phase<pg8::EpiStore<0>, pg8::StaticOrder, true, true>(F.lds, g, S, E); }
        SEAM(kb + 1);
        if (PH(2) && IN(kb + 2)) for (int rep_ = 0; rep_ < REP2; ++rep_) { const Ctx F = make_ctx(ldsb); mlstm_pre(F, WSP(bf16, WS_PROJ), INP(I_MCW) + l * 4 * DM, INP(I_MCB) + l * DM, INP(I_MWQ) + l * DM * 4, INP(I_MWK) + l * DM * 4, INP(I_MWV) + l * DM * 4,
                                  INP(I_MWIF) + (size_t)l * 3 * DM * 8, INP(I_MBIF) + l * 8, WSP(bf16, WS_MQ), WSP(bf16, WS_MK), WSP(bf16, WS_MV), WSP(float, WS_IFG)); }
        SEAM(kb + 2);
        if (PH(3) && IN(kb + 3)) for (int rep_ = 0; rep_ < REP3; ++rep_) {
            { const Ctx F = make_ctx(ldsb); const int nlo = F.G > 128 ? 128 : 0, nhi = F.G - nlo;
              for (int j = F.vcu - nlo; j >= 0 && j < 96; j += nhi) { const int bh = j / 3, sc = j % 3, b = bh >> 2, h = bh & 3;
                chunk_mixer<true, true>(F, b, h, sc, nullptr, WSP(bf16, WS_MK) + h * 256, WSP(bf16, WS_MV) + h * 256, DM, DM, nullptr, WSP(float, WS_IFG), nullptr, nullptr, nullptr,
                                        WSP(float, WS_MLST) + (size_t)bh * 3 * ML_SLOT); } }
            { const Ctx F = make_ctx(ldsb); const int nlo = F.G > 128 ? 128 : 0, nhi = F.G - nlo;
              for (int j = 96 + (F.vcu - nlo + nhi - 96 % nhi) % nhi; F.vcu >= nlo && j < 192; j += nhi) { const int bh = (j - 96) / 3, sc = (j - 96) % 3, b = bh >> 2, h = bh & 3;
                chunk_mixer<false, true>(F, b, h, sc, nullptr, WSP(bf16, WS_PROJ) + OFF_RK + h * 128, WSP(bf16, WS_PROJ) + OFF_RV + h * 256, DIN, DIN, WSP(f32x2v, WS_ROPE), nullptr, nullptr, nullptr, nullptr,
                                         WSP(float, WS_RTST) + (size_t)bh * 3 * RT_SLOT); } }
            { const Ctx F = make_ctx(ldsb);
              for (int it = F.vcu; it < 128; it += F.G) lru_chunked(F, it >> 4, it & 15, 0, LRU_SPLIT, WSP(float, WS_LRUC) + it * 64, WSP(bf16, WS_PROJ), INP(I_LCW) + l * 4 * DM, INP(I_LCB) + l * DM, INP(I_LWR) + (size_t)l * DM * 64, INP(I_LBR) + l * DM,
                                INP(I_LWI) + (size_t)l * DM * 64, INP(I_LBI) + l * DM, INP(I_LLAM) + l * DM, WSP(bf16, WS_LRU)); }
        }
        SEAM(kb + 3);
        if (PH(4) && IN(kb + 4)) { const Ctx F = make_ctx(ldsb); combine_states(F, WSP(float, WS_MLST), WSP(float, WS_RTST)); }
        SEAM(kb + 4);
        if (PH(5) && IN(kb + 5)) for (int rep_ = 0; rep_ < REP4; ++rep_) {
            { const Ctx F = make_ctx(ldsb); const int nlo = F.G > 128 ? 128 : 0, nhi = F.G - nlo;
              for (int j = F.vcu - nlo; j >= 0 && j < 128; j += nhi) { const int bh = j >> 2, sc = j & 3, b = bh >> 2, h = bh & 3;
                chunk_mixer<true, false>(F, b, h, sc, WSP(bf16, WS_MQ) + h * 256, WSP(bf16, WS_MK) + h * 256, WSP(bf16, WS_MV) + h * 256, DM, DM, nullptr, WSP(float, WS_IFG),
                                         WSP(bf16, WS_PROJ) + OFF_MO + h * 256, INP(I_MNORM) + l * DM + h * 256, WSP(bf16, WS_MLS) + h * 256, WSP(float, WS_MLST) + (size_t)bh * 3 * ML_SLOT); } }
            { const Ctx F = make_ctx(ldsb); const int nlo = F.G > 128 ? 128 : 0, nhi = F.G - nlo;
              for (int j = 128 + (F.vcu - nlo + nhi - 128 % nhi) % nhi; F.vcu >= nlo && j < 256; j += nhi) { const int bh = (j - 128) >> 2, sc = j & 3, b = bh >> 2, h = bh & 3;
                chunk_mixer<false, false>(F, b, h, sc, WSP(bf16, WS_PROJ) + OFF_RQ + h * 128, WSP(bf16, WS_PROJ) + OFF_RK + h * 128, WSP(bf16, WS_PROJ) + OFF_RV + h * 256, DIN, DIN, WSP(f32x2v, WS_ROPE), nullptr,
                                          WSP(bf16, WS_PROJ) + OFF_RG + h * 256, nullptr, WSP(bf16, WS_RET) + h * 256, WSP(float, WS_RTST) + (size_t)bh * 3 * RT_SLOT); } }
            { const Ctx F = make_ctx(ldsb);
              for (int it = F.vcu; it < 128; it += F.G) lru_chunked(F, it >> 4, it & 15, LRU_SPLIT, SEQ / 64, WSP(float, WS_LRUC) + it * 64, WSP(bf16, WS_PROJ), INP(I_LCW) + l * 4 * DM, INP(I_LCB) + l * DM, INP(I_LWR) + (size_t)l * DM * 64, INP(I_LBR) + l * DM,
                                INP(I_LWI) + (size_t)l * DM * 64, INP(I_LBI) + l * DM, INP(I_LLAM) + l * DM, WSP(bf16, WS_LRU)); }
        }
        SEAM(kb + 5);
        if (PH(6) && IN(kb + 6)) for (int rep_ = 0; rep_ < REP5; ++rep_) {
            { const Ctx F = make_ctx(ldsb); pg8::StaticOrder S; S.init(M, DM, F.G, F.bx); pg8::Gemm g{WSP(bf16, WS_RET), WSP(bf16, WS_WBR), M, DM, DM};
              pg8::EpiGate<0> E{WSP(bf16, WS_PROJ) + OFF_GATE, DIN, WSP(bf16, WS_MQ), nullptr, nullptr, DM}; pg8::gemm_phase<pg8::EpiGate<0>, pg8::StaticOrder, true, true>(F.lds, g, S, E); }
            { const Ctx F = make_ctx(ldsb); pg8::StaticOrder S; S.init(M, DM, F.G, F.bx); pg8::Gemm g{WSP(bf16, WS_LRU), WSP(bf16, WS_WBR) + (size_t)DM * DM, M, DM, DM};
              pg8::EpiGate<0> E{WSP(bf16, WS_PROJ) + OFF_GATE + DM, DIN, WSP(bf16, WS_MK), nullptr, nullptr, DM}; pg8::gemm_phase<pg8::EpiGate<0>, pg8::StaticOrder, true, true>(F.lds, g, S, E); }
            { const Ctx F = make_ctx(ldsb); pg8::StaticOrder S; S.init(M, DM, F.G, F.bx); pg8::Gemm g{WSP(bf16, WS_MLS), WSP(bf16, WS_WBR) + (size_t)2 * DM * DM, M, DM, DM};
              pg8::EpiGate<1> E{WSP(bf16, WS_PROJ) + OFF_GATE + 2 * DM, DIN, WSP(bf16, WS_ACT), WSP(bf16, WS_MQ), WSP(bf16, WS_MK), DM}; pg8::gemm_phase<pg8::EpiGate<1>, pg8::StaticOrder, true, true>(F.lds, g, S, E); }
        }
        SEAM(kb + 6);
        if (PH(7) && IN(kb + 7)) { const Ctx F = make_ctx(ldsb); pg8::Gemm g{WSP(bf16, WS_ACT), WSP(bf16, WS_WOUT), M, DM, DM}; pg8::StaticOrder S; S.init(M, DM, F.G, F.bx); pg8::EpiResid E{outp(args), MOD_L(2), 6 * DM};
            pg8::gemm_phase<pg8::EpiResid, pg8::StaticOrder, true, true>(F.lds, g, S, E); }
        SEAM(kb + 7);
        if (PH(8) && IN(kb + 8)) for (int rep_ = 0; rep_ < REP7; ++rep_) { const Ctx F = make_ctx(ldsb); norm_phase(F, outp(args), INP(I_NMLP) + l * DM, MOD_L(4), MOD_L(3), WSP(bf16, WS_ACT)); }
        SEAM(kb + 8);
        if (PH(9) && IN(kb + 9)) for (int rep_ = 0; rep_ < REP8; ++rep_) { const Ctx F = make_ctx(ldsb); pg8::Gemm g{WSP(bf16, WS_ACT), WSP(bf16, WS_WFF1), M, DFF, DM}; pg8::StaticOrder S; S.init(M, DFF, F.G, F.bx); pg8::EpiStore<2> E{WSP(bf16, WS_PROJ), DFF};
            pg8::gemm_phase<pg8::EpiStore<2>, pg8::StaticOrder, true, true>(F.lds, g, S, E); }
        SEAM(kb + 9);
        if (PH(10) && IN(kb + 10)) { const Ctx F = make_ctx(ldsb); pg8::Gemm g{WSP(bf16, WS_PROJ), WSP(bf16, WS_WFF2), M, DM, DFF}; pg8::StaticOrder S; S.init(M, DM, F.G, F.bx); pg8::EpiResid E{outp(args), MOD_L(5), 6 * DM};
            pg8::gemm_phase<pg8::EpiResid, pg8::StaticOrder, true, true>(F.lds, g, S, E); }
        SEAM(kb + 10);
    }
    if (PH(12) && IN(N_PHASES - 1)) { const Ctx F = make_ctx(ldsb); final_norm_phase(F, outp(args), INP(I_FNORM)); }
#undef INP
#undef WSP
#undef MOD_L
#undef IN
#undef SEAM
}

extern "C" void kernel_launch(void* const* d_in, const int* in_sizes, int n_in, void* d_out, int out_size, void* d_ws, size_t ws_size, hipStream_t stream) {
    static int grid = 0;
    if (grid == 0) {
        if (n_in != N_INPUTS || out_size != M * DM || ws_size < WS_END) { fprintf(stderr, "kernel_launch: unexpected shapes (n_in %d, out %d, ws %zu); nothing launched\n", n_in, out_size, ws_size); grid = -1; return; }
        int dev = 0, cus = 0, per_cu = 0;
        if (hipGetDevice(&dev) != hipSuccess || hipDeviceGetAttribute(&cus, hipDeviceAttributeMultiprocessorCount, dev) != hipSuccess) { grid = -1; return; }
        if (hipFuncSetAttribute((const void*)fwd, hipFuncAttributeMaxDynamicSharedMemorySize, LDS_BYTES) != hipSuccess) { grid = -1; return; }
        if (hipOccupancyMaxActiveBlocksPerMultiprocessor(&per_cu, (const void*)fwd, NWAVES * 64, LDS_BYTES) != hipSuccess || per_cu < 1) { fprintf(stderr, "kernel_launch: occupancy query says %d blocks per CU; nothing launched\n", per_cu); (void)hipGetLastError(); grid = -1; return; }
        grid = cus;
    }
    if (grid < 0) return;
    (void)hipMemsetAsync((char*)d_ws + WS_CTL, 0, CTL_ZERO_BYTES, stream);
    Args a{};
    for (int i = 0; i < N_INPUTS; ++i) a.in[i] = (const float*)d_in[i];
    a.out = (float*)d_out; a.ws = (unsigned char*)d_ws;
#if MK_ONE_LAUNCH
    a.ph_lo = 0; a.ph_hi = N_PHASES;
    hipLaunchKernelGGL(fwd, dim3(grid), dim3(NWAVES * 64), LDS_BYTES, stream, a);
#else
    for (int k = 0; k < N_PHASES; ++k) { a.ph_lo = k; a.ph_hi = k + 1; hipLaunchKernelGGL(fwd, dim3(grid), dim3(NWAVES * 64), LDS_BYTES, stream, a); }
#endif
}
```

```cpp
#include <hip/hip_runtime.h>
#include <cstdio>
#include <cstdint>
#include <cmath>
constexpr int NB = 8, SEQ = 2048, DM = 1024, DIN = 10240, DFF = 4096, NL = 4, M = NB * SEQ;
constexpr int OFF_RQ = 0, OFF_RK = 512, OFF_RV = 1024, OFF_RG = 2048, OFF_LX = 3072, OFF_LY = 4096, OFF_MX = 5120, OFF_MO = 6144, OFF_GATE = 7168;
constexpr float EPSF = 1e-6f;
#define MK_ONE_LAUNCH 1
namespace pg8 {
#define PG8_LAS __attribute__((address_space(3)))
typedef unsigned short bf16_t;
typedef short bf16x8 __attribute__((ext_vector_type(8)));
typedef float f32x4 __attribute__((ext_vector_type(4)));
typedef unsigned u32x4 __attribute__((ext_vector_type(4)));
constexpr int BM = 256, BK = 64, HALF = 128, HTB = HALF * BK * 2  , STAGE_BYTES = 8 * HTB, NXCD = 8, WGM = 8;

__host__ __device__ __forceinline__ int lds_byte(int r, int c) { const int st = (r >> 4) * 2 + (c >> 5), rr = r & 15, cc = c & 31, ob = rr * 64 + cc * 2; return st * 1024 + (ob ^ (((ob >> 9) & 1) << 5)); }
__host__ __device__ __forceinline__ void stage_rc(int b, int& R, int& C) { const int st = b / 1024, sb = b % 1024, swz = sb ^ (((sb >> 9) & 1) << 5); R = (st >> 1) * 16 + swz / 64; C = (st & 1) * 32 + (swz % 64) / 2; }
__host__ __device__ __forceinline__ int perm32(int rho) { const int n = rho >> 4, i = rho & 15; return 8 * (i >> 2) + 4 * n + (i & 3); }

struct Unit { int pm, pn; };
struct Gemm { const bf16_t* A; const bf16_t* Bt; int M, N, K; };

struct StaticOrder {
    int nM, nN, nwg, G, c;
    __host__ __device__ void init(int M, int N, int G_, int c_) { nM = M / BM; nN = N / BM; nwg = nM * nN; G = G_; c = c_; }
    __host__ __device__ bool next(int i, Unit& u) const {
        const long L = (long)i * G + c; if (L >= nwg) return false;
        int wgid = (int)L; { const int q = nwg / NXCD, r = nwg % NXCD, xcd = wgid % NXCD, off = wgid / NXCD; wgid = (xcd < r ? xcd * (q + 1) : r * (q + 1) + (xcd - r) * q) + off; }
        const int nig = WGM * nN, gid = wgid / nig, fm = gid * WGM, gsz = (nM - fm) < WGM ? (nM - fm) : WGM;
        u.pm = fm + ((wgid % nig) % gsz); u.pn = (wgid % nig) / gsz; return true;
    }
    __device__ __forceinline__ void a_ready(const Unit&) const {}
    __device__ __forceinline__ void done(const Unit&) const {}
};
__device__ __forceinline__ unsigned cvt_pk_bf16(float lo, float hi) { unsigned r; asm volatile("v_cvt_pk_bf16_f32 %0, %1, %2" : "=v"(r) : "v"(lo), "v"(hi)); return r; }
typedef float f32x2 __attribute__((ext_vector_type(2)));
__device__ __forceinline__ float bf_lo(unsigned w) { return __builtin_bit_cast(float, w << 16); }
__device__ __forceinline__ float bf_hi(unsigned w) { return __builtin_bit_cast(float, w & 0xffff0000u); }
__device__ __forceinline__ float sigmoid_f(float x) { return 1.0f / (1.0f + __expf(-x)); }
template <int ACT> struct EpiStore {
    static constexpr bool PERM = true, AFTER_DRAIN = false;
    bf16_t* O; int ldc;
    __device__ __forceinline__ void operator()(const f32x4 (&acc)[2][2][4][2], const Unit& u, int wr, int wc, int fr, int fq) const {
        const int row0 = u.pm * BM + wr * 64 + fr, col0 = u.pn * BM + wc * 32 + 8 * fq;
#pragma unroll
        for (int ai = 0; ai < 2; ++ai)
#pragma unroll
            for (int m = 0; m < 4; ++m) { bf16_t* rowp = O + (size_t)(row0 + ai * HALF + m * 16) * ldc + col0;
#pragma unroll
                for (int bj = 0; bj < 2; ++bj) { f32x4 v0 = acc[ai][bj][m][0], v1 = acc[ai][bj][m][1];
                    if (ACT == 2) {
#pragma unroll
                        for (int e = 0; e < 4; ++e) { const float a = fmaxf(v0[e], 0.f), b = fmaxf(v1[e], 0.f); v0[e] = a * a; v1[e] = b * b; } }
                    u32x4 w; w.x = cvt_pk_bf16(v0[0], v0[1]); w.y = cvt_pk_bf16(v0[2], v0[3]); w.z = cvt_pk_bf16(v1[0], v1[1]); w.w = cvt_pk_bf16(v1[2], v1[3]);
                    *(u32x4*)(rowp + bj * HALF) = w; } }
    }
};
template <int MODE> struct EpiGate {
    static constexpr bool PERM = true, AFTER_DRAIN = false;
    const bf16_t* G; int ldg; bf16_t* O; const bf16_t* Y1; const bf16_t* Y2; int ldc;
    __device__ __forceinline__ void operator()(const f32x4 (&acc)[2][2][4][2], const Unit& u, int wr, int wc, int fr, int fq) const {
        const int row0 = u.pm * BM + wr * 64 + fr, col0 = u.pn * BM + wc * 32 + 8 * fq;
#pragma unroll
        for (int ai = 0; ai < 2; ++ai)
#pragma unroll
            for (int m = 0; m < 4; ++m) { const size_t row = (size_t)(row0 + ai * HALF + m * 16);
#pragma unroll
                for (int bj = 0; bj < 2; ++bj) { f32x4 v0 = acc[ai][bj][m][0], v1 = acc[ai][bj][m][1];
                    const u32x4 gw = *(const u32x4*)(G + row * ldg + col0 + bj * HALF);
                    v0[0] *= sigmoid_f(bf_lo(gw.x)); v0[1] *= sigmoid_f(bf_hi(gw.x)); v0[2] *= sigmoid_f(bf_lo(gw.y)); v0[3] *= sigmoid_f(bf_hi(gw.y));
                    v1[0] *= sigmoid_f(bf_lo(gw.z)); v1[1] *= sigmoid_f(bf_hi(gw.z)); v1[2] *= sigmoid_f(bf_lo(gw.w)); v1[3] *= sigmoid_f(bf_hi(gw.w));
                    if (MODE == 1) {
                        const u32x4 a = *(const u32x4*)(Y1 + row * ldc + col0 + bj * HALF), b = *(const u32x4*)(Y2 + row * ldc + col0 + bj * HALF);
                        v0[0] += bf_lo(a.x) + bf_lo(b.x); v0[1] += bf_hi(a.x) + bf_hi(b.x); v0[2] += bf_lo(a.y) + bf_lo(b.y); v0[3] += bf_hi(a.y) + bf_hi(b.y);
                        v1[0] += bf_lo(a.z) + bf_lo(b.z); v1[1] += bf_hi(a.z) + bf_hi(b.z); v1[2] += bf_lo(a.w) + bf_lo(b.w); v1[3] += bf_hi(a.w) + bf_hi(b.w); }
                    u32x4 w; w.x = cvt_pk_bf16(v0[0], v0[1]); w.y = cvt_pk_bf16(v0[2], v0[3]); w.z = cvt_pk_bf16(v1[0], v1[1]); w.w = cvt_pk_bf16(v1[2], v1[3]);
                    *(u32x4*)(O + row * ldc + col0 + bj * HALF) = w; }
                asm volatile("" ::: "memory"); }
    }
};
struct EpiResid {
    static constexpr bool PERM = false, AFTER_DRAIN = false;
    float* X; const float* g; int gstride;
    __device__ __forceinline__ void operator()(const f32x4 (&acc)[2][2][4][2], const Unit& u, int wr, int wc, int fr, int fq) const {
        const float* gb = g + (size_t)(u.pm >> 3) * gstride;
        const int row0 = u.pm * BM + wr * 64 + fr, col0 = u.pn * BM + wc * 32 + 4 * fq;
#pragma unroll
        for (int bj = 0; bj < 2; ++bj)
#pragma unroll
            for (int n = 0; n < 2; ++n) { const f32x4 gv = *(const f32x4*)(gb + col0 + bj * HALF + n * 16);
#pragma unroll
                for (int ai = 0; ai < 2; ++ai)
#pragma unroll
                    for (int m = 0; m < 4; ++m) { float* p = X + (size_t)(row0 + ai * HALF + m * 16) * 1024 + col0 + bj * HALF + n * 16;
                        const f32x4 xv = *(const f32x4*)p; *(f32x4*)p = xv + gv * acc[ai][bj][m][n]; if (m & 1) asm volatile("" ::: "memory"); } }
    }
};
template <class Epi, class Sched, bool ALIGN_EPI = false, bool SP2 = false>
__device__ __forceinline__ void gemm_phase(PG8_LAS unsigned char* lds, const Gemm g, const Sched& S, const Epi& E, const int tid_in) {
    int tid_o = tid_in; asm volatile("" : "+v"(tid_o));
    const int tid = tid_o, wid = __builtin_amdgcn_readfirstlane(tid >> 6), lane = tid & 63, wr = wid >> 2, wc = wid & 3, fr = lane & 15, fq = lane >> 4;
    const int K = g.K, nt = K / BK;
    unsigned voffA[2], voffB[2];
#pragma unroll
    for (int i = 0; i < 2; ++i) { int R, C; stage_rc(tid * 16 + i * 8192, R, C); const int Rb = Epi::PERM ? ((R & ~31) + perm32(R & 31)) : R;
        voffA[i] = (unsigned)(R * K + C) * 2u; voffB[i] = (unsigned)(Rb * K + C) * 2u; }
    const size_t kstep = (size_t)(BK * 2);
    const size_t hstep = (size_t)HALF * K * 2;
    const size_t tstep = 2 * hstep;
    const unsigned ldsw = (unsigned)wid * 1024u;
    const int aoff = lds_byte(wr * 64 + fr, fq * 8), boff = lds_byte(wc * 32 + fr, fq * 8);
#define PG8_SA(b, h) (((b) * 2 + (h)) * HTB)
#define PG8_SB(b, h) ((4 + (b) * 2 + (h)) * HTB)
#define PG8_STAGE(bufoff, gbase, voff) do { _Pragma("unroll") for (int _i = 0; _i < 2; ++_i) \
        __builtin_amdgcn_global_load_lds((const unsigned*)((const char*)(gbase) + (voff)[_i]), (PG8_LAS unsigned*)(lds + (bufoff) + ldsw + _i * 8192), 16, 0, 0); } while (0)
#define PG8_LDA(dst, b, h) do { _Pragma("unroll") for (int m = 0; m < 4; ++m) _Pragma("unroll") for (int k = 0; k < 2; ++k) dst[m][k] = *(const PG8_LAS bf16x8*)(lds + PG8_SA(b, h) + aoff + m * 2048 + k * 1024); } while (0)
#define PG8_LDB(dst, b, h) do { _Pragma("unroll") for (int n = 0; n < 2; ++n) _Pragma("unroll") for (int k = 0; k < 2; ++k) dst[n][k] = *(const PG8_LAS bf16x8*)(lds + PG8_SB(b, h) + boff + n * 2048 + k * 1024); } while (0)
#define PG8_MMA(ai, bj, At, Bt) do { __builtin_amdgcn_s_setprio(1); _Pragma("unroll") for (int m = 0; m < 4; ++m) _Pragma("unroll") for (int n = 0; n < 2; ++n) _Pragma("unroll") for (int k = 0; k < 2; ++k) \
        acc[ai][bj][m][n] = __builtin_amdgcn_mfma_f32_16x16x32_bf16(Bt[n][k], At[m][k], acc[ai][bj][m][n], 0, 0, 0); __builtin_amdgcn_s_setprio(0); } while (0)
#define PG8_WAIT_V(n) asm volatile("s_waitcnt vmcnt(" #n ")" ::: "memory")
#define PG8_WAIT_L(n) asm volatile("s_waitcnt lgkmcnt(" #n ")" ::: "memory")
#define PG8_BAR __builtin_amdgcn_s_barrier()
#define PG8_SCHED __builtin_amdgcn_sched_barrier(0)
    Unit cur, nxt; int ui = 0;
    if (!S.next(0, cur)) return;
    f32x4 acc[2][2][4][2];
#pragma unroll
    for (int a = 0; a < 2; ++a)
#pragma unroll
        for (int b = 0; b < 2; ++b)
#pragma unroll
            for (int m = 0; m < 4; ++m)
#pragma unroll
                for (int n = 0; n < 2; ++n) acc[a][b][m][n] = (f32x4){0.f, 0.f, 0.f, 0.f};
    bf16x8 At[4][2], B0[2][2], B1[2][2];
    const char* cA = (const char*)g.A + (size_t)cur.pm * tstep; const char* cB = (const char*)g.Bt + (size_t)cur.pn * tstep;
    S.a_ready(cur);
    if constexpr (SP2) {
        PG8_STAGE(PG8_SB(0, 0), cB, voffB); PG8_STAGE(PG8_SB(0, 1), cB + hstep, voffB); PG8_STAGE(PG8_SA(0, 0), cA, voffA); PG8_STAGE(PG8_SA(0, 1), cA + hstep, voffA);
        if (wr == 1) PG8_BAR;
        PG8_WAIT_V(2); PG8_BAR;
        PG8_STAGE(PG8_SB(1, 0), cB + kstep, voffB); PG8_STAGE(PG8_SA(1, 0), cA + kstep, voffA); PG8_STAGE(PG8_SB(1, 1), cB + hstep + kstep, voffB);
        PG8_WAIT_V(6); PG8_BAR;
    } else {
        PG8_STAGE(PG8_SB(0, 0), cB, voffB); PG8_STAGE(PG8_SA(0, 0), cA, voffA); PG8_STAGE(PG8_SB(0, 1), cB + hstep, voffB); PG8_STAGE(PG8_SA(0, 1), cA + hstep, voffA);
        if (wr == 1) PG8_BAR;
        PG8_WAIT_V(4); PG8_BAR;
        PG8_STAGE(PG8_SB(1, 0), cB + kstep, voffB); PG8_STAGE(PG8_SA(1, 0), cA + kstep, voffA); PG8_STAGE(PG8_SB(1, 1), cB + hstep + kstep, voffB);
        PG8_WAIT_V(6); PG8_BAR;
    }
    for (;;) {
        const bool has_next = S.next(ui + 1, nxt);
        const char* nA = has_next ? (const char*)g.A + (size_t)nxt.pm * tstep : cA; const char* nB = has_next ? (const char*)g.Bt + (size_t)nxt.pn * tstep : cB;
        for (int t = 0; t < nt; t += 2) {
            const bool last = (t == nt - 2);
            const char* a1 = cA + (size_t)(t + 1) * kstep;
            const char* a2 = last ? nA : cA + (size_t)(t + 2) * kstep; const char* b2 = last ? nB : cB + (size_t)(t + 2) * kstep;
            const char* a3 = a2 + kstep; const char* b3 = b2 + kstep;
            if (last && has_next) S.a_ready(nxt);
            if constexpr (SP2) {
            PG8_LDB(B0, 0, 0); PG8_LDB(B1, 0, 1); PG8_SCHED; PG8_LDA(At, 0, 0); PG8_STAGE(PG8_SA(1, 1), a1 + hstep, voffA);
            PG8_WAIT_V(8); PG8_WAIT_L(0); PG8_BAR; PG8_MMA(0, 0, At, B0); PG8_MMA(0, 1, At, B1); PG8_BAR; PG8_SCHED;
            PG8_LDA(At, 0, 1); PG8_STAGE(PG8_SB(0, 0), b2, voffB); PG8_STAGE(PG8_SB(0, 1), b2 + hstep, voffB); PG8_STAGE(PG8_SA(0, 0), a2, voffA);
            PG8_WAIT_V(8); PG8_WAIT_L(0); PG8_BAR; PG8_MMA(1, 0, At, B0); PG8_MMA(1, 1, At, B1); PG8_BAR; PG8_SCHED;
            PG8_LDB(B0, 1, 0); PG8_LDB(B1, 1, 1); PG8_SCHED; PG8_LDA(At, 1, 0); PG8_STAGE(PG8_SA(0, 1), a2 + hstep, voffA);
            PG8_WAIT_V(8); PG8_WAIT_L(0); PG8_BAR; PG8_MMA(0, 0, At, B0); PG8_MMA(0, 1, At, B1); PG8_BAR; PG8_SCHED;
            PG8_LDA(At, 1, 1); PG8_STAGE(PG8_SB(1, 0), b3, voffB); PG8_STAGE(PG8_SB(1, 1), b3 + hstep, voffB); PG8_STAGE(PG8_SA(1, 0), a3, voffA);
            PG8_WAIT_V(8); PG8_WAIT_L(0); PG8_BAR; PG8_MMA(1, 0, At, B0); PG8_MMA(1, 1, At, B1); PG8_BAR; PG8_SCHED;
            } else {
            PG8_LDB(B0, 0, 0); PG8_SCHED; PG8_LDA(At, 0, 0); PG8_STAGE(PG8_SA(1, 1), a1 + hstep, voffA);
            PG8_WAIT_L(8); PG8_BAR; PG8_WAIT_L(0); PG8_MMA(0, 0, At, B0); PG8_BAR; PG8_SCHED;
            PG8_LDB(B1, 0, 1); PG8_STAGE(PG8_SB(0, 0), b2, voffB);
            PG8_BAR; PG8_WAIT_L(0); PG8_MMA(0, 1, At, B1); PG8_BAR;
            PG8_LDA(At, 0, 1); PG8_STAGE(PG8_SA(0, 0), a2, voffA);
            PG8_BAR; PG8_WAIT_L(0); PG8_MMA(1, 0, At, B0); PG8_BAR; PG8_SCHED;
            PG8_STAGE(PG8_SB(0, 1), b2 + hstep, voffB);
            PG8_WAIT_V(6); PG8_BAR; PG8_MMA(1, 1, At, B1); PG8_BAR;
            PG8_LDB(B0, 1, 0); PG8_SCHED; PG8_LDA(At, 1, 0); PG8_STAGE(PG8_SA(0, 1), a2 + hstep, voffA);
            PG8_WAIT_L(8); PG8_BAR; PG8_WAIT_L(0); PG8_MMA(0, 0, At, B0); PG8_BAR; PG8_SCHED;
            PG8_LDB(B1, 1, 1); PG8_STAGE(PG8_SB(1, 0), b3, voffB);
            PG8_BAR; PG8_WAIT_L(0); PG8_MMA(0, 1, At, B1); PG8_BAR;
            PG8_LDA(At, 1, 1); PG8_STAGE(PG8_SA(1, 0), a3, voffA);
            PG8_BAR; PG8_WAIT_L(0); PG8_MMA(1, 0, At, B0); PG8_BAR; PG8_SCHED;
            PG8_STAGE(PG8_SB(1, 1), b3 + hstep, voffB);
            PG8_WAIT_V(6); PG8_BAR; PG8_MMA(1, 1, At, B1); PG8_BAR;
            }
        }
        if constexpr (ALIGN_EPI) { if (wr == 0) PG8_BAR; }
        if constexpr (!Epi::AFTER_DRAIN) { E(acc, cur, wr, wc, fr, fq); S.done(cur); }
        if (!has_next) break;
#pragma unroll
        for (int a = 0; a < 2; ++a)
#pragma unroll
            for (int b = 0; b < 2; ++b)
#pragma unroll
                for (int m = 0; m < 4; ++m)
#pragma unroll
                    for (int n = 0; n < 2; ++n) acc[a][b][m][n] = (f32x4){0.f, 0.f, 0.f, 0.f};
        cur = nxt; cA = nA; cB = nB; ++ui;
        if constexpr (ALIGN_EPI) { if (wr == 1) PG8_BAR; }
    }
    PG8_WAIT_V(0);
    if constexpr (!ALIGN_EPI) { if (wr == 0) PG8_BAR; }
    PG8_BAR;
    if constexpr (Epi::AFTER_DRAIN) { E.fused(acc, cur, wr, wc, fr, fq, lds, wid, lane); S.done(cur); }
#undef PG8_SA
#undef PG8_SB
#undef PG8_STAGE
#undef PG8_LDA
#undef PG8_LDB
#undef PG8_MMA
#undef PG8_WAIT_V
#undef PG8_WAIT_L
#undef PG8_BAR
#undef PG8_SCHED
}
}
#ifndef MK_ONE_LAUNCH
#define MK_ONE_LAUNCH 1
#endif
constexpr int NWAVES = 8;
constexpr size_t MiB = 1u << 20;
constexpr size_t WS_CTL = 0, CTL_ZERO_BYTES = 1 * MiB;
constexpr size_t WS_MODF = 1 * MiB;
constexpr size_t WS_ROPE = 2 * MiB;
constexpr size_t WS_IFG = 10 * MiB;
constexpr size_t WS_LRUC = 11 * MiB;
constexpr size_t WS_WIN = 12 * MiB;
constexpr size_t WS_WBR = 32 * MiB;
constexpr size_t WS_WOUT = 38 * MiB;
constexpr size_t WS_WFF1 = 40 * MiB;
constexpr size_t WS_WFF2 = 48 * MiB;
constexpr size_t WS_ACT = 56 * MiB;
constexpr size_t WS_RET = 88 * MiB, WS_LRU = 120 * MiB, WS_MLS = 152 * MiB;
constexpr size_t WS_MQ = 184 * MiB, WS_MK = 216 * MiB, WS_MV = 248 * MiB;
constexpr size_t WS_PROJ = 280 * MiB;
constexpr size_t WS_END = 600 * MiB;
constexpr size_t WS_MLST = WS_ACT, WS_RTST = WS_WIN;
constexpr int LDS_BYTES = 163840;
constexpr int SCRATCH_BYTES = 163584, MISC_OFF = SCRATCH_BYTES;

#define GAS __attribute__((address_space(1)))
#define LAS __attribute__((address_space(3)))
typedef unsigned short bf16;
typedef unsigned v4u __attribute__((ext_vector_type(4)));
typedef unsigned v2u __attribute__((ext_vector_type(2)));
typedef float f32x4 __attribute__((ext_vector_type(4)));
typedef float f32x2v __attribute__((ext_vector_type(2)));
#define LDS_WAIT() asm volatile("s_waitcnt lgkmcnt(0)" ::: "memory")
#define VM_WAIT() asm volatile("s_waitcnt vmcnt(0)" ::: "memory")
__device__ __forceinline__ unsigned f2bf(float f) { unsigned u = __builtin_bit_cast(unsigned, f); return (u + 0x7fffu + ((u >> 16) & 1u)) >> 16; }
__device__ __forceinline__ unsigned pk2(float lo, float hi) { return f2bf(lo) | (f2bf(hi) << 16); }
__device__ __forceinline__ float bf2f(unsigned short h) { return __builtin_bit_cast(float, (unsigned)h << 16); }
__device__ __forceinline__ float bflo(unsigned w) { return __builtin_bit_cast(float, w << 16); }
__device__ __forceinline__ float bfhi(unsigned w) { return __builtin_bit_cast(float, w & 0xffff0000u); }
__device__ __forceinline__ float sigmoidf_(float x) { return 1.0f / (1.0f + __expf(-x)); }
__device__ __forceinline__ float wave_sum(float v) {
#pragma unroll
    for (int o = 1; o < 64; o <<= 1) v += __shfl_xor(v, o);
    return v;
}
#define XB_TMO      128
#define XB_XCNT(j)  (256  + 64 * (j))
#define XB_XSUB(j)  (1280 + 64 * (j))
#define XB_XGEN(j)  (2304 + 64 * (j))
#define XB_TOP      3328
#define XB_TOPGEN   3392
#define XCD_BAR_WORDS 3456
#define XB_SPIN_CAP (1u << 18)

__device__ __forceinline__ unsigned xb_ld(unsigned* p)              { return __hip_atomic_load(p, __ATOMIC_RELAXED, __HIP_MEMORY_SCOPE_AGENT); }
__device__ __forceinline__ unsigned xb_add(unsigned* p, unsigned v) { return __hip_atomic_fetch_add(p, v, __ATOMIC_RELAXED, __HIP_MEMORY_SCOPE_AGENT); }
__device__ __forceinline__ unsigned xb_xcc_id() { return (unsigned)__builtin_amdgcn_s_getreg((3 << 11) | 20) & 0xFu; }
#define XB_SPIN(cond, bar) do { unsigned _sp = 0; while (cond) { __builtin_amdgcn_s_sleep(1); \
    if ((++_sp & 255u) == 0u) { if (xb_ld(&(bar)[XB_TMO])) break; if (_sp > XB_SPIN_CAP) { atomicAdd(&(bar)[XB_TMO], 1u); break; } } } } while (0)

struct XcdBarrier {
    unsigned* bar; unsigned x;
    volatile LAS unsigned* st;
};

__device__ __forceinline__ XcdBarrier xcd_barrier_post(unsigned* bar, volatile LAS unsigned* st, const bool is_t0) {
    XcdBarrier b; b.bar = bar; b.x = xb_xcc_id(); b.st = st;
    if (is_t0) (void)xb_add(&bar[XB_XCNT(b.x)], 1u);
    return b;
}
__device__ __forceinline__ void xcd_barrier_complete(unsigned* bar, unsigned x, unsigned& nloc, unsigned& nx) {
    const unsigned G = gridDim.x * gridDim.y * gridDim.z;
    unsigned sum, cnt, mine, sp = 0u;
    for (;;) {
        sum = 0u; cnt = 0u; mine = 0u;
#pragma unroll
        for (unsigned j = 0; j < 16; ++j) { const unsigned c = xb_ld(&bar[XB_XCNT(j)]); sum += c; cnt += (c > 0u) ? 1u : 0u; mine = (j == x) ? c : mine; }
        if (sum == G) break;
        __builtin_amdgcn_s_sleep(1);
        if ((++sp & 255u) == 0u) { if (xb_ld(&bar[XB_TMO])) break; if (sp > XB_SPIN_CAP) { atomicAdd(&bar[XB_TMO], 1u); break; } }
    }
    nloc = mine > 0u ? mine : 1u; nx = cnt > 0u ? cnt : 1u;
}

__device__ __forceinline__ void xcd_barrier(const XcdBarrier& b, const bool is_t0) {
    asm volatile("s_waitcnt vmcnt(0)" ::: "memory");
    __syncthreads();
    if (is_t0) {
        unsigned* bar = b.bar;
        __builtin_amdgcn_s_waitcnt(0);
        unsigned nloc = b.st[0], nx = b.st[1];
        if (nloc == 0u) { xcd_barrier_complete(bar, b.x, nloc, nx); b.st[0] = nloc; b.st[1] = nx; }
        const unsigned old = xb_add(&bar[XB_XSUB(b.x)], 1u);
        const unsigned gen = old / nloc;
        if (old + 1u == (gen + 1u) * nloc) {
            __builtin_amdgcn_fence(__ATOMIC_RELEASE, "agent");
            asm volatile("s_waitcnt vmcnt(0)" ::: "memory");
            const unsigned og = xb_add(&bar[XB_TOP], 1u);
            const unsigned tg = og / nx;
            if (og + 1u == (tg + 1u) * nx) xb_add(&bar[XB_TOPGEN], 1u);
            else XB_SPIN(xb_ld(&bar[XB_TOPGEN]) == tg, bar);
            __builtin_amdgcn_fence(__ATOMIC_ACQUIRE, "agent");
            xb_add(&bar[XB_XGEN(b.x)], 1u);
            asm volatile("s_waitcnt vmcnt(0)" ::: "memory");
        } else {
            XB_SPIN(xb_ld(&bar[XB_XGEN(b.x)]) == gen, bar);
            __builtin_amdgcn_fence(__ATOMIC_ACQUIRE, "agent");
            asm volatile("s_waitcnt vmcnt(0)" ::: "memory");
        }
    }
    __syncthreads();
}
__device__ __forceinline__ void p0_transpose_item(const float* W, int K, int N, bf16* WT, int row_off, LAS float* scr, int item, int lane) {
    const int nblk = N / 32, kb = item / nblk, nb = item % nblk, k0 = 64 * kb, n0 = 32 * nb;
#pragma unroll 8
    for (int i = 0; i < 32; ++i) { const int kk = 2 * i + (lane >> 5); scr[kk * 33 + (lane & 31)] = W[(size_t)(k0 + kk) * N + n0 + (lane & 31)]; }
    LDS_WAIT(); asm volatile("" ::: "memory");
    const int c = lane & 7;
#pragma unroll
    for (int j = 0; j < 4; ++j) { const int n = (lane >> 3) + 8 * j; const LAS float* s = scr + (8 * c) * 33 + n;
        v4u o; o.x = pk2(s[0 * 33], s[1 * 33]); o.y = pk2(s[2 * 33], s[3 * 33]); o.z = pk2(s[4 * 33], s[5 * 33]); o.w = pk2(s[6 * 33], s[7 * 33]);
        *(GAS v4u*)(WT + (size_t)(row_off + n0 + n) * K + k0 + 8 * c) = o; }
    LDS_WAIT(); asm volatile("" ::: "memory");
}
__device__ __forceinline__ float log1p_pos(float t) { return t < 0.0625f ? t * (1.0f + t * (-0.5f + t * (0.33333334f + t * (-0.25f + t * (0.2f + t * -0.16666667f))))) : __logf(1.0f + t); }
__device__ __forceinline__ float expm1_neg(float x) { return x > -0.0625f ? x * (1.0f + x * (0.5f + x * (0.16666667f + x * (0.041666668f + x * (0.008333334f + x * 0.0013888889f))))) : __expf(x) - 1.0f; }
__device__ __forceinline__ float log_sigmoid_f(float x) { return x >= 0.f ? -log1p_pos(__expf(-x)) : x - log1p_pos(__expf(x)); }
__device__ __forceinline__ float log_gamma_h(int h) { return h == 0 ? -0.031748698314580f : h == 1 ? -0.015748356968139f : h == 2 ? -0.007843177461025f : -0.003913899321136f; }
struct Ctx {
    LAS unsigned char* lds;
    int tid, lane, wave, vcu, G, bx;
};

__device__ __forceinline__ void p0_prologue(const Ctx& F, const float* x, const float* c, const int* positions, const float* w_ada, const float* b_ada,
                                            float* modf, f32x2v* rope, float* xw) {
    LAS float* cond = (LAS float*)F.lds;
    LAS float* red = (LAS float*)(F.lds + 32768);
    for (int i = F.tid; i < NB * DM; i += 512) { const float v = c[i]; cond[i] = v / (1.f + __expf(-v)); }
    __syncthreads();
    const int col = F.tid & 63, ks = F.tid >> 6;
    for (int it = F.vcu; it < NL * 96; it += F.G) {
        const int l = it / 96, cg = it % 96, n = cg * 64 + col;
        const float* w = w_ada + ((size_t)l * DM + ks * 128) * (6 * DM) + n;
        float acc[8];
#pragma unroll
        for (int b = 0; b < 8; ++b) acc[b] = 0.f;
#pragma unroll 8
        for (int k = 0; k < 128; ++k) { const float wv = w[(size_t)k * (6 * DM)];
#pragma unroll
            for (int b = 0; b < 8; ++b) acc[b] += cond[b * DM + ks * 128 + k] * wv; }
#pragma unroll
        for (int b = 0; b < 8; ++b) red[(ks * 8 + b) * 64 + col] = acc[b];
        __syncthreads();
        { const int b = F.tid >> 6; float s = b_ada[l * 6 * DM + n];
#pragma unroll
          for (int k2 = 0; k2 < 8; ++k2) s += red[(k2 * 8 + b) * 64 + col];
          modf[((size_t)l * NB + b) * (6 * DM) + n] = s; }
        __syncthreads();
    }
    const int gt = F.vcu * 512 + F.tid, NT = F.G * 512;
    for (int idx = gt; idx < M * 64; idx += NT) { const int tok = idx >> 6, i = idx & 63;
        const float inv = powf(10000.0f, -(float)i * (1.0f / 64.0f)); const float ang = (float)positions[tok] * inv;
        float sn, cs; sincosf(ang, &sn, &cs); rope[idx] = (f32x2v){cs, sn}; }
    for (int idx = gt; idx < M * DM / 4; idx += NT) ((f32x4*)xw)[idx] = ((const f32x4*)x)[idx];
}

__device__ __forceinline__ void convert_weights(const Ctx& F, const float* w_in, const float* w_br0, const float* w_br1, const float* w_br2, const float* w_out,
                                                const float* w_ff1, const float* w_ff2, bf16* Win, bf16* Wbr, bf16* Wout, bf16* Wff1, bf16* Wff2) {
    LAS float* scr = (LAS float*)(F.lds + F.wave * 16384);
    const int gw = F.vcu * NWAVES + F.wave, NGW = F.G * NWAVES;
    constexpr int I_IN = (DM / 64) * (DIN / 32), I_SQ = (DM / 64) * (DM / 32), I_F1 = (DM / 64) * (DFF / 32), I_F2 = (DFF / 64) * (DM / 32);
    constexpr int NITEMS = I_IN + 4 * I_SQ + I_F1 + I_F2;
    for (int it = gw; it < NITEMS; it += NGW) {
        int r = it;
        if (r < I_IN) { p0_transpose_item(w_in, DM, DIN, Win, 0, scr, r, F.lane); continue; } r -= I_IN;
        if (r < I_SQ) { p0_transpose_item(w_br0, DM, DM, Wbr, 0, scr, r, F.lane); continue; } r -= I_SQ;
        if (r < I_SQ) { p0_transpose_item(w_br1, DM, DM, Wbr, DM, scr, r, F.lane); continue; } r -= I_SQ;
        if (r < I_SQ) { p0_transpose_item(w_br2, DM, DM, Wbr, 2 * DM, scr, r, F.lane); continue; } r -= I_SQ;
        if (r < I_SQ) { p0_transpose_item(w_out, DM, DM, Wout, 0, scr, r, F.lane); continue; } r -= I_SQ;
        if (r < I_F1) { p0_transpose_item(w_ff1, DM, DFF, Wff1, 0, scr, r, F.lane); continue; } r -= I_F1;
        p0_transpose_item(w_ff2, DFF, DM, Wff2, 0, scr, r, F.lane);
    }
}

__device__ __forceinline__ void norm_phase(const Ctx& F, const float* xw, const float* gain, const float* sc, const float* sh, bf16* out) {
    const int gw = F.vcu * NWAVES + F.wave, NGW = F.G * NWAVES;
    for (int ri = gw; ri < M / 8; ri += NGW) {
        const int b = ri / (SEQ / 8);
        f32x4 A[4], Bv[4];
#pragma unroll
        for (int j = 0; j < 4; ++j) { const int cidx = 4 * F.lane + 256 * j;
            const f32x4 g = *(const f32x4*)(gain + cidx), s1 = *(const f32x4*)(sc + (size_t)b * 6 * DM + cidx); A[j] = g * (s1 + 1.0f); Bv[j] = *(const f32x4*)(sh + (size_t)b * 6 * DM + cidx); }
        for (int r = 0; r < 8; ++r) { const size_t row = (size_t)ri * 8 + r;
            const f32x4* xr = (const f32x4*)(xw + row * DM) + F.lane;
            f32x4 v[4]; float ss = 0.f;
#pragma unroll
            for (int j = 0; j < 4; ++j) { v[j] = xr[64 * j]; ss += (v[j].x * v[j].x + v[j].y * v[j].y) + (v[j].z * v[j].z + v[j].w * v[j].w); }
            const float rs = rsqrtf(wave_sum(ss) * (1.0f / DM) + EPSF);
            unsigned long long* o8 = (unsigned long long*)(out + row * DM) + F.lane;
#pragma unroll
            for (int j = 0; j < 4; ++j) { const f32x4 o = v[j] * rs * A[j] + Bv[j];
                o8[64 * j] = (unsigned long long)pk2(o.x, o.y) | ((unsigned long long)pk2(o.z, o.w) << 32); } }
    }
}
__device__ __forceinline__ void final_norm_phase(const Ctx& F, float* xw, const float* gain) {
    const int gw = F.vcu * NWAVES + F.wave, NGW = F.G * NWAVES;
    f32x4 A[4];
#pragma unroll
    for (int j = 0; j < 4; ++j) A[j] = *(const f32x4*)(gain + 4 * F.lane + 256 * j);
    for (int row = gw; row < M; row += NGW) {
        f32x4* xr = (f32x4*)(xw + (size_t)row * DM) + F.lane;
        f32x4 v[4]; float ss = 0.f;
#pragma unroll
        for (int j = 0; j < 4; ++j) { v[j] = xr[64 * j]; ss += (v[j].x * v[j].x + v[j].y * v[j].y) + (v[j].z * v[j].z + v[j].w * v[j].w); }
        const float rs = rsqrtf(wave_sum(ss) * (1.0f / DM) + EPSF);
#pragma unroll
        for (int j = 0; j < 4; ++j) xr[64 * j] = v[j] * rs * A[j];
    }
}

__device__ __forceinline__ void mlstm_pre(const Ctx& F, const bf16* proj, const float* conv_w, const float* conv_b, const float* wq, const float* wk, const float* wv,
                                          const float* w_if, const float* b_if, bf16* MQ, bf16* MK, bf16* MV, float* IFG) {
    LAS f32x4* wif = (LAS f32x4*)F.lds;
    LAS float* part = (LAS float*)(F.lds + 98304);
    LAS float* gsh = (LAS float*)(F.lds + 98304 + 8192);
    for (int e = F.tid; e < 3 * DM * 8; e += 512) { const int j = e >> 3, g = e & 7, src = j >> 10, ch = j & 1023, nb = ch >> 2, d = ch & 3, vi = (src * 4 + d) * 8 + g;
        ((LAS float*)wif)[((vi >> 2) * 256 + nb) * 4 + (vi & 3)] = w_if[e]; }
    const int u = F.tid & 255, rg = F.tid >> 8, c0 = 4 * u, wrun = F.wave & 3;
    f32x4 cw[4], Wq[4], Wk[4], Wv[4];
#pragma unroll
    for (int k = 0; k < 4; ++k) { cw[k] = *(const f32x4*)(conv_w + k * DM + c0); Wq[k] = *(const f32x4*)(wq + u * 16 + k * 4); Wk[k] = *(const f32x4*)(wk + u * 16 + k * 4); Wv[k] = *(const f32x4*)(wv + u * 16 + k * 4); }
    const f32x4 cb = *(const f32x4*)(conv_b + c0);
    __syncthreads();
    for (int rr = F.vcu; rr < M / 64; rr += F.G) {
        const int r = 2 * rr + rg, t0 = (r & 63) * 32;
        const bf16* mx = proj + (size_t)r * 32 * DIN + OFF_MX + c0;
        f32x4 x0 = {0.f, 0.f, 0.f, 0.f}, x1 = x0, x2 = x0;
        if (t0 != 0) { v2u a = *(const v2u*)(mx - 3 * (size_t)DIN), b = *(const v2u*)(mx - 2 * (size_t)DIN), cc = *(const v2u*)(mx - (size_t)DIN);
            x0 = (f32x4){bflo(a.x), bfhi(a.x), bflo(a.y), bfhi(a.y)}; x1 = (f32x4){bflo(b.x), bfhi(b.x), bflo(b.y), bfhi(b.y)}; x2 = (f32x4){bflo(cc.x), bfhi(cc.x), bflo(cc.y), bfhi(cc.y)}; }
#pragma unroll 1
        for (int tt = 0; tt < 32; ++tt) {
            const size_t row = (size_t)r * 32 + tt;
            const v2u xr = *(const v2u*)(mx + (size_t)tt * DIN);
            const f32x4 x3 = {bflo(xr.x), bfhi(xr.x), bflo(xr.y), bfhi(xr.y)};
            f32x4 cv = cb + cw[0] * x0 + cw[1] * x1 + cw[2] * x2 + cw[3] * x3;
            f32x4 xc; xc.x = cv.x * sigmoidf_(cv.x); xc.y = cv.y * sigmoidf_(cv.y); xc.z = cv.z * sigmoidf_(cv.z); xc.w = cv.w * sigmoidf_(cv.w);
            const f32x4 q = Wq[0] * xc.x + Wq[1] * xc.y + Wq[2] * xc.z + Wq[3] * xc.w;
            const f32x4 k = Wk[0] * xc.x + Wk[1] * xc.y + Wk[2] * xc.z + Wk[3] * xc.w;
            const f32x4 v = Wv[0] * x3.x + Wv[1] * x3.y + Wv[2] * x3.z + Wv[3] * x3.w;
            *(v2u*)(MQ + row * DM + c0) = (v2u){pk2(q.x, q.y), pk2(q.z, q.w)};
            *(v2u*)(MK + row * DM + c0) = (v2u){pk2(k.x * 0.0625f, k.y * 0.0625f), pk2(k.z * 0.0625f, k.w * 0.0625f)};
            *(v2u*)(MV + row * DM + c0) = (v2u){pk2(v.x, v.y), pk2(v.z, v.w)};
            f32x4 pa = {0.f, 0.f, 0.f, 0.f}, pb = pa;
            const float vals[12] = {q.x, q.y, q.z, q.w, k.x, k.y, k.z, k.w, v.x, v.y, v.z, v.w};
#pragma unroll
            for (int sd = 0; sd < 12; ++sd) { pa += wif[(sd * 2) * 256 + u] * vals[sd]; pb += wif[(sd * 2 + 1) * 256 + u] * vals[sd]; }
            const bool b0 = F.lane & 1, b1 = F.lane & 2, b2 = F.lane & 4;
            float a4[4];
#pragma unroll
            for (int i = 0; i < 4; ++i) { const float snd = b0 ? pa[i] : pb[i], kp = b0 ? pb[i] : pa[i]; a4[i] = kp + __shfl_xor(snd, 1); }
            float c2[2];
#pragma unroll
            for (int i = 0; i < 2; ++i) { const float snd = b1 ? a4[i] : a4[i + 2], kp = b1 ? a4[i + 2] : a4[i]; c2[i] = kp + __shfl_xor(snd, 2); }
            float d1; { const float snd = b2 ? c2[0] : c2[1], kp = b2 ? c2[1] : c2[0]; d1 = kp + __shfl_xor(snd, 4); }
            d1 += __shfl_xor(d1, 8); d1 += __shfl_xor(d1, 16); d1 += __shfl_xor(d1, 32);
            if (F.lane < 8) { const int gi = 4 * (F.lane & 1) + 2 * ((F.lane >> 1) & 1) + ((F.lane >> 2) & 1); part[((rg * 32 + tt) * 4 + wrun) * 8 + gi] = d1; }
            x0 = x1; x1 = x2; x2 = x3;
        }
        __syncthreads();
        { const int rg2 = F.tid >> 8, tt = (F.tid >> 3) & 31, g = F.tid & 7; const LAS float* p = part + ((rg2 * 32 + tt) * 4) * 8 + g;
          gsh[(rg2 * 32 + tt) * 8 + g] = (p[0] + p[8]) + (p[16] + p[24]) + b_if[g]; }
        __syncthreads();
        if (F.wave < 4) { const int hh = F.wave; const float ic = gsh[F.lane * 8 + hh], lf = log_sigmoid_f(gsh[F.lane * 8 + 4 + hh]);
            float bc = lf;
#pragma unroll
            for (int o = 1; o < 64; o <<= 1) { const float t = __shfl_up(bc, o); if (F.lane >= o) bc += t; }
            float cm = ic - bc;
#pragma unroll
            for (int o = 1; o < 64; o <<= 1) { const float t = __shfl_up(cm, o); if (F.lane >= o) cm = fmaxf(cm, t); }
            *(f32x4*)(IFG + (((size_t)rr * 64 + F.lane) * 4 + hh) * 4) = (f32x4){ic, bc, cm, lf}; }
        __syncthreads();
    }
}

__device__ __forceinline__ float gelu_tanh_f(float x) { const float y = 0.7978845608028654f * (x + 0.044715f * x * x * x); return x * __builtin_amdgcn_rcpf(1.0f + __expf(-2.0f * y)); }

#ifndef MXR_SC
#define MXR_SC 1
#endif
#ifndef MXR_DEN
#define MXR_DEN 1
#endif
#ifndef MXR_RP
#define MXR_RP 1
#endif
typedef short s16x4 __attribute__((ext_vector_type(4)));
typedef short bf16x8 __attribute__((ext_vector_type(8)));
__device__ __forceinline__ bf16x8 tr_frag(LAS unsigned char* p0, LAS unsigned char* p1) {
    const s16x4 lo = __builtin_amdgcn_ds_read_tr16_b64_v4i16((LAS s16x4*)p0);
    const s16x4 hi = __builtin_amdgcn_ds_read_tr16_b64_v4i16((LAS s16x4*)p1);
    return (bf16x8){lo[0], lo[1], lo[2], lo[3], hi[0], hi[1], hi[2], hi[3]};
}
__device__ __forceinline__ bf16x8 pack8(const f32x4& a, const f32x4& b) {
    const unsigned w0 = pg8::cvt_pk_bf16(a[0], a[1]), w1 = pg8::cvt_pk_bf16(a[2], a[3]), w2 = pg8::cvt_pk_bf16(b[0], b[1]), w3 = pg8::cvt_pk_bf16(b[2], b[3]);
    return __builtin_bit_cast(bf16x8, (v4u){w0, w1, w2, w3});
}
__device__ __forceinline__ float scan_add(float v, int lane) {
#pragma unroll
    for (int o = 1; o < 64; o <<= 1) { const float t = __shfl_up(v, o); if (lane >= o) v += t; }
    return v;
}
__device__ __forceinline__ float scan_max(float v, int lane) {
#pragma unroll
    for (int o = 1; o < 64; o <<= 1) { const float t = __shfl_up(v, o); if (lane >= o) v = fmaxf(v, t); }
    return v;
}
__device__ __forceinline__ float rcpf_(float x) { return __builtin_amdgcn_rcpf(x); }
__device__ __forceinline__ float sigm_fast(float x) { return rcpf_(1.0f + __expf(-x)); }
__device__ __forceinline__ int phys_t(int row) { return (row & ~12) | ((row & 4) << 1) | ((row & 8) >> 1); }

constexpr int SC_CHUNKS = 8, N_SC = SEQ / 64 / SC_CHUNKS;
constexpr int ML_SLOT = 65536 + 256 + 64, RT_SLOT = 32768 + 64;

template <bool ML, bool LOCAL>
__device__ __forceinline__ void chunk_mixer(const Ctx& F, int b, int h, int sc, const bf16* Qg, const bf16* Kg, const bf16* Vg, int qk_pitch, int v_pitch,
                                            const f32x2v* rope, const float* IFG, const bf16* Gg, const float* m_norm_h, bf16* OUT, float* slots) {
    constexpr int DK = ML ? 256 : 128, RB = 2 * DK, SR = RB + 32, ST = RB + 32, SV = 512 + 32, SP = 160, NKS = DK / 32, NT = DK / 16, SLOT = ML ? ML_SLOT : RT_SLOT;
    constexpr unsigned oQ = 0, oK = 64 * SR, oKW = oK + 64 * SR, oV = oKW + 64 * ST, oP = oV + 64 * SV, oDEN = oP + 64 * SP, oNV = oDEN + 256;
    static_assert(oNV + 1024 + 1024 + 8192 <= 163584, "mixer LDS map");
    LAS unsigned char* const L = F.lds;
    constexpr int OTS = 288;
    LAS float* const OT = (LAS float*)L;
    static_assert(64 * OTS * 4 <= oP, "output tile stays inside the dead Q | K | KW | V images (P, DEN, NV untouched)");
    LAS float* const DEN = (LAS float*)(L + oDEN);
    LAS float* const NV = (LAS float*)(L + oNV);
    LAS float* const NS = (LAS float*)(L + oNV + 2048);
    LAS float* const GV = (LAS float*)(L + oNV + 1024);
    int lane = F.lane, tid_i = F.tid; asm volatile("" : "+v"(lane), "+v"(tid_i));
    const int w = F.wave;
    const float lg = log_gamma_h(h);
    f32x4 C[NT][2];
#pragma unroll
    for (int t = 0; t < NT; ++t) { C[t][0] = (f32x4){0.f, 0.f, 0.f, 0.f}; C[t][1] = C[t][0]; }
    float m_s = LOCAL ? -INFINITY : 0.f, btot = 0.f;
    __syncthreads();
    if (ML) { if (tid_i < 256) NV[tid_i] = 0.f; }
    if (!LOCAL) { if (sc > 0) {
        const float* S = slots + (size_t)(sc - 1) * SLOT; const float* Sl = S + ((size_t)w * NT * 2 * 64 + lane) * 4;
#pragma unroll
        for (int t = 0; t < NT; ++t)
#pragma unroll
            for (int nt = 0; nt < 2; ++nt) C[t][nt] = *(const f32x4*)(Sl + (t * 2 + nt) * 256);
        if (ML) { if (tid_i < 256) NV[tid_i] = S[65536 + tid_i]; m_s = S[65536 + 258]; } } }
    v4u pq[4], pk[4], pv[4]; f32x4 pr[4]; f32x4 pg = {0.f, 0.f, 0.f, 0.f};
    constexpr bool EARLY_QV = !(ML && !LOCAL), EARLY_K = !(ML && !LOCAL);
    const unsigned voff_qk = ML ? (unsigned)(((tid_i >> 5) * qk_pitch + 8 * (tid_i & 31)) * 2) : (unsigned)(((tid_i >> 3) * qk_pitch + 8 * (tid_i & 7)) * 2);
    const unsigned voff_v = (unsigned)(((tid_i >> 5) * v_pitch + 8 * (tid_i & 31)) * 2);
#define GLD16(base, voff) (*(const v4u*)((const char*)(base) + (voff)))
#define MX_FETCH_KG(cch) do { const size_t r0_ = (size_t)b * SEQ + (size_t)(cch) * 64; \
        if (ML) { pg = *(const f32x4*)(IFG + ((r0_ + lane) * 4 + h) * 4); \
            if (EARLY_K) { _Pragma("unroll") for (int i_ = 0; i_ < 4; ++i_) pk[i_] = GLD16(Kg + (r0_ + 16 * i_) * (size_t)qk_pitch, voff_qk); } } \
        else { pk[0] = GLD16(Kg + r0_ * (size_t)qk_pitch, voff_qk); pk[1] = GLD16(Kg + r0_ * (size_t)qk_pitch + 64, voff_qk); \
            const f32x4* rp_ = (const f32x4*)(rope + (r0_ + (tid_i >> 3)) * 64 + 8 * (tid_i & 7)); pr[0] = rp_[0]; pr[1] = rp_[1]; pr[2] = rp_[2]; pr[3] = rp_[3]; } } while (0)
#define MX_FETCH_QV(cch) do { const size_t r0_ = (size_t)b * SEQ + (size_t)(cch) * 64; \
        if (!LOCAL) { if (ML) { _Pragma("unroll") for (int i_ = 0; i_ < 4; ++i_) pq[i_] = GLD16(Qg + (r0_ + 16 * i_) * (size_t)qk_pitch, voff_qk); } \
            else { pq[0] = GLD16(Qg + r0_ * (size_t)qk_pitch, voff_qk); pq[1] = GLD16(Qg + r0_ * (size_t)qk_pitch + 64, voff_qk); } } \
        _Pragma("unroll") for (int i_ = 0; i_ < 4; ++i_) pv[i_] = GLD16(Vg + (r0_ + 16 * i_) * (size_t)v_pitch, voff_v); } while (0)
    MX_FETCH_KG(sc * SC_CHUNKS); if (EARLY_QV) MX_FETCH_QV(sc * SC_CHUNKS);
#pragma unroll 1
    for (int cc = 0; cc < SC_CHUNKS; ++cc) {
        const int c = sc * SC_CHUNKS + cc;
        const size_t row0 = (size_t)b * SEQ + (size_t)c * 64;
        int lane_o = lane, g, fr, q4, p4, tid_o = tid_i;
#define RELANE() do { asm volatile("" : "+v"(lane_o)); g = lane_o >> 4; fr = lane_o & 15; q4 = fr >> 2; p4 = lane_o & 3; } while (0)
#define RETID() asm volatile("" : "+v"(tid_o))
        RELANE(); RETID();
        float bcum = 0.f, mi = 0.f, winter = 0.f, wk, decay, rowterm = 0.f, agate = 0.f, m_new = 0.f;
        if (ML) {
            const float ic = pg.x; bcum = pg.y; const float cm = pg.z; agate = ic - bcum;
            mi = bcum + fmaxf(m_s, cm); winter = __expf(bcum + m_s - mi);
            const float b_last = __shfl(bcum, 63); m_new = __shfl(mi, 63); btot += b_last;
            wk = __expf(b_last - bcum + ic - m_new); decay = __expf(b_last + m_s - m_new); rowterm = bcum - mi;
        } else { wk = __expf(lg * (float)(63 - lane)); decay = __expf(lg * 64.0f); }
        if (ML && !LOCAL) { if (w == 0) { GV[lane] = winter; GV[64 + lane] = rowterm; GV[128 + lane] = agate; GV[192 + lane] = mi; } }
        if (!EARLY_QV) MX_FETCH_QV(c);
        if (ML && !EARLY_K) {
#pragma unroll
            for (int i_ = 0; i_ < 4; ++i_) pk[i_] = GLD16(Kg + (row0 + 16 * i_) * (size_t)qk_pitch, voff_qk); }
        if (ML) {
            float cs8[8] = {0.f, 0.f, 0.f, 0.f, 0.f, 0.f, 0.f, 0.f};
#pragma unroll
            for (int i = 0; i < 4; ++i) { const int id = tid_o + 512 * i, row = id >> 5, ch = id & 31;
                if (!LOCAL) *(LAS v4u*)(L + oQ + SR * row + 16 * ch) = pq[i];
                const v4u kv = pk[i]; const float wr = __shfl(wk, row);
                const float kw[8] = {bflo(kv.x) * wr, bfhi(kv.x) * wr, bflo(kv.y) * wr, bfhi(kv.y) * wr, bflo(kv.z) * wr, bfhi(kv.z) * wr, bflo(kv.w) * wr, bfhi(kv.w) * wr};
#pragma unroll
                for (int e = 0; e < 8; ++e) cs8[e] += kw[e];
                v4u k2;
                k2.x = pg8::cvt_pk_bf16(kw[0], kw[1]); k2.y = pg8::cvt_pk_bf16(kw[2], kw[3]);
                k2.z = pg8::cvt_pk_bf16(kw[4], kw[5]); k2.w = pg8::cvt_pk_bf16(kw[6], kw[7]);
                if (!LOCAL) *(LAS v4u*)(L + oK + SR * row + 16 * ch) = kv;
                *(LAS v4u*)(L + oKW + ST * phys_t(row) + 16 * ch) = k2; }
#pragma unroll
            for (int e = 0; e < 8; ++e) cs8[e] += __shfl_xor(cs8[e], 32);
            if ((tid_o & 32) == 0) { LAS float* np_ = NS + 256 * w + 8 * (tid_o & 31); *(LAS f32x4*)np_ = (f32x4){cs8[0], cs8[1], cs8[2], cs8[3]}; *(LAS f32x4*)(np_ + 4) = (f32x4){cs8[4], cs8[5], cs8[6], cs8[7]}; }
        } else {
            const int row = tid_o >> 3, c8 = tid_o & 7;
            const v4u ka = pk[0], kb = pk[1];
            v4u qa = {0u, 0u, 0u, 0u}, qb = qa; if (!LOCAL) { qa = pq[0]; qb = pq[1]; }
            const f32x4 r0 = pr[0], r1 = pr[1], r2 = pr[2], r3 = pr[3];
            const float cs[8] = {r0.x, r0.z, r1.x, r1.z, r2.x, r2.z, r3.x, r3.z}, sn[8] = {r0.y, r0.w, r1.y, r1.w, r2.y, r2.w, r3.y, r3.w};
            const unsigned qaw[4] = {qa.x, qa.y, qa.z, qa.w}, qbw[4] = {qb.x, qb.y, qb.z, qb.w}, kaw[4] = {ka.x, ka.y, ka.z, ka.w}, kbw[4] = {kb.x, kb.y, kb.z, kb.w};
            const float ksc = 0.08838834764831845f, wr = __shfl(wk, row);
            unsigned q1[4], q2[4], k1[4], k2[4], kw1[4], kw2[4];
#pragma unroll
            for (int e = 0; e < 4; ++e) {
                if (!LOCAL) { const float x1a = bflo(qaw[e]), x1b = bfhi(qaw[e]), x2a = bflo(qbw[e]), x2b = bfhi(qbw[e]);
                    q1[e] = pg8::cvt_pk_bf16(x1a * cs[2 * e] - x2a * sn[2 * e], x1b * cs[2 * e + 1] - x2b * sn[2 * e + 1]);
                    q2[e] = pg8::cvt_pk_bf16(x1a * sn[2 * e] + x2a * cs[2 * e], x1b * sn[2 * e + 1] + x2b * cs[2 * e + 1]); }
                const float y1a = bflo(kaw[e]), y1b = bfhi(kaw[e]), y2a = bflo(kbw[e]), y2b = bfhi(kbw[e]);
                const float o1a = (y1a * cs[2 * e] - y2a * sn[2 * e]) * ksc, o1b = (y1b * cs[2 * e + 1] - y2b * sn[2 * e + 1]) * ksc;
                const float o2a = (y1a * sn[2 * e] + y2a * cs[2 * e]) * ksc, o2b = (y1b * sn[2 * e + 1] + y2b * cs[2 * e + 1]) * ksc;
                k1[e] = pg8::cvt_pk_bf16(o1a, o1b); k2[e] = pg8::cvt_pk_bf16(o2a, o2b); kw1[e] = pg8::cvt_pk_bf16(o1a * wr, o1b * wr); kw2[e] = pg8::cvt_pk_bf16(o2a * wr, o2b * wr); }
            if (!LOCAL) {
                *(LAS v4u*)(L + oQ + SR * row + 16 * c8) = (v4u){q1[0], q1[1], q1[2], q1[3]}; *(LAS v4u*)(L + oQ + SR * row + 16 * (c8 + 8)) = (v4u){q2[0], q2[1], q2[2], q2[3]};
                *(LAS v4u*)(L + oK + SR * row + 16 * c8) = (v4u){k1[0], k1[1], k1[2], k1[3]}; *(LAS v4u*)(L + oK + SR * row + 16 * (c8 + 8)) = (v4u){k2[0], k2[1], k2[2], k2[3]}; }
            *(LAS v4u*)(L + oKW + ST * phys_t(row) + 16 * c8) = (v4u){kw1[0], kw1[1], kw1[2], kw1[3]}; *(LAS v4u*)(L + oKW + ST * phys_t(row) + 16 * (c8 + 8)) = (v4u){kw2[0], kw2[1], kw2[2], kw2[3]};
        }
        RETID();
#pragma unroll
        for (int i = 0; i < 4; ++i) { const int id = tid_o + 512 * i, row = id >> 5, ch = id & 31;
            *(LAS v4u*)(L + oV + SV * phys_t(row) + 16 * ch) = pv[i]; }
        __syncthreads();
        v4u gpre[4];
        if (!ML && !LOCAL) { const int row_ = tid_i >> 3, c0_ = 32 * (tid_i & 7); const bf16* gp_ = Gg + (row0 + row_) * DIN + c0_;
            gpre[0] = *(const v4u*)gp_; gpre[1] = *(const v4u*)(gp_ + 8); gpre[2] = *(const v4u*)(gp_ + 16); gpre[3] = *(const v4u*)(gp_ + 24); }
        RELANE();
        if (!LOCAL) {
        for (int rsc_ = 0; rsc_ < MXR_SC; ++rsc_)
        { const int mt = w >> 1;
          f32x4 S[2] = {(f32x4){0.f, 0.f, 0.f, 0.f}, (f32x4){0.f, 0.f, 0.f, 0.f}};
          const int nt0 = 2 * (w & 1);
          if (nt0 <= mt) {
              LAS unsigned char* const qa = L + oQ + SR * (16 * mt + fr) + 16 * g; LAS unsigned char* const ka = L + oK + SR * (16 * nt0 + fr) + 16 * g;
#pragma unroll
              for (int kk = 0; kk < NKS; ++kk) { const bf16x8 a = *(const LAS bf16x8*)(qa + 64 * kk);
#pragma unroll
                  for (int tt = 0; tt < 2; ++tt) { const bf16x8 bb = *(const LAS bf16x8*)(ka + 16 * SR * tt + 64 * kk);
                      S[tt] = __builtin_amdgcn_mfma_f32_16x16x32_bf16(a, bb, S[tt], 0, 0, 0); } } }
          f32x4 rt4 = {0.f, 0.f, 0.f, 0.f}; if (ML) rt4 = *(const LAS f32x4*)(GV + 64 + 16 * mt + 4 * g);
#pragma unroll
          for (int tt = 0; tt < 2; ++tt) { const int j = 16 * (nt0 + tt) + fr; const float aj = ML ? GV[128 + j] : 0.f;
#pragma unroll
              for (int r = 0; r < 4; ++r) { const int i = 16 * mt + 4 * g + r; float wgt;
                  if (ML) { wgt = (j <= i) ? __expf(rt4[r] + aj) : 0.f; } else wgt = (j <= i) ? __expf(lg * (float)(i - j)) : 0.f;
                  *(LAS unsigned short*)(L + oP + SP * i + 2 * j) = (unsigned short)f2bf(S[tt][r] * wgt); } } }
        __syncthreads();
        }
        float nnew = 0.f;
        RETID();
        if (ML) for (int rdn_ = 0; rdn_ < MXR_DEN; ++rdn_) {
            if (!LOCAL) { const int i = tid_o >> 3, part = tid_o & 7;
              const v4u pv = *(const LAS v4u*)(L + oP + SP * i + 16 * part);
              float ps = (bflo(pv.x) + bfhi(pv.x)) + (bflo(pv.y) + bfhi(pv.y)) + (bflo(pv.z) + bfhi(pv.z)) + (bflo(pv.w) + bfhi(pv.w));
              float qn = 0.f;
#pragma unroll
              for (int e4 = 0; e4 < 4; ++e4) { const v4u qv = *(const LAS v4u*)(L + oQ + SR * i + 64 * part + 16 * e4);
                  const f32x4 n0 = *(const LAS f32x4*)(NV + 32 * part + 8 * e4), n1 = *(const LAS f32x4*)(NV + 32 * part + 8 * e4 + 4);
                  qn += bflo(qv.x) * n0.x + bfhi(qv.x) * n0.y + bflo(qv.y) * n0.z + bfhi(qv.y) * n0.w + bflo(qv.z) * n1.x + bfhi(qv.z) * n1.y + bflo(qv.w) * n1.z + bfhi(qv.w) * n1.w; }
              float tot = ps + GV[i] * qn;
              tot += __builtin_bit_cast(float, __builtin_amdgcn_update_dpp(0, __builtin_bit_cast(int, tot), 0x104, 0xf, 0xf, true));
              tot += __builtin_bit_cast(float, __builtin_amdgcn_update_dpp(0, __builtin_bit_cast(int, tot), 0x102, 0xf, 0xf, true));
              tot += __builtin_bit_cast(float, __builtin_amdgcn_update_dpp(0, __builtin_bit_cast(int, tot), 0x101, 0xf, 0xf, true));
              if (part == 0) DEN[i] = rcpf_(fmaxf(fabsf(tot), __expf(-GV[192 + i]))); }
            if (tid_o < 256) { const LAS float* np_ = NS + tid_o; float s_ = 0.f;
#pragma unroll
              for (int ww = 0; ww < 8; ++ww) s_ += np_[256 * ww];
              nnew = decay * NV[tid_o] + s_; }
        }
        RELANE();
        f32x4 O[4][2];
        if (!LOCAL) {
#pragma unroll
        for (int mt = 0; mt < 4; ++mt) { O[mt][0] = (f32x4){0.f, 0.f, 0.f, 0.f}; O[mt][1] = O[mt][0]; }
        { LAS unsigned char* const qb = L + oQ + SR * fr + 8 * g;
#pragma unroll
          for (int kk = 0; kk < NKS; ++kk) { const bf16x8 b0 = pack8(C[2 * kk][0], C[2 * kk + 1][0]), b1 = pack8(C[2 * kk][1], C[2 * kk + 1][1]);
#pragma unroll
              for (int mt = 0; mt < 4; ++mt) {
                  const v2u lo = *(const LAS v2u*)(qb + 16 * SR * mt + 64 * kk), hi = *(const LAS v2u*)(qb + 16 * SR * mt + 64 * kk + 32);
                  const bf16x8 a = __builtin_bit_cast(bf16x8, (v4u){lo.x, lo.y, hi.x, hi.y});
                  O[mt][0] = __builtin_amdgcn_mfma_f32_16x16x32_bf16(a, b0, O[mt][0], 0, 0, 0); O[mt][1] = __builtin_amdgcn_mfma_f32_16x16x32_bf16(a, b1, O[mt][1], 0, 0, 0); }
              __builtin_amdgcn_sched_barrier(0); } }
#pragma unroll
        for (int mt = 0; mt < 4; ++mt)
#pragma unroll
            for (int r = 0; r < 4; ++r) { const int i = 16 * mt + 4 * g + r; const float sc_ = ML ? GV[i] : __expf(lg * (float)(i + 1)); O[mt][0][r] *= sc_; O[mt][1][r] *= sc_; }
        }
        bf16x8 vf[2][2];
        { LAS unsigned char* const vb = L + oV + SV * (16 * (g >> 1) + 4 * (g & 1) + q4) + 8 * p4 + 64 * w;
#pragma unroll
          for (int kk2 = 0; kk2 < 2; ++kk2)
#pragma unroll
              for (int nt = 0; nt < 2; ++nt) vf[kk2][nt] = tr_frag(vb + 32 * SV * kk2 + 32 * nt, vb + 32 * SV * kk2 + 8 * SV + 32 * nt); }
        if (!LOCAL) {
        LAS unsigned char* const pb = L + oP + SP * fr + 16 * g;
#pragma unroll
        for (int mt = 0; mt < 4; ++mt) {
#pragma unroll
            for (int kk2 = 0; kk2 < 2; ++kk2) { const bf16x8 a = *(const LAS bf16x8*)(pb + 16 * SP * mt + 64 * kk2);
                O[mt][0] = __builtin_amdgcn_mfma_f32_16x16x32_bf16(a, vf[kk2][0], O[mt][0], 0, 0, 0); O[mt][1] = __builtin_amdgcn_mfma_f32_16x16x32_bf16(a, vf[kk2][1], O[mt][1], 0, 0, 0); }
            __builtin_amdgcn_sched_barrier(0); }
        }
        { LAS unsigned char* const kb = L + oKW + ST * (16 * (g >> 1) + 4 * (g & 1) + q4) + 8 * p4;
          bf16x8 an[2] = {tr_frag(kb, kb + 8 * ST), tr_frag(kb + 32 * ST, kb + 32 * ST + 8 * ST)};
#pragma unroll
          for (int t = 0; t < NT; ++t) { const bf16x8 a0 = an[0], a1 = an[1];
              constexpr bool PIPE = !(ML && !LOCAL);
              if (PIPE && t + 1 < NT) { an[0] = tr_frag(kb + 32 * (t + 1), kb + 8 * ST + 32 * (t + 1)); an[1] = tr_frag(kb + 32 * ST + 32 * (t + 1), kb + 32 * ST + 8 * ST + 32 * (t + 1)); }
              C[t][0] *= decay; C[t][1] *= decay;
              C[t][0] = __builtin_amdgcn_mfma_f32_16x16x32_bf16(a0, vf[0][0], C[t][0], 0, 0, 0); C[t][1] = __builtin_amdgcn_mfma_f32_16x16x32_bf16(a0, vf[0][1], C[t][1], 0, 0, 0);
              C[t][0] = __builtin_amdgcn_mfma_f32_16x16x32_bf16(a1, vf[1][0], C[t][0], 0, 0, 0); C[t][1] = __builtin_amdgcn_mfma_f32_16x16x32_bf16(a1, vf[1][1], C[t][1], 0, 0, 0);
              __builtin_amdgcn_sched_barrier(0);
              if (!PIPE && t + 1 < NT) { an[0] = tr_frag(kb + 32 * (t + 1), kb + 8 * ST + 32 * (t + 1)); an[1] = tr_frag(kb + 32 * ST + 32 * (t + 1), kb + 32 * ST + 8 * ST + 32 * (t + 1)); } } }
        if (cc + 1 < SC_CHUNKS) { MX_FETCH_KG(c + 1); if (EARLY_QV) MX_FETCH_QV(c + 1); }
        __syncthreads();
        RETID();
        if (ML) { if (tid_o < 256) NV[tid_o] = nnew; }
        if (!LOCAL) for (int rrp_ = 0; rrp_ < MXR_RP; ++rrp_) {
        RELANE();
        { LAS float* const ob = OT + (4 * g) * OTS + 32 * (fr >> 2) + 4 * w + (fr & 3);
#pragma unroll
          for (int mt = 0; mt < 4; ++mt)
#pragma unroll
              for (int r = 0; r < 4; ++r) { const float inv = ML ? DEN[16 * mt + 4 * g + r] : 1.0f;
                  ob[(16 * mt + r) * OTS] = O[mt][0][r] * inv; ob[(16 * mt + r) * OTS + 128] = O[mt][1][r] * inv; } }
        __syncthreads();
        RETID();
        { const int row = tid_o >> 3, part = tid_o & 7, c0 = 32 * part; const size_t grow = row0 + row;
          v4u gw0, gw1, gw2, gw3;
          if (ML) { gw0 = *(const v4u*)(Gg + grow * DIN + c0); gw1 = *(const v4u*)(Gg + grow * DIN + c0 + 8); gw2 = *(const v4u*)(Gg + grow * DIN + c0 + 16); gw3 = *(const v4u*)(Gg + grow * DIN + c0 + 24); }
          else { gw0 = gpre[0]; gw1 = gpre[1]; gw2 = gpre[2]; gw3 = gpre[3]; }
          const unsigned gws[16] = {gw0.x, gw0.y, gw0.z, gw0.w, gw1.x, gw1.y, gw1.z, gw1.w, gw2.x, gw2.y, gw2.z, gw2.w, gw3.x, gw3.y, gw3.z, gw3.w};
          float ss = 0.f;
          if (ML) {
#pragma unroll
              for (int e = 0; e < 8; ++e) { f32x4 t4 = *(const LAS f32x4*)(OT + row * OTS + 32 * e + 4 * part);
                  t4.x *= sigm_fast(bflo(gws[2 * e])); t4.y *= sigm_fast(bfhi(gws[2 * e])); t4.z *= sigm_fast(bflo(gws[2 * e + 1])); t4.w *= sigm_fast(bfhi(gws[2 * e + 1]));
                  ss += (t4.x * t4.x + t4.y * t4.y) + (t4.z * t4.z + t4.w * t4.w); *(LAS f32x4*)(OT + row * OTS + 32 * e + 4 * part) = t4; }
          } else {
#pragma unroll
              for (int e = 0; e < 8; ++e) { const f32x4 t4 = *(const LAS f32x4*)(OT + row * OTS + 32 * e + 4 * part); ss += (t4.x * t4.x + t4.y * t4.y) + (t4.z * t4.z + t4.w * t4.w); } }
          ss += __shfl_xor(ss, 1); ss += __shfl_xor(ss, 2); ss += __shfl_xor(ss, 4);
          const float rs = rsqrtf(ss * (1.0f / 256.0f) + EPSF);
#pragma unroll
          for (int e = 0; e < 4; ++e) { const f32x4 ta = *(const LAS f32x4*)(OT + row * OTS + 64 * e + 4 * part), tb = *(const LAS f32x4*)(OT + row * OTS + 64 * e + 32 + 4 * part);
              float o[8] = {ta.x, ta.y, ta.z, ta.w, tb.x, tb.y, tb.z, tb.w};
              if (ML) { const f32x4 na = *(const f32x4*)(m_norm_h + c0 + 8 * e), nb = *(const f32x4*)(m_norm_h + c0 + 8 * e + 4);
                  o[0] *= rs * na.x; o[1] *= rs * na.y; o[2] *= rs * na.z; o[3] *= rs * na.w; o[4] *= rs * nb.x; o[5] *= rs * nb.y; o[6] *= rs * nb.z; o[7] *= rs * nb.w; }
              else {
#pragma unroll
                  for (int k = 0; k < 4; ++k) { const float ga = bflo(gws[4 * e + k]), gb = bfhi(gws[4 * e + k]); o[2 * k] *= rs * ga * sigm_fast(ga); o[2 * k + 1] *= rs * gb * sigm_fast(gb); } }
              *(v4u*)(OUT + grow * DM + c0 + 8 * e) = (v4u){pg8::cvt_pk_bf16(o[0], o[1]), pg8::cvt_pk_bf16(o[2], o[3]), pg8::cvt_pk_bf16(o[4], o[5]), pg8::cvt_pk_bf16(o[6], o[7])}; } }
        __syncthreads();
        }
        if (ML) m_s = m_new;
    }
#undef RELANE
#undef RETID
#undef MX_FETCH_KG
#undef MX_FETCH_QV
#undef GLD16
    if (LOCAL) {
        float* S = slots + (size_t)sc * SLOT;
        float* Sl = S + ((size_t)w * NT * 2 * 64 + lane) * 4;
#pragma unroll
        for (int t = 0; t < NT; ++t)
#pragma unroll
            for (int nt = 0; nt < 2; ++nt) *(f32x4*)(Sl + (t * 2 + nt) * 256) = C[t][nt];
        if (ML) { __syncthreads(); if (tid_i < 256) S[65536 + tid_i] = NV[tid_i]; if (tid_i == 0) { S[65536 + 256] = m_s; S[65536 + 257] = btot; } }
    }
}

__device__ __forceinline__ void combine_states(const Ctx& F, float* mlst, float* rtst) {
    for (int it = F.vcu; it < 256; it += F.G) {
        const int type = it >> 7, bh = (it >> 2) & 31, part = it & 3;
        if (type == 0) {
            float* S0 = mlst + (size_t)bh * 3 * ML_SLOT; float* S1 = S0 + ML_SLOT; float* S2 = S1 + ML_SLOT;
            const float ml0 = S0[65792], b0 = S0[65793], ml1 = S1[65792], b1 = S1[65793], ml2 = S2[65792], b2 = S2[65793];
            (void)b0;
            const float m1 = fmaxf(b0 + 0.f, ml0), a1 = __expf(ml0 - m1);
            const float m2 = fmaxf(b1 + m1, ml1), f1 = __expf(b1 + m1 - m2), g1 = __expf(ml1 - m2);
            const float m3 = fmaxf(b2 + m2, ml2), f2 = __expf(b2 + m2 - m3), g2 = __expf(ml2 - m3);
            constexpr int NV4 = (65536 + 256) / 4 / 4;
            for (int i = F.tid; i < NV4; i += 512) { const size_t o = ((size_t)part * NV4 + i) * 4;
                const f32x4 s0 = *(const f32x4*)(S0 + o), s1 = *(const f32x4*)(S1 + o), s2 = *(const f32x4*)(S2 + o);
                const f32x4 t1 = s0 * a1, t2 = t1 * f1 + s1 * g1, t3 = t2 * f2 + s2 * g2;
                *(f32x4*)(S0 + o) = t1; *(f32x4*)(S1 + o) = t2; *(f32x4*)(S2 + o) = t3; }
            if (part == 0 && F.tid == 0) { S0[65794] = m1; S1[65794] = m2; S2[65794] = m3; }
        } else {
            float* S0 = rtst + (size_t)bh * 3 * RT_SLOT; float* S1 = S0 + RT_SLOT; float* S2 = S1 + RT_SLOT;
            const float G = __expf(log_gamma_h(bh & 3) * 512.0f);
            constexpr int NV4 = 32768 / 4 / 4;
            for (int i = F.tid; i < NV4; i += 512) { const size_t o = ((size_t)part * NV4 + i) * 4;
                const f32x4 s0 = *(const f32x4*)(S0 + o), s1 = *(const f32x4*)(S1 + o), s2 = *(const f32x4*)(S2 + o);
                const f32x4 t2 = s0 * G + s1, t3 = t2 * G + s2;
                *(f32x4*)(S1 + o) = t2; *(f32x4*)(S2 + o) = t3; }
        }
    }
}
__device__ __forceinline__ unsigned offP(unsigned row, unsigned ch) { return 128u * row + 16u * (ch ^ ((row >> 1) & 7u)); }
__device__ __forceinline__ void lru_chunked(const Ctx& F, int b, int cb, int c_begin, int c_end, float* carry_g, const bf16* proj, const float* conv_w, const float* conv_b, const float* w_r, const float* b_r,
                                            const float* w_i, const float* b_i, const float* lam, bf16* LRU) {
    constexpr unsigned oRAW = 0, RAWB = 8704, oLY = 2 * RAWB, oXL = oLY + 16384, oXH = oXL + 16384, oXO = oXH + 8192, oAS = oXO + 8192, oUS = oAS + 16384, oSEG = oUS + 16384, oCAR = oSEG + 4096;
    LAS unsigned char* const L = F.lds;
    LAS float* const XL = (LAS float*)(L + oXL); LAS float* const AS = (LAS float*)(L + oAS); LAS float* const US = (LAS float*)(L + oUS);
    LAS float* const SEG = (LAS float*)(L + oSEG); LAS float* const CAR = (LAS float*)(L + oCAR);
    const int tid = F.tid, lane = F.lane, w = F.wave, g = lane >> 4, fr = lane & 15;
    const int ch0 = cb * 64;
    const int ctok = tid >> 3, cg = tid & 7;
    LAS float* const CWL = (LAS float*)(L + oCAR + 512);
    __syncthreads();
    if (tid < 320) CWL[tid] = (tid < 256) ? conv_w[(tid >> 6) * DM + ch0 + (tid & 63)] : conv_b[ch0 + (tid & 63)];
    const int mt = w >> 1, nt0 = 2 * (w & 1);
    float brr[2], bii[2], spp[2];
    bf16x8 Bh[2][2][2], Bl[2][2][2];
#pragma unroll
    for (int tt = 0; tt < 2; ++tt) { const int e = 16 * (nt0 + tt) + fr; brr[tt] = b_r[ch0 + e]; bii[tt] = b_i[ch0 + e];
        const float lm = lam[ch0 + e]; spp[tt] = (-lm > 20.f) ? -lm : log1p_pos(__expf(-lm));
#pragma unroll
        for (int gt = 0; gt < 2; ++gt) { const float* W = (gt ? w_i : w_r) + (size_t)cb * 4096 + e;
#pragma unroll
            for (int kk = 0; kk < 2; ++kk) { float hi[8], lo[8];
#pragma unroll
                for (int j = 0; j < 8; ++j) { const float wv = W[(32 * kk + 8 * g + j) * 64]; hi[j] = __builtin_bit_cast(float, f2bf(wv) << 16); lo[j] = wv - hi[j]; }
                Bh[gt][tt][kk] = __builtin_bit_cast(bf16x8, (v4u){pk2(hi[0], hi[1]), pk2(hi[2], hi[3]), pk2(hi[4], hi[5]), pk2(hi[6], hi[7])});
                Bl[gt][tt][kk] = __builtin_bit_cast(bf16x8, (v4u){pk2(lo[0], lo[1]), pk2(lo[2], lo[3]), pk2(lo[4], lo[5]), pk2(lo[6], lo[7])}); } } }
    __syncthreads();
    if (tid < 64) CAR[(c_begin & 1) * 64 + tid] = (c_begin > 0) ? carry_g[tid] : 0.f;
    v4u pr0, pr1 = {0u, 0u, 0u, 0u}, pl;
#define LRU_FETCH(cc) do { const int t0_ = (cc) * 64; const size_t rowb_ = (size_t)b * SEQ; \
        { const int row_ = tid >> 3, c16_ = tid & 7, t_ = t0_ - 3 + row_; pr0 = (t_ >= 0) ? *(const v4u*)(proj + (rowb_ + t_) * DIN + OFF_LX + ch0 + 8 * c16_) : (v4u){0u, 0u, 0u, 0u}; } \
        if (tid < 24) { const int row_ = 64 + (tid >> 3), c16_ = tid & 7, t_ = t0_ - 3 + row_; pr1 = *(const v4u*)(proj + (rowb_ + t_) * DIN + OFF_LX + ch0 + 8 * c16_); } \
        { const int row_ = tid >> 3, c16_ = tid & 7; pl = *(const v4u*)(proj + (rowb_ + t0_ + row_) * DIN + OFF_LY + ch0 + 8 * c16_); } } while (0)
    LRU_FETCH(c_begin);
#pragma unroll 1
    for (int c = c_begin; c < c_end; ++c) {
        const int par = c & 1; const size_t row0 = (size_t)b * SEQ + (size_t)c * 64;
        LAS unsigned char* const RAW = L + oRAW + par * RAWB; LAS unsigned char* const LY = L + oLY + par * 8192;
        *(LAS v4u*)(RAW + tid * 16) = pr0; if (tid < 24) *(LAS v4u*)(RAW + 8192 + tid * 16) = pr1; *(LAS v4u*)(LY + tid * 16) = pl;
        if (c + 1 < c_end) LRU_FETCH(c + 1);
        __syncthreads();
        { float x[8];
          { const f32x4 a = *(const LAS f32x4*)(CWL + 256 + 8 * cg), c4 = *(const LAS f32x4*)(CWL + 256 + 8 * cg + 4); x[0] = a.x; x[1] = a.y; x[2] = a.z; x[3] = a.w; x[4] = c4.x; x[5] = c4.y; x[6] = c4.z; x[7] = c4.w; }
#pragma unroll
          for (int k = 0; k < 4; ++k) { const v4u rv = *(const LAS v4u*)(RAW + (ctok + k) * 128 + cg * 16);
              const f32x4 wa = *(const LAS f32x4*)(CWL + 64 * k + 8 * cg), wb = *(const LAS f32x4*)(CWL + 64 * k + 8 * cg + 4);
              x[0] += wa.x * bflo(rv.x); x[1] += wa.y * bfhi(rv.x); x[2] += wa.z * bflo(rv.y); x[3] += wa.w * bfhi(rv.y);
              x[4] += wb.x * bflo(rv.z); x[5] += wb.y * bfhi(rv.z); x[6] += wb.z * bflo(rv.w); x[7] += wb.w * bfhi(rv.w); }
          *(LAS f32x4*)(XL + ctok * 64 + 8 * cg) = (f32x4){x[0], x[1], x[2], x[3]}; *(LAS f32x4*)(XL + ctok * 64 + 8 * cg + 4) = (f32x4){x[4], x[5], x[6], x[7]};
          float hi[8], lo[8];
#pragma unroll
          for (int e = 0; e < 8; ++e) { hi[e] = __builtin_bit_cast(float, f2bf(x[e]) << 16); lo[e] = x[e] - hi[e]; }
          *(LAS v4u*)(L + oXH + offP(ctok, cg)) = (v4u){pk2(hi[0], hi[1]), pk2(hi[2], hi[3]), pk2(hi[4], hi[5]), pk2(hi[6], hi[7])};
          *(LAS v4u*)(L + oXO + offP(ctok, cg)) = (v4u){pk2(lo[0], lo[1]), pk2(lo[2], lo[3]), pk2(lo[4], lo[5]), pk2(lo[6], lo[7])}; }
        __syncthreads();
        { f32x4 acc[2][2];
#pragma unroll
          for (int gt = 0; gt < 2; ++gt) { acc[gt][0] = (f32x4){0.f, 0.f, 0.f, 0.f}; acc[gt][1] = acc[gt][0]; }
#pragma unroll
          for (int kk = 0; kk < 2; ++kk) { const bf16x8 ah = *(const LAS bf16x8*)(L + oXH + offP(16 * mt + fr, 4 * kk + g)), al = *(const LAS bf16x8*)(L + oXO + offP(16 * mt + fr, 4 * kk + g));
#pragma unroll
              for (int gt = 0; gt < 2; ++gt)
#pragma unroll
                  for (int tt = 0; tt < 2; ++tt) { acc[gt][tt] = __builtin_amdgcn_mfma_f32_16x16x32_bf16(ah, Bh[gt][tt][kk], acc[gt][tt], 0, 0, 0);
                      acc[gt][tt] = __builtin_amdgcn_mfma_f32_16x16x32_bf16(al, Bh[gt][tt][kk], acc[gt][tt], 0, 0, 0); acc[gt][tt] = __builtin_amdgcn_mfma_f32_16x16x32_bf16(ah, Bl[gt][tt][kk], acc[gt][tt], 0, 0, 0); } }
#pragma unroll
          for (int tt = 0; tt < 2; ++tt)
#pragma unroll
              for (int r = 0; r < 4; ++r) { const int i = 16 * mt + 4 * g + r, e = 16 * (nt0 + tt) + fr;
                  const float rg = sigmoidf_(acc[0][tt][r] + brr[tt]), ig = sigmoidf_(acc[1][tt][r] + bii[tt]), log_a = -8.0f * rg * spp[tt];
                  AS[i * 64 + e] = __expf(log_a); US[i * 64 + e] = sqrtf(-expm1_neg(2.0f * log_a)) * (ig * XL[i * 64 + e]); } }
        __syncthreads();
        { const int ch = tid & 63, seg = tid >> 6;
          float hl[8], pc[8]; float h = 0.f, p = 1.f;
#pragma unroll
          for (int k = 0; k < 8; ++k) { const float a = AS[(8 * seg + k) * 64 + ch], u = US[(8 * seg + k) * 64 + ch]; h = a * h + u; p *= a; hl[k] = h; pc[k] = p; }
          SEG[(seg * 64 + ch) * 2] = p; SEG[(seg * 64 + ch) * 2 + 1] = h;
          __syncthreads();
          float hin = CAR[par * 64 + ch];
          for (int s = 0; s < seg; ++s) hin = SEG[(s * 64 + ch) * 2] * hin + SEG[(s * 64 + ch) * 2 + 1];
#pragma unroll
          for (int k = 0; k < 8; ++k) { const float hv = hl[k] + pc[k] * hin; if (k == 7 && seg == 7) CAR[(par ^ 1) * 64 + ch] = hv;
              const float ly = bf2f(*(const LAS unsigned short*)(LY + (8 * seg + k) * 128 + ch * 2));
              LRU[(row0 + 8 * seg + k) * DM + ch0 + ch] = (bf16)f2bf(hv * gelu_tanh_f(ly)); } }
    }
    __syncthreads();
    if (c_end < SEQ / 64 && tid < 64) carry_g[tid] = CAR[(c_end & 1) * 64 + tid];
#undef LRU_FETCH
}
enum { I_X = 0, I_C, I_POS, I_WADA, I_BADA, I_NMIX, I_NMLP, I_WIN, I_LCW, I_LCB, I_LWR, I_LBR, I_LWI, I_LBI, I_LLAM, I_MCW, I_MCB, I_MWQ, I_MWK, I_MWV, I_MWIF, I_MBIF, I_MNORM,
       I_WBR0, I_WBR1, I_WBR2, I_WOUT, I_WFF1, I_WFF2, I_FNORM, N_INPUTS };
constexpr int PH_PER_LAYER = 11, N_PHASES = 2 + NL * PH_PER_LAYER;
constexpr int LRU_SPLIT = 8;
struct Args { const float* in[N_INPUTS]; float* out; unsigned char* ws; int ph_lo, ph_hi; };
static_assert(sizeof(Args) == N_INPUTS * 8 + 8 + 8 + 8, "Args has no padding bytes");

__device__ __forceinline__ const float* inp(const Args& a, int i) { asm volatile("" : "+s"(i)); return a.in[i]; }
__device__ __forceinline__ unsigned char* wsbase(const Args& a) { int z = 0; asm volatile("" : "+s"(z)); return (&a.ws)[z]; }
__device__ __forceinline__ int phlo(const Args& a) { int z = 0; asm volatile("" : "+s"(z)); return (&a.ph_lo)[z]; }
__device__ __forceinline__ int phhi(const Args& a) { int z = 0; asm volatile("" : "+s"(z)); return (&a.ph_hi)[z]; }
__device__ __forceinline__ bool in_range(const Args& a, int k) { return phlo(a) <= k && k < phhi(a); }
__device__ __forceinline__ bool seam_here(const Args& a, int k) { return phlo(a) <= k && k + 1 < phhi(a); }
__device__ __forceinline__ float* outp(const Args& a) { int z = 0; asm volatile("" : "+s"(z)); return (&a.out)[z]; }
__device__ __forceinline__ bool t0_here(int wave_s) { int ln; asm volatile("v_mbcnt_lo_u32_b32 %0, -1, 0\n\tv_mbcnt_hi_u32_b32 %0, -1, %0" : "=v"(ln)); return wave_s == 0 && ln == 0; }
__device__ __forceinline__ Ctx make_ctx(LAS unsigned char* lds, int wave_s) {
    Ctx F; int g = (int)gridDim.x, bx = (int)blockIdx.x, wv = wave_s; int ln;
    asm volatile("v_mbcnt_lo_u32_b32 %0, -1, 0\n\tv_mbcnt_hi_u32_b32 %0, -1, %0" : "=v"(ln));
    asm volatile("" : "+s"(g), "+s"(bx), "+s"(wv));
    F.lds = lds; F.lane = ln; F.wave = wv; F.tid = wv * 64 + ln; F.G = g; F.bx = bx; F.vcu = (g % 8 == 0) ? (bx % 8) * (g / 8) + bx / 8 : bx;
    return F;
}
__global__ void __launch_bounds__(NWAVES * 64, 2) fwd(Args args) {
    extern __shared__ __attribute__((aligned(16))) unsigned char lds_raw[];
    LAS unsigned char* const ldsb = (LAS unsigned char*)lds_raw;
    const int wave_s = __builtin_amdgcn_readfirstlane((int)threadIdx.x >> 6);
    volatile LAS unsigned* MISC = (volatile LAS unsigned*)(ldsb + MISC_OFF);
    for (int u = threadIdx.x; u < (LDS_BYTES - SCRATCH_BYTES) / 4; u += NWAVES * 64) ((LAS unsigned*)(ldsb + SCRATCH_BYTES))[u] = 0u;
    __syncthreads();
    { const int span = phhi(args) - phlo(args);
      if (span > 1) (void)xcd_barrier_post((unsigned*)(wsbase(args) + WS_CTL) + 4096, MISC + 8, threadIdx.x == 0); }
#ifndef REP0
#define REP0 1
#endif
#ifndef REP1
#define REP1 1
#endif
#ifndef REP2
#define REP2 1
#endif
#ifndef REP3
#define REP3 1
#endif
#ifndef REP4
#define REP4 1
#endif
#ifndef REP5
#define REP5 1
#endif
#ifndef REP7
#define REP7 1
#endif
#ifndef REP8
#define REP8 1
#endif
#ifndef REPD3A
#define REPD3A 1
#endif
#ifndef REPD3B
#define REPD3B 1
#endif
#ifndef REPD3C
#define REPD3C 1
#endif
#ifndef PMASK
#define PMASK 0xFFFF
#endif
#define IN(k) in_range(args, (k))
#define PH(j) ((PMASK >> (j)) & 1)
#define SEAM(k) do { if (seam_here(args, (k))) { XcdBarrier b_; b_.bar = (unsigned*)(wsbase(args) + WS_CTL) + 4096; b_.x = xb_xcc_id(); b_.st = MISC + 8; xcd_barrier(b_, t0_here(wave_s)); } } while (0)

#define INP(i) inp(args, (i))
#define WSP(T, off) ((T*)(wsbase(args) + (off)))
    if (PH(11) && IN(0)) { const Ctx F = make_ctx(ldsb, wave_s); p0_prologue(F, INP(I_X), INP(I_C), (const int*)INP(I_POS), INP(I_WADA), INP(I_BADA), WSP(float, WS_MODF), WSP(f32x2v, WS_ROPE), outp(args)); }
    SEAM(0);

    for (int l = 0; l < NL; ++l) {
        const int kb = 1 + l * PH_PER_LAYER;
#define MOD_L(j) (WSP(float, WS_MODF) + ((size_t)l * NB * 6 + (j)) * DM)
        if (PH(0) && IN(kb + 0)) for (int rep_ = 0; rep_ < REP0; ++rep_) { const Ctx F = make_ctx(ldsb, wave_s);
            convert_weights(F, INP(I_WIN) + (size_t)l * DM * DIN, INP(I_WBR0) + (size_t)l * DM * DM, INP(I_WBR1) + (size_t)l * DM * DM, INP(I_WBR2) + (size_t)l * DM * DM,
                            INP(I_WOUT) + (size_t)l * DM * DM, INP(I_WFF1) + (size_t)l * DM * DFF, INP(I_WFF2) + (size_t)l * DFF * DM,
                            WSP(bf16, WS_WIN), WSP(bf16, WS_WBR), WSP(bf16, WS_WOUT), WSP(bf16, WS_WFF1), WSP(bf16, WS_WFF2));
            norm_phase(F, outp(args), INP(I_NMIX) + l * DM, MOD_L(1), MOD_L(0), WSP(bf16, WS_ACT));
        }
        SEAM(kb + 0);
        if (PH(1) && IN(kb + 1)) for (int rep_ = 0; rep_ < REP1; ++rep_) { const Ctx F = make_ctx(ldsb, wave_s); pg8::Gemm g{WSP(bf16, WS_ACT), WSP(bf16, WS_WIN), M, DIN, DM}; pg8::StaticOrder S; S.init(M, DIN, F.G, F.bx); pg8::EpiStore<0> E{WSP(bf16, WS_PROJ), DIN};
            pg8::gemm_phase<pg8::EpiStore<0>, pg8::StaticOrder, true, true>(F.lds, g, S, E, F.tid); }
        SEAM(kb + 1);
        if (PH(2) && IN(kb + 2)) for (int rep_ = 0; rep_ < REP2; ++rep_) { const Ctx F = make_ctx(ldsb, wave_s); mlstm_pre(F, WSP(bf16, WS_PROJ), INP(I_MCW) + l * 4 * DM, INP(I_MCB) + l * DM, INP(I_MWQ) + l * DM * 4, INP(I_MWK) + l * DM * 4, INP(I_MWV) + l * DM * 4,
                                  INP(I_MWIF) + (size_t)l * 3 * DM * 8, INP(I_MBIF) + l * 8, WSP(bf16, WS_MQ), WSP(bf16, WS_MK), WSP(bf16, WS_MV), WSP(float, WS_IFG)); }
        SEAM(kb + 2);
        if (PH(3) && IN(kb + 3)) for (int rep_ = 0; rep_ < REP3; ++rep_) {
            { const Ctx F = make_ctx(ldsb, wave_s); const int nlo = F.G > 128 ? 128 : 0, nhi = F.G - nlo;
              for (int j = F.vcu - nlo; j >= 0 && j < 96; j += nhi) { const int bh = j / 3, sc = j % 3, b = bh >> 2, h = bh & 3;
                chunk_mixer<true, true>(F, b, h, sc, nullptr, WSP(bf16, WS_MK) + h * 256, WSP(bf16, WS_MV) + h * 256, DM, DM, nullptr, WSP(float, WS_IFG), nullptr, nullptr, nullptr,
                                        WSP(float, WS_MLST) + (size_t)bh * 3 * ML_SLOT); } }
            { const Ctx F = make_ctx(ldsb, wave_s); const int nlo = F.G > 128 ? 128 : 0, nhi = F.G - nlo;
              for (int j = 96 + (F.vcu - nlo + nhi - 96 % nhi) % nhi; F.vcu >= nlo && j < 192; j += nhi) { const int bh = (j - 96) / 3, sc = (j - 96) % 3, b = bh >> 2, h = bh & 3;
                chunk_mixer<false, true>(F, b, h, sc, nullptr, WSP(bf16, WS_PROJ) + OFF_RK + h * 128, WSP(bf16, WS_PROJ) + OFF_RV + h * 256, DIN, DIN, WSP(f32x2v, WS_ROPE), nullptr, nullptr, nullptr, nullptr,
                                         WSP(float, WS_RTST) + (size_t)bh * 3 * RT_SLOT); } }
            { const Ctx F = make_ctx(ldsb, wave_s);
              for (int it = F.vcu; it < 128; it += F.G) lru_chunked(F, it >> 4, it & 15, 0, LRU_SPLIT, WSP(float, WS_LRUC) + it * 64, WSP(bf16, WS_PROJ), INP(I_LCW) + l * 4 * DM, INP(I_LCB) + l * DM, INP(I_LWR) + (size_t)l * DM * 64, INP(I_LBR) + l * DM,
                                INP(I_LWI) + (size_t)l * DM * 64, INP(I_LBI) + l * DM, INP(I_LLAM) + l * DM, WSP(bf16, WS_LRU)); }
        }
        SEAM(kb + 3);
        if (PH(4) && IN(kb + 4)) { const Ctx F = make_ctx(ldsb, wave_s); combine_states(F, WSP(float, WS_MLST), WSP(float, WS_RTST)); }
        SEAM(kb + 4);
        if (PH(5) && IN(kb + 5)) for (int rep_ = 0; rep_ < REP4; ++rep_) {
            { const Ctx F = make_ctx(ldsb, wave_s); const int nlo = F.G > 128 ? 128 : 0, nhi = F.G - nlo;
              for (int ra_ = 0; ra_ < REPD3A; ++ra_) for (int j = F.vcu - nlo; j >= 0 && j < 128; j += nhi) { const int bh = j >> 2, sc = j & 3, b = bh >> 2, h = bh & 3;
                chunk_mixer<true, false>(F, b, h, sc, WSP(bf16, WS_MQ) + h * 256, WSP(bf16, WS_MK) + h * 256, WSP(bf16, WS_MV) + h * 256, DM, DM, nullptr, WSP(float, WS_IFG),
                                         WSP(bf16, WS_PROJ) + OFF_MO + h * 256, INP(I_MNORM) + l * DM + h * 256, WSP(bf16, WS_MLS) + h * 256, WSP(float, WS_MLST) + (size_t)bh * 3 * ML_SLOT); } }
            { const Ctx F = make_ctx(ldsb, wave_s); const int nlo = F.G > 128 ? 128 : 0, nhi = F.G - nlo;
              for (int rb_ = 0; rb_ < REPD3B; ++rb_) for (int j = 128 + (F.vcu - nlo + nhi - 128 % nhi) % nhi; F.vcu >= nlo && j < 256; j += nhi) { const int bh = (j - 128) >> 2, sc = j & 3, b = bh >> 2, h = bh & 3;
                chunk_mixer<false, false>(F, b, h, sc, WSP(bf16, WS_PROJ) + OFF_RQ + h * 128, WSP(bf16, WS_PROJ) + OFF_RK + h * 128, WSP(bf16, WS_PROJ) + OFF_RV + h * 256, DIN, DIN, WSP(f32x2v, WS_ROPE), nullptr,
                                          WSP(bf16, WS_PROJ) + OFF_RG + h * 256, nullptr, WSP(bf16, WS_RET) + h * 256, WSP(float, WS_RTST) + (size_t)bh * 3 * RT_SLOT); } }
            { const Ctx F = make_ctx(ldsb, wave_s);
              for (int rc_ = 0; rc_ < REPD3C; ++rc_) for (int it = F.vcu; it < 128; it += F.G) lru_chunked(F, it >> 4, it & 15, LRU_SPLIT, SEQ / 64, WSP(float, WS_LRUC) + it * 64, WSP(bf16, WS_PROJ), INP(I_LCW) + l * 4 * DM, INP(I_LCB) + l * DM, INP(I_LWR) + (size_t)l * DM * 64, INP(I_LBR) + l * DM,
                                INP(I_LWI) + (size_t)l * DM * 64, INP(I_LBI) + l * DM, INP(I_LLAM) + l * DM, WSP(bf16, WS_LRU)); }
        }
        SEAM(kb + 5);
        if (PH(6) && IN(kb + 6)) for (int rep_ = 0; rep_ < REP5; ++rep_) {
            { const Ctx F = make_ctx(ldsb, wave_s); pg8::StaticOrder S; S.init(M, DM, F.G, F.bx); pg8::Gemm g{WSP(bf16, WS_RET), WSP(bf16, WS_WBR), M, DM, DM};
              pg8::EpiGate<0> E{WSP(bf16, WS_PROJ) + OFF_GATE, DIN, WSP(bf16, WS_MQ), nullptr, nullptr, DM}; pg8::gemm_phase<pg8::EpiGate<0>, pg8::StaticOrder, true, true>(F.lds, g, S, E, F.tid); }
            { const Ctx F = make_ctx(ldsb, wave_s); pg8::StaticOrder S; S.init(M, DM, F.G, F.bx); pg8::Gemm g{WSP(bf16, WS_LRU), WSP(bf16, WS_WBR) + (size_t)DM * DM, M, DM, DM};
              pg8::EpiGate<0> E{WSP(bf16, WS_PROJ) + OFF_GATE + DM, DIN, WSP(bf16, WS_MK), nullptr, nullptr, DM}; pg8::gemm_phase<pg8::EpiGate<0>, pg8::StaticOrder, true, true>(F.lds, g, S, E, F.tid); }
            { const Ctx F = make_ctx(ldsb, wave_s); pg8::StaticOrder S; S.init(M, DM, F.G, F.bx); pg8::Gemm g{WSP(bf16, WS_MLS), WSP(bf16, WS_WBR) + (size_t)2 * DM * DM, M, DM, DM};
              pg8::EpiGate<1> E{WSP(bf16, WS_PROJ) + OFF_GATE + 2 * DM, DIN, WSP(bf16, WS_ACT), WSP(bf16, WS_MQ), WSP(bf16, WS_MK), DM}; pg8::gemm_phase<pg8::EpiGate<1>, pg8::StaticOrder, true, true>(F.lds, g, S, E, F.tid); }
        }
        SEAM(kb + 6);
        if (PH(7) && IN(kb + 7)) { const Ctx F = make_ctx(ldsb, wave_s); pg8::Gemm g{WSP(bf16, WS_ACT), WSP(bf16, WS_WOUT), M, DM, DM}; pg8::StaticOrder S; S.init(M, DM, F.G, F.bx); pg8::EpiResid E{outp(args), MOD_L(2), 6 * DM};
            pg8::gemm_phase<pg8::EpiResid, pg8::StaticOrder, true, true>(F.lds, g, S, E, F.tid); }
        SEAM(kb + 7);
        if (PH(8) && IN(kb + 8)) for (int rep_ = 0; rep_ < REP7; ++rep_) { const Ctx F = make_ctx(ldsb, wave_s); norm_phase(F, outp(args), INP(I_NMLP) + l * DM, MOD_L(4), MOD_L(3), WSP(bf16, WS_ACT)); }
        SEAM(kb + 8);
        if (PH(9) && IN(kb + 9)) for (int rep_ = 0; rep_ < REP8; ++rep_) { const Ctx F = make_ctx(ldsb, wave_s); pg8::Gemm g{WSP(bf16, WS_ACT), WSP(bf16, WS_WFF1), M, DFF, DM}; pg8::StaticOrder S; S.init(M, DFF, F.G, F.bx); pg8::EpiStore<2> E{WSP(bf16, WS_PROJ), DFF};
            pg8::gemm_phase<pg8::EpiStore<2>, pg8::StaticOrder, true, true>(F.lds, g, S, E, F.tid); }
        SEAM(kb + 9);
        if (PH(10) && IN(kb + 10)) { const Ctx F = make_ctx(ldsb, wave_s); pg8::Gemm g{WSP(bf16, WS_PROJ), WSP(bf16, WS_WFF2), M, DM, DFF}; pg8::StaticOrder S; S.init(M, DM, F.G, F.bx); pg8::EpiResid E{outp(args), MOD_L(5), 6 * DM};
            pg8::gemm_phase<pg8::EpiResid, pg8::StaticOrder, true, true>(F.lds, g, S, E, F.tid); }
        SEAM(kb + 10);
    }
    if (PH(12) && IN(N_PHASES - 1)) { const Ctx F = make_ctx(ldsb, wave_s); final_norm_phase(F, outp(args), INP(I_FNORM)); }
#undef INP
#undef WSP
#undef MOD_L
#undef IN
#undef SEAM
}

extern "C" void kernel_launch(void* const* d_in, const int* in_sizes, int n_in, void* d_out, int out_size, void* d_ws, size_t ws_size, hipStream_t stream) {
    static int grid = 0;
    if (grid == 0) {
        if (n_in != N_INPUTS || out_size != M * DM || ws_size < WS_END) { fprintf(stderr, "kernel_launch: unexpected shapes (n_in %d, out %d, ws %zu); nothing launched\n", n_in, out_size, ws_size); grid = -1; return; }
        int dev = 0, cus = 0, per_cu = 0;
        if (hipGetDevice(&dev) != hipSuccess || hipDeviceGetAttribute(&cus, hipDeviceAttributeMultiprocessorCount, dev) != hipSuccess) { grid = -1; return; }
        if (hipFuncSetAttribute((const void*)fwd, hipFuncAttributeMaxDynamicSharedMemorySize, LDS_BYTES) != hipSuccess) { grid = -1; return; }
        if (hipOccupancyMaxActiveBlocksPerMultiprocessor(&per_cu, (const void*)fwd, NWAVES * 64, LDS_BYTES) != hipSuccess || per_cu < 1) { fprintf(stderr, "kernel_launch: occupancy query says %d blocks per CU; nothing launched\n", per_cu); (void)hipGetLastError(); grid = -1; return; }
        grid = cus;
    }
    if (grid < 0) return;
    (void)hipMemsetAsync((char*)d_ws + WS_CTL, 0, CTL_ZERO_BYTES, stream);
    Args a{};
    for (int i = 0; i < N_INPUTS; ++i) a.in[i] = (const float*)d_in[i];
    a.out = (float*)d_out; a.ws = (unsigned char*)d_ws;
#if MK_ONE_LAUNCH
    a.ph_lo = 0; a.ph_hi = N_PHASES;
    hipLaunchKernelGGL(fwd, dim3(grid), dim3(NWAVES * 64), LDS_BYTES, stream, a);
#else
    for (int k = 0; k < N_PHASES; ++k) { a.ph_lo = k; a.ph_hi = k + 1; hipLaunchKernelGGL(fwd, dim3(grid), dim3(NWAVES * 64), LDS_BYTES, stream, a); }
#endif
}
```
